# Optimizing an MI355X kernel written in HIP

```python
import functools
import jax, jax.numpy as jnp
from jax import lax
import numpy as np

D_MODEL = 2048
BATCH = 1
SEQ = 8192
DEPTH = 4

GRID_W = 64
CTX_LEN = 256
EPS = 1e-6
N_MOD = 6

RET_DK = 128
RET_DV = 128
RET_WIDTH = D_MODEL // 2
RET_HEADS = RET_WIDTH // RET_DV
RET_CHUNK = 128
K_SCALE = RET_DK ** -0.5
ROPE_THETA = 10000.0

POOL_WIDTH = D_MODEL // 4
POOL_WINDOWS = (2, 4, 8, 16)
POOL_GROUPS = len(POOL_WINDOWS)
POOL_GROUP_DIM = POOL_WIDTH // POOL_GROUPS

SG_WIDTH = D_MODEL // 4
SG_GROUPS = 4
SG_GROUP_DIM = SG_WIDTH // SG_GROUPS
SG_CHUNK = 128

N_BRANCH = 3
D_FF = 4 * D_MODEL
N_IN = 4 * RET_WIDTH + POOL_WIDTH + 2 * SG_WIDTH + N_BRANCH * D_MODEL
SPLIT_IDX = (RET_WIDTH, 2 * RET_WIDTH, 3 * RET_WIDTH, 4 * RET_WIDTH,
             4 * RET_WIDTH + POOL_WIDTH, 4 * RET_WIDTH + POOL_WIDTH + SG_WIDTH,
             4 * RET_WIDTH + POOL_WIDTH + 2 * SG_WIDTH)

kernel_name = "hybrid_retention_pool_sgmlp_diffusion_trunk"

F32 = jnp.float32


def rms_norm(x, g):
    xf = x.astype(F32)
    y = xf * lax.rsqrt(jnp.mean(xf * xf, axis=-1, keepdims=True) + EPS)
    return (y * g.astype(F32)).astype(x.dtype)


def modulate(h, shift, scale):
    return h * (1 + scale) + shift


def to_heads(t):
    b, tl, _ = t.shape
    return t.astype(F32).reshape(b, tl, RET_HEADS, -1).transpose(0, 2, 1, 3)


def axial_rope(t, rows, cols):
    half = RET_DK // 2
    nf = half // 2
    inv = ROPE_THETA ** (-jnp.arange(nf, dtype=F32) / nf)

    def rot(tp, pos):
        ang = pos[:, None] * inv[None]
        cos, sin = jnp.cos(ang), jnp.sin(ang)
        t1, t2 = tp[..., :nf], tp[..., nf:]
        return jnp.concatenate([t1 * cos - t2 * sin, t1 * sin + t2 * cos], axis=-1)

    return jnp.concatenate([rot(t[..., :half], rows), rot(t[..., half:], cols)], axis=-1)


def retention_chunkwise(q, k, v, log_gamma, state0):
    b, h, t, dk = q.shape
    n = t // RET_CHUNK
    qc = q.reshape(b, h, n, RET_CHUNK, dk)
    kc = k.reshape(b, h, n, RET_CHUNK, dk)
    vc = v.reshape(b, h, n, RET_CHUNK, -1)
    idx = jnp.arange(RET_CHUNK, dtype=F32)
    dist = idx[:, None] - idx[None, :]
    decay = jnp.where(dist >= 0, jnp.exp(log_gamma[:, None, None] * jnp.maximum(dist, 0.0)), 0.0)
    scores = jnp.einsum('bhncd,bhnsd->bhncs', qc, kc) * decay[None, :, None]
    o_intra = jnp.einsum('bhncs,bhnse->bhnce', scores, vc)
    q_decay = jnp.exp(log_gamma[:, None] * (idx + 1.0)[None])[None, :, None, :, None]
    k_decay = jnp.exp(log_gamma[:, None] * (RET_CHUNK - 1.0 - idx)[None])[None, :, None, :, None]
    kv = jnp.einsum('bhnsd,bhnse->bhnde', kc * k_decay, vc)
    chunk_decay = jnp.exp(log_gamma * RET_CHUNK)[None, :, None, None]

    def step(state, kv_n):
        return state * chunk_decay + kv_n, state

    final, states = lax.scan(step, state0, jnp.moveaxis(kv, 2, 0))
    states = jnp.moveaxis(states, 0, 2)
    o_cross = jnp.einsum('bhncd,bhnde->bhnce', qc * q_decay, states)
    return (o_intra + o_cross).reshape(b, h, t, -1), final


def retention_final_state(k, v, log_gamma):
    t = k.shape[2]
    w = jnp.exp(log_gamma[:, None] * (t - 1.0 - jnp.arange(t, dtype=F32))[None])
    return jnp.einsum('bhtd,bhte,ht->bhde', k, v, w)


def bidir_retention(q, k, v, lg_f, lg_b, sf0, sb0):
    of, sf = retention_chunkwise(q, k, v, lg_f, sf0)
    ob, sb = retention_chunkwise(jnp.flip(q, 2), jnp.flip(k, 2), jnp.flip(v, 2), lg_b, sb0)
    return of + jnp.flip(ob, 2), sf, sb


def retention_out(o, gate, norm_g):
    o = o * lax.rsqrt(jnp.mean(o * o, axis=-1, keepdims=True) + EPS)
    b, h, t, dv = o.shape
    o = o.transpose(0, 2, 1, 3).reshape(b, t, h * dv) * norm_g.astype(F32)
    return (o * jax.nn.silu(gate.astype(F32))).astype(gate.dtype)


def multiscale_pool(p, seg_len, pool_w, pool_scale):
    b, t, _ = p.shape
    ns = t // seg_len
    pf = p.astype(F32).reshape(b, ns, seg_len, POOL_GROUPS, POOL_GROUP_DIM)
    cs = jnp.pad(jnp.cumsum(pf, axis=2), ((0, 0), (0, 0), (1, 0), (0, 0), (0, 0)))
    pos = jnp.arange(seg_len)
    outs = []
    for gi, w in enumerate(POOL_WINDOWS):
        lo = jnp.maximum(pos - w // 2, 0)
        hi = jnp.minimum(pos + w // 2 - 1, seg_len - 1)
        cnt = (hi - lo + 1).astype(F32)
        cg = cs[:, :, :, gi, :]
        mean = (cg[:, :, hi + 1] - cg[:, :, lo]) / cnt[:, None]
        outs.append(mean - pf[:, :, :, gi, :])
    y = jnp.stack(outs, axis=3)
    y = jnp.einsum('bnsgc,gcd->bnsgd', y, pool_w)
    return (y.reshape(b, t, POOL_WIDTH) * pool_scale).astype(p.dtype)


def chunk_spatial_gating(u, v, v_norm_g, w_s, b_s):
    b, t, _ = u.shape
    u = jax.nn.gelu(u)
    v = rms_norm(jax.nn.gelu(v), v_norm_g)
    vc = v.reshape(b, t // SG_CHUNK, SG_CHUNK, SG_GROUPS, SG_GROUP_DIM)
    mixed = jnp.einsum('gij,bnjgc->bnigc', w_s, vc) + b_s.T[None, None, :, :, None]
    return u * mixed.reshape(b, t, SG_WIDTH).astype(u.dtype)


def token_mixer(z, rope_pos, seg_len, sf0, sb0, lg_f, lg_b, ret_norm_g, pool_w, pool_scale,
                sg_norm_g, sg_w, sg_b, w_br, w_bp, w_bs, w_out):
    zq, zk, zv, zg, zp, zu, zsv, zgate = jnp.split(z, SPLIT_IDX, axis=-1)
    q = to_heads(zq)
    k = to_heads(zk) * K_SCALE
    v = to_heads(zv)
    if rope_pos is not None:
        q = axial_rope(q, *rope_pos)
        k = axial_rope(k, *rope_pos)
    o, sf, sb = bidir_retention(q, k, v, lg_f, lg_b, sf0, sb0)
    ret = retention_out(o, zg, ret_norm_g)
    pool = multiscale_pool(zp, seg_len, pool_w, pool_scale)
    sg = chunk_spatial_gating(zu, zsv, sg_norm_g, sg_w, sg_b)
    g_r, g_p, g_s = jnp.split(jax.nn.sigmoid(zgate), N_BRANCH, axis=-1)
    y = g_r * (ret @ w_br) + g_p * (pool @ w_bp) + g_s * (sg @ w_bs)
    return y @ w_out, sf, sb


def sq_relu_mlp(h, w1, w2):
    a = jax.nn.relu(h @ w1)
    return (a * a) @ w2


def setup_inputs(seed: int = 0) -> dict:
    key = jax.random.key(seed)
    ks = jax.random.split(key, 24)

    def nrm(k, shape, scale):
        return jax.random.normal(k, shape, F32) * scale

    gamma0 = 1.0 - 2.0 ** (-5.0 - np.arange(RET_HEADS))
    logit0 = jnp.asarray(np.log(gamma0 / (1.0 - gamma0)).astype(np.float32))
    return {
        "x": nrm(ks[0], (BATCH, SEQ, D_MODEL), 1.0),
        "c": nrm(ks[1], (BATCH, D_MODEL), 1.0),
        "ctx": nrm(ks[2], (BATCH, CTX_LEN, D_MODEL), 1.0),
        "c_ctx": nrm(ks[3], (D_MODEL,), 1.0),
        "w_ada": nrm(ks[4], (DEPTH, D_MODEL, N_MOD * D_MODEL), D_MODEL ** -0.5),
        "b_ada": nrm(ks[5], (DEPTH, N_MOD * D_MODEL), 0.02),
        "norm1_g": 1.0 + nrm(ks[6], (DEPTH, D_MODEL), 0.02),
        "w_in": nrm(ks[7], (DEPTH, D_MODEL, N_IN), D_MODEL ** -0.5),
        "ret_decay_logit": logit0[None, None, :] + nrm(ks[8], (DEPTH, 2, RET_HEADS), 0.1),
        "ret_norm_g": 1.0 + nrm(ks[9], (DEPTH, RET_WIDTH), 0.02),
        "pool_w": nrm(ks[10], (DEPTH, POOL_GROUPS, POOL_GROUP_DIM, POOL_GROUP_DIM), POOL_GROUP_DIM ** -0.5),
        "pool_scale": 1.0 + nrm(ks[11], (DEPTH, POOL_WIDTH), 0.1),
        "sg_norm_g": 1.0 + nrm(ks[12], (DEPTH, SG_WIDTH), 0.02),
        "sg_w": nrm(ks[13], (DEPTH, SG_GROUPS, SG_CHUNK, SG_CHUNK), SG_CHUNK ** -0.5),
        "sg_b": 1.0 + nrm(ks[14], (DEPTH, SG_GROUPS, SG_CHUNK), 0.02),
        "w_br": nrm(ks[15], (DEPTH, RET_WIDTH, D_MODEL), RET_WIDTH ** -0.5),
        "w_bp": nrm(ks[16], (DEPTH, POOL_WIDTH, D_MODEL), POOL_WIDTH ** -0.5),
        "w_bs": nrm(ks[17], (DEPTH, SG_WIDTH, D_MODEL), SG_WIDTH ** -0.5),
        "w_out": nrm(ks[18], (DEPTH, D_MODEL, D_MODEL), D_MODEL ** -0.5),
        "norm2_g": 1.0 + nrm(ks[19], (DEPTH, D_MODEL), 0.02),
        "w1": nrm(ks[20], (DEPTH, D_MODEL, D_FF), D_MODEL ** -0.5),
        "w2": nrm(ks[21], (DEPTH, D_FF, D_MODEL), D_FF ** -0.5),
        "final_norm_g": 1.0 + nrm(ks[22], (D_MODEL,), 0.02),
    }


def reference(x, c, ctx, c_ctx, w_ada, b_ada, norm1_g, w_in, ret_decay_logit, ret_norm_g, pool_w,
              pool_scale, sg_norm_g, sg_w, sg_b, w_br, w_bp, w_bs, w_out, norm2_g, w1, w2, final_norm_g):
    t = x.shape[1]
    rows_n = t // GRID_W
    tok = jnp.arange(rows_n * GRID_W)
    rope_pos = ((tok // GRID_W).astype(F32), (tok % GRID_W).astype(F32))
    silu_c = jax.nn.silu(c)
    silu_cc = jax.nn.silu(c_ctx)[None]
    xc = ctx
    for l in range(DEPTH):
        last = l == DEPTH - 1
        mod_x = jnp.split((silu_c @ w_ada[l] + b_ada[l])[:, None, :], N_MOD, axis=-1)
        mod_c = jnp.split((silu_cc @ w_ada[l] + b_ada[l])[:, None, :], N_MOD, axis=-1)
        lg = jax.nn.log_sigmoid(ret_decay_logit[l].astype(F32))
        mixer = functools.partial(
            token_mixer, lg_f=lg[0], lg_b=lg[1], ret_norm_g=ret_norm_g[l], pool_w=pool_w[l],
            pool_scale=pool_scale[l], sg_norm_g=sg_norm_g[l], sg_w=sg_w[l], sg_b=sg_b[l],
            w_br=w_br[l], w_bp=w_bp[l], w_bs=w_bs[l], w_out=w_out[l])

        hc = modulate(rms_norm(xc, norm1_g[l]), mod_c[0], mod_c[1])
        if last:
            zk, zv = jnp.split(hc @ w_in[l][:, RET_WIDTH:3 * RET_WIDTH], 2, axis=-1)
            kh = to_heads(zk) * K_SCALE
            vh = to_heads(zv)
            sf = retention_final_state(kh, vh, lg[0])
            sb = retention_final_state(jnp.flip(kh, 2), jnp.flip(vh, 2), lg[1])
        else:
            zero = jnp.zeros((xc.shape[0], RET_HEADS, RET_DK, RET_DV), F32)
            out_c, sf, sb = mixer(hc @ w_in[l], None, CTX_LEN, zero, zero)
            xc = xc + mod_c[2] * out_c
            hc2 = modulate(rms_norm(xc, norm2_g[l]), mod_c[3], mod_c[4])
            xc = xc + mod_c[5] * sq_relu_mlp(hc2, w1[l], w2[l])

        hx = modulate(rms_norm(x, norm1_g[l]), mod_x[0], mod_x[1])
        out_x, _, _ = mixer(hx @ w_in[l], rope_pos, GRID_W, sf, sb)
        x = x + mod_x[2] * out_x
        hx2 = modulate(rms_norm(x, norm2_g[l]), mod_x[3], mod_x[4])
        x = x + mod_x[5] * sq_relu_mlp(hx2, w1[l], w2[l])
    return rms_norm(x, final_norm_g)
```

```cpp
#include <hip/hip_runtime.h>
#include <cstdio>
#include <cstdint>

#ifndef PMASK
#define PMASK 0xFFFF
#endif
#ifndef DUP
#define DUP 0
#endif
#ifndef MK_SPLIT
#define MK_SPLIT 0
#endif

constexpr int D = 2048, SEQ = 8192, CTX = 256, DEPTH = 4, GRID_W = 64;
constexpr int MROWS = CTX + SEQ;
constexpr int NCHUNK = MROWS / 128;
constexpr int RET_W = 1024, RET_H = 8, HD = 128;
constexpr int POOL_W = 512, SG_W = 512, DFF = 8192;
constexpr int N_IN = 4 * RET_W + POOL_W + 2 * SG_W + 3 * D;
constexpr int C_Q = 0, C_K = 1024, C_V = 2048, C_G = 3072, C_P = 4096, C_U = 4608, C_SV = 5120, C_GATE = 5632;
constexpr float EPS = 1e-6f;
constexpr float K_SCALE = 0.08838834764831845f;
constexpr float LOG2E = 1.4426950408889634f;

#define LAS __attribute__((address_space(3)))
#define GAS __attribute__((address_space(1)))
typedef unsigned short bf16;
typedef short bf16x8 __attribute__((ext_vector_type(8)));
typedef short bf16x4 __attribute__((ext_vector_type(4)));
typedef float f32x4 __attribute__((ext_vector_type(4)));
typedef float f32x2 __attribute__((ext_vector_type(2)));
typedef unsigned u32x4 __attribute__((ext_vector_type(4)));
typedef unsigned u32x2 __attribute__((ext_vector_type(2)));

__device__ __forceinline__ unsigned f2bf(float f) { unsigned u = __builtin_bit_cast(unsigned, f); return (u + 0x7fffu + ((u >> 16) & 1u)) >> 16; }
__device__ __forceinline__ unsigned pk2(float lo, float hi) { return f2bf(lo) | (f2bf(hi) << 16); }
__device__ __forceinline__ unsigned cvt_pk_bf16(float lo, float hi) { unsigned r; asm volatile("v_cvt_pk_bf16_f32 %0, %1, %2" : "=v"(r) : "v"(lo), "v"(hi)); return r; }
__device__ __forceinline__ float bflo(unsigned w) { return __uint_as_float(w << 16); }
__device__ __forceinline__ float bfhi(unsigned w) { return __uint_as_float(w & 0xffff0000u); }
__device__ __forceinline__ float silu_f(float x) { return x * __builtin_amdgcn_rcpf(1.f + __expf(-x)); }
__device__ __forceinline__ float gelu_tanh_f(float x) { const float u = 1.5957691216057308f * (x + 0.044715f * x * x * x); return x * __builtin_amdgcn_rcpf(1.f + __expf(-u)); }
__device__ __forceinline__ float log_sigmoid_f(float x) { return x >= 0.f ? -log1pf(expf(-x)) : x - log1pf(expf(x)); }
__device__ __forceinline__ float wave_sum(float v) {
#pragma unroll
    for (int o = 1; o < 64; o <<= 1) v += __shfl_xor(v, o);
    return v;
}
#define LDS_WAIT() asm volatile("s_waitcnt lgkmcnt(0)" ::: "memory")
#define VM_WAIT() asm volatile("s_waitcnt vmcnt(0)" ::: "memory")

namespace pg8 {
constexpr int BM = 256, BK = 64, HALF = 128, HTB = HALF * BK * 2  , STAGE_BYTES = 8 * HTB, NXCD = 8, WGM = 8;
__host__ __device__ __forceinline__ int lds_byte(int r, int c) { const int st = (r >> 4) * 2 + (c >> 5), rr = r & 15, cc = c & 31, ob = rr * 64 + cc * 2; return st * 1024 + (ob ^ (((ob >> 9) & 1) << 5)); }
__host__ __device__ __forceinline__ void stage_rc(int b, int& R, int& C) { const int st = b / 1024, sb = b % 1024, swz = sb ^ (((sb >> 9) & 1) << 5); R = (st >> 1) * 16 + swz / 64; C = (st & 1) * 32 + (swz % 64) / 2; }
__host__ __device__ __forceinline__ int perm32(int rho) { const int n = rho >> 4, i = rho & 15; return 8 * (i >> 2) + 4 * n + (i & 3); }

struct Unit { const char* A; const char* B; int nt, pm, pn, kind; };

struct TileOrder {
    int nM, nN, nwg, G, c;
    __device__ void init(int nM_, int nN_, int G_, int c_) { nM = nM_; nN = nN_; nwg = nM * nN; G = G_; c = c_; }
    __device__ bool tile(int i, int& pm, int& pn) const {
        const long L = (long)i * G + c; if (L >= nwg) return false;
        int wgid = (int)L; { const int q = nwg / NXCD, r = nwg % NXCD, xcd = wgid % NXCD, off = wgid / NXCD; wgid = (xcd < r ? xcd * (q + 1) : r * (q + 1) + (xcd - r) * q) + off; }
        const int nig = WGM * nN, gid = wgid / nig, fm = gid * WGM, gsz = (nM - fm) < WGM ? (nM - fm) : WGM;
        pm = fm + ((wgid % nig) % gsz); pn = (wgid % nig) / gsz; return true;
    }
};
struct GemmSched {
    TileOrder T; const char* A; const char* B; size_t a_tile, b_tile; int nt, pm0;
    __device__ __forceinline__ bool next(int i, Unit& u) const { int pm, pn; if (!T.tile(i, pm, pn)) return false; pm += pm0; u.A = A + (size_t)pm * a_tile; u.B = B + (size_t)pn * b_tile; u.nt = nt; u.pm = pm; u.pn = pn; u.kind = 0; return true; }
};
struct BranchSched {
    TileOrder T; const char* A; const char* B; size_t a_tile, b_tile; int pm0;
    __device__ __forceinline__ bool next(int i, Unit& u) const { int pm, pn; const int ti = i / 3, seg = i - 3 * ti; if (!T.tile(ti, pm, pn)) return false; pm += pm0;
        const int koff = seg == 0 ? 0 : (seg == 1 ? 1024 : 1536);
        u.A = A + (size_t)pm * a_tile + koff * 2; u.B = B + (size_t)pn * b_tile + koff * 2; u.nt = seg == 0 ? 16 : 8; u.pm = pm; u.pn = pn; u.kind = seg; return true; }
};

template <class Epi, class Sched>
__device__ __forceinline__ void gemm_phase(LAS unsigned char* lds, const int tid, const int lda, const int ldb, const Sched& S, const Epi& E) {
    const int wid = __builtin_amdgcn_readfirstlane(tid >> 6), lane = tid & 63, wr = wid >> 2, wc = wid & 3, fr = lane & 15, fq = lane >> 4;
    unsigned voffA[2], voffB[2];
#pragma unroll
    for (int i = 0; i < 2; ++i) { int R, C; stage_rc(tid * 16 + i * 8192, R, C); const int Rb = Epi::PERM ? (64 * (R >> 5) + perm32(R & 31)) : R;
        voffA[i] = (unsigned)(R * lda + C) * 2u; voffB[i] = (unsigned)(Rb * ldb + C) * 2u; }
    const size_t kstep = (size_t)(BK * 2);
    const size_t hstepA = (size_t)HALF * lda * 2, hstepB = (size_t)(Epi::PERM ? 32 : HALF) * ldb * 2;
    const unsigned ldsw = (unsigned)wid * 1024u;
    const int aoff = lds_byte(wr * 64 + fr, fq * 8), boff = lds_byte(wc * 32 + fr, fq * 8);
#define PG8_SA(b, h) (((b) * 2 + (h)) * HTB)
#define PG8_SB(b, h) ((4 + (b) * 2 + (h)) * HTB)
#define PG8_STAGE(bufoff, gbase, voff) do { _Pragma("unroll") for (int _i = 0; _i < 2; ++_i) \
        __builtin_amdgcn_global_load_lds((const unsigned*)((const char*)(gbase) + (voff)[_i]), (LAS unsigned*)(lds + (bufoff) + ldsw + _i * 8192), 16, 0, 0); } while (0)
#define PG8_LDA(dst, b, h) do { _Pragma("unroll") for (int m = 0; m < 4; ++m) _Pragma("unroll") for (int k = 0; k < 2; ++k) dst[m][k] = *(const LAS bf16x8*)(lds + PG8_SA(b, h) + aoff + m * 2048 + k * 1024); } while (0)
#define PG8_LDB(dst, b, h) do { _Pragma("unroll") for (int n = 0; n < 2; ++n) _Pragma("unroll") for (int k = 0; k < 2; ++k) dst[n][k] = *(const LAS bf16x8*)(lds + PG8_SB(b, h) + boff + n * 2048 + k * 1024); } while (0)
#define PG8_MMA(ai, bj, At, Bt) do { __builtin_amdgcn_s_setprio(1); _Pragma("unroll") for (int m = 0; m < 4; ++m) _Pragma("unroll") for (int n = 0; n < 2; ++n) _Pragma("unroll") for (int k = 0; k < 2; ++k) \
        acc[ai][bj][m][n] = __builtin_amdgcn_mfma_f32_16x16x32_bf16(Bt[n][k], At[m][k], acc[ai][bj][m][n], 0, 0, 0); __builtin_amdgcn_s_setprio(0); } while (0)
#define PG8_WAIT_V(n) asm volatile("s_waitcnt vmcnt(" #n ")" ::: "memory")
#define PG8_WAIT_L(n) asm volatile("s_waitcnt lgkmcnt(" #n ")" ::: "memory")
#define PG8_BAR __builtin_amdgcn_s_barrier()
#define PG8_SCHED __builtin_amdgcn_sched_barrier(0)
    Unit cur, nxt; int ui = 0;
    if (!S.next(0, cur)) return;
    f32x4 acc[2][2][4][2];
#pragma unroll
    for (int a = 0; a < 2; ++a)
#pragma unroll
        for (int b = 0; b < 2; ++b)
#pragma unroll
            for (int m = 0; m < 4; ++m)
#pragma unroll
                for (int n = 0; n < 2; ++n) acc[a][b][m][n] = (f32x4){0.f, 0.f, 0.f, 0.f};
    bf16x8 At[4][2], B0[2][2], B1[2][2];
    const char* cA = cur.A; const char* cB = cur.B;
    PG8_STAGE(PG8_SB(0, 0), cB, voffB); PG8_STAGE(PG8_SB(0, 1), cB + hstepB, voffB); PG8_STAGE(PG8_SA(0, 0), cA, voffA); PG8_STAGE(PG8_SA(0, 1), cA + hstepA, voffA);
    if (wr == 1) PG8_BAR;
    PG8_WAIT_V(2); PG8_BAR;
    PG8_STAGE(PG8_SB(1, 0), cB + kstep, voffB); PG8_STAGE(PG8_SA(1, 0), cA + kstep, voffA); PG8_STAGE(PG8_SB(1, 1), cB + hstepB + kstep, voffB);
    PG8_WAIT_V(6); PG8_BAR;
    for (;;) {
        const bool has_next = S.next(ui + 1, nxt);
        const char* nA = has_next ? nxt.A : cA; const char* nB = has_next ? nxt.B : cB;
        const int nt = cur.nt;
        for (int t = 0; t < nt; t += 2) {
            const bool last = (t == nt - 2);
            const char* a1 = cA + (size_t)(t + 1) * kstep;
            const char* a2 = last ? nA : cA + (size_t)(t + 2) * kstep; const char* b2 = last ? nB : cB + (size_t)(t + 2) * kstep;
            const char* a3 = a2 + kstep; const char* b3 = b2 + kstep;
            PG8_LDB(B0, 0, 0); PG8_LDB(B1, 0, 1); PG8_SCHED; PG8_LDA(At, 0, 0); PG8_STAGE(PG8_SA(1, 1), a1 + hstepA, voffA);
            PG8_WAIT_V(8); PG8_WAIT_L(0); PG8_BAR; PG8_MMA(0, 0, At, B0); PG8_MMA(0, 1, At, B1); PG8_BAR; PG8_SCHED;
            PG8_LDA(At, 0, 1); PG8_STAGE(PG8_SB(0, 0), b2, voffB); PG8_STAGE(PG8_SB(0, 1), b2 + hstepB, voffB); PG8_STAGE(PG8_SA(0, 0), a2, voffA);
            PG8_WAIT_V(8); PG8_WAIT_L(0); PG8_BAR; PG8_MMA(1, 0, At, B0); PG8_MMA(1, 1, At, B1); PG8_BAR; PG8_SCHED;
            PG8_LDB(B0, 1, 0); PG8_LDB(B1, 1, 1); PG8_SCHED; PG8_LDA(At, 1, 0); PG8_STAGE(PG8_SA(0, 1), a2 + hstepA, voffA);
            PG8_WAIT_V(8); PG8_WAIT_L(0); PG8_BAR; PG8_MMA(0, 0, At, B0); PG8_MMA(0, 1, At, B1); PG8_BAR; PG8_SCHED;
            PG8_LDA(At, 1, 1); PG8_STAGE(PG8_SB(1, 0), b3, voffB); PG8_STAGE(PG8_SB(1, 1), b3 + hstepB, voffB); PG8_STAGE(PG8_SA(1, 0), a3, voffA);
            PG8_WAIT_V(8); PG8_WAIT_L(0); PG8_BAR; PG8_MMA(1, 0, At, B0); PG8_MMA(1, 1, At, B1); PG8_BAR; PG8_SCHED;
        }
        if (wr == 0) PG8_BAR;
        E(acc, cur, wr, wc, fr, fq);
#if defined(EPI2)
        if (Epi::PROBE2) E(acc, cur, wr, wc, fr, fq);
#endif
        if (!has_next) break;
        if (!(Epi::KEEP && E.keep(cur))) {
#pragma unroll
            for (int a = 0; a < 2; ++a)
#pragma unroll
                for (int b = 0; b < 2; ++b)
#pragma unroll
                    for (int m = 0; m < 4; ++m)
#pragma unroll
                        for (int n = 0; n < 2; ++n) acc[a][b][m][n] = (f32x4){0.f, 0.f, 0.f, 0.f};
        }
        cur = nxt; cA = nA; cB = nB; ++ui;
        if (wr == 1) PG8_BAR;
    }
    PG8_WAIT_V(0);
    PG8_BAR;
#undef PG8_SA
#undef PG8_SB
#undef PG8_STAGE
#undef PG8_LDA
#undef PG8_LDB
#undef PG8_MMA
#undef PG8_WAIT_V
#undef PG8_WAIT_L
#undef PG8_BAR
#undef PG8_SCHED
}
}

constexpr size_t KiB = 1024, MiB = 1u << 20;
constexpr size_t WS_CTL = 0, CTL_ZERO_BYTES = 128 * KiB;
constexpr size_t WS_BAR = 64 * KiB;
constexpr size_t WS_MOD = 256 * KiB;
constexpr size_t WS_ROPE = 1 * MiB;
constexpr size_t WS_PWT = WS_ROPE + 64 * KiB;
constexpr size_t WS_SGW = WS_PWT + 512 * KiB;
constexpr size_t WS_WIN = 4 * MiB;
constexpr size_t SZ_WIN = (size_t)N_IN * D * 2;
constexpr size_t WS_WCAT = WS_WIN + DEPTH * SZ_WIN;
constexpr size_t SZ_WSQ = (size_t)D * D * 2;
constexpr size_t WS_WOUT = WS_WCAT + DEPTH * SZ_WSQ;
constexpr size_t WS_W1 = WS_WOUT + DEPTH * SZ_WSQ;
constexpr size_t SZ_WFF = (size_t)DFF * D * 2;
constexpr size_t WS_W2 = WS_W1 + DEPTH * SZ_WFF;
constexpr size_t WS_X = WS_W2 + DEPTH * SZ_WFF;
constexpr size_t WS_H = WS_X + (size_t)MROWS * D * 4;
constexpr size_t WS_ZB = WS_H + (size_t)MROWS * D * 2;
constexpr size_t WS_KVT = WS_ZB + (size_t)MROWS * N_IN * 2;
constexpr size_t WS_ST = WS_KVT + (size_t)NCHUNK * 16 * 16384 * 4;
constexpr size_t WS_MIX = WS_ST + (size_t)NCHUNK * 16 * 16384 * 2;
constexpr size_t WS_Y = WS_MIX + (size_t)MROWS * D * 2;
constexpr size_t WS_A1 = WS_Y + (size_t)MROWS * D * 2;
constexpr size_t WS_MODP = WS_A1 + (size_t)MROWS * DFF * 2;
constexpr size_t WS_SLAB = WS_MODP + (size_t)16 * DEPTH * 2 * 6 * D * 4;
constexpr size_t WS_XCH = WS_SLAB + (size_t)4 * CTX * D * 4;
constexpr size_t WS_END = WS_XCH + (size_t)MROWS * 8 * 4;
constexpr size_t WS_CNT = 0;

constexpr int SCR_BYTES = 147456;
constexpr int MISC_OFF = SCR_BYTES;
constexpr int LDS_BYTES = SCR_BYTES + 256;
constexpr int TP = 272;
constexpr int TILE_B = 128 * TP;

#define XB_TMO      128
#define XB_XCNT(j)  (256  + 64 * (j))
#define XB_XSUB(j)  (1280 + 64 * (j))
#define XB_XGEN(j)  (2304 + 64 * (j))
#define XB_TOP      3328
#define XB_TOPGEN   3392
#define XCD_BAR_WORDS 3456
#define XB_SPIN_CAP (1u << 18)
__device__ __forceinline__ unsigned xb_ld(unsigned* p)              { return __hip_atomic_load(p, __ATOMIC_RELAXED, __HIP_MEMORY_SCOPE_AGENT); }
__device__ __forceinline__ unsigned xb_add(unsigned* p, unsigned v) { return __hip_atomic_fetch_add(p, v, __ATOMIC_RELAXED, __HIP_MEMORY_SCOPE_AGENT); }
__device__ __forceinline__ unsigned xb_xcc_id() { return (unsigned)__builtin_amdgcn_s_getreg((3 << 11) | 20) & 0xFu; }
#define XB_SPIN(cond, bar) do { unsigned _sp = 0; while (cond) { __builtin_amdgcn_s_sleep(1); \
    if ((++_sp & 255u) == 0u) { if (xb_ld(&(bar)[XB_TMO])) break; if (_sp > XB_SPIN_CAP) { atomicAdd(&(bar)[XB_TMO], 1u); break; } } } } while (0)
struct XcdBarrier { unsigned* bar; unsigned x; volatile LAS unsigned* st; };
__device__ __forceinline__ XcdBarrier xcd_barrier_post(unsigned* bar, volatile LAS unsigned* st) {
    XcdBarrier b; b.bar = bar; b.x = xb_xcc_id(); b.st = st;
    if (threadIdx.x == 0) (void)xb_add(&bar[XB_XCNT(b.x)], 1u);
    return b;
}
__device__ __forceinline__ void xcd_barrier_complete(unsigned* bar, unsigned x, unsigned& nloc, unsigned& nx) {
    const unsigned G = gridDim.x * gridDim.y * gridDim.z;
    unsigned sum, cnt, mine, sp = 0u;
    for (;;) {
        sum = 0u; cnt = 0u; mine = 0u;
#pragma unroll
        for (unsigned j = 0; j < 16; ++j) { const unsigned c = xb_ld(&bar[XB_XCNT(j)]); sum += c; cnt += (c > 0u) ? 1u : 0u; mine = (j == x) ? c : mine; }
        if (sum == G) break;
        __builtin_amdgcn_s_sleep(1);
        if ((++sp & 255u) == 0u) { if (xb_ld(&bar[XB_TMO])) break; if (sp > XB_SPIN_CAP) { atomicAdd(&bar[XB_TMO], 1u); break; } }
    }
    nloc = mine > 0u ? mine : 1u; nx = cnt > 0u ? cnt : 1u;
}
__device__ __forceinline__ void xcd_barrier(const XcdBarrier& b) {
    asm volatile("s_waitcnt vmcnt(0)" ::: "memory");
    __syncthreads();
    if (threadIdx.x == 0) {
        unsigned* bar = b.bar;
        __builtin_amdgcn_s_waitcnt(0);
        unsigned nloc = b.st[0], nx = b.st[1];
        if (nloc == 0u) { xcd_barrier_complete(bar, b.x, nloc, nx); b.st[0] = nloc; b.st[1] = nx; }
        const unsigned old = xb_add(&bar[XB_XSUB(b.x)], 1u);
        const unsigned gen = old / nloc;
        if (old + 1u == (gen + 1u) * nloc) {
            __builtin_amdgcn_fence(__ATOMIC_RELEASE, "agent");
            asm volatile("s_waitcnt vmcnt(0)" ::: "memory");
            const unsigned og = xb_add(&bar[XB_TOP], 1u);
            const unsigned tg = og / nx;
            if (og + 1u == (tg + 1u) * nx) xb_add(&bar[XB_TOPGEN], 1u);
            else XB_SPIN(xb_ld(&bar[XB_TOPGEN]) == tg, bar);
            __builtin_amdgcn_fence(__ATOMIC_ACQUIRE, "agent");
            xb_add(&bar[XB_XGEN(b.x)], 1u);
            asm volatile("s_waitcnt vmcnt(0)" ::: "memory");
        } else {
            XB_SPIN(xb_ld(&bar[XB_XGEN(b.x)]) == gen, bar);
            __builtin_amdgcn_fence(__ATOMIC_ACQUIRE, "agent");
            asm volatile("s_waitcnt vmcnt(0)" ::: "memory");
        }
    }
    __syncthreads();
}

struct Args { const float* in[23]; float* out; unsigned char* ws; int ph_lo, ph_hi; };
typedef const __attribute__((address_space(4))) Args* KArgs;
struct Frame {
    LAS unsigned char* lds;
    int tid, lane, wave, G, bid;
    unsigned char* ws;
    const float* const __attribute__((address_space(4)))* in;
};
__device__ __forceinline__ void make_frame(Frame& F, LAS unsigned char* lds) {
    int t = threadIdx.x; asm volatile("" : "+v"(t));
    KArgs ka = (KArgs)__builtin_amdgcn_kernarg_segment_ptr(); asm volatile("" : "+s"(ka));
    F.lds = lds; F.tid = t; F.lane = t & 63; F.wave = __builtin_amdgcn_readfirstlane(t >> 6); F.G = gridDim.x; F.bid = blockIdx.x;
    F.ws = ka->ws; F.in = ka->in;
}
enum { I_X = 0, I_C, I_CTX, I_CCTX, I_WADA, I_BADA, I_N1G, I_WIN, I_RLOG, I_RNG, I_PW, I_PS, I_SGNG, I_SGW, I_SGB, I_WBR, I_WBP, I_WBS, I_WOUT, I_N2G, I_W1, I_W2, I_FNG };

using pg8::Unit; using pg8::BM; using pg8::HALF;
#if defined(EPI2)
#define P2(x) static constexpr bool PROBE2 = (EPI2 == x);
#else
#define P2(x)
#endif
struct EpiInProj {           P2(1)
    static constexpr bool PERM = true, KEEP = false;
    bf16* ZB; const float* rope;
    __device__ __forceinline__ bool keep(const Unit&) const { return false; }
    __device__ __forceinline__ void operator()(f32x4 (&acc)[2][2][4][2], const Unit& u, int wr, int wc, int fr, int fq) const {
        const int pn = u.pn, row0 = u.pm * BM + wr * 64 + fr;
        if (pn < 8) {
            const int half = wc & 1; const float ks = pn >= 4 ? K_SCALE : 1.f; const bool latent = u.pm > 0;
            f32x4 csn[4];
            auto ldcs = [&](int step, f32x4 (&c4)[4]) { const int row = row0 + (step >> 2) * HALF + (step & 3) * 16;
#pragma unroll
                for (int q = 0; q < 4; ++q) c4[q] = (f32x4){1.f, 0.f, 1.f, 0.f};
                if (latent) { const int tok = row - CTX; const int pos = half ? (tok & (GRID_W - 1)) : (tok / GRID_W); const float* rp = rope + (size_t)(pos * 32 + 8 * fq) * 2;
#pragma unroll
                    for (int q = 0; q < 4; ++q) c4[q] = *(const f32x4*)(rp + 4 * q); } };
            ldcs(0, csn);
#pragma unroll
            for (int ai = 0; ai < 2; ++ai)
#pragma unroll
                for (int m = 0; m < 4; ++m) {
                    const int row = row0 + ai * HALF + m * 16;
                    f32x4 cs[4];
#pragma unroll
                    for (int q = 0; q < 4; ++q) cs[q] = csn[q];
                    if (ai * 4 + m < 7) ldcs(ai * 4 + m + 1, csn);
                    float o1[8], o2[8];
#pragma unroll
                    for (int n = 0; n < 2; ++n) { const f32x4 t1 = acc[ai][0][m][n] * ks, t2 = acc[ai][1][m][n] * ks;
#pragma unroll
                        for (int j = 0; j < 4; ++j) { const int e = 4 * n + j; const float c = cs[e >> 1][2 * (e & 1)], sn = cs[e >> 1][2 * (e & 1) + 1];
                            o1[e] = t1[j] * c - t2[j] * sn; o2[e] = t1[j] * sn + t2[j] * c; } }
                    bf16* dst = ZB + (size_t)row * N_IN + pn * BM + 64 * wc + 8 * fq;
                    u32x4 w1, w2; w1.x = cvt_pk_bf16(o1[0], o1[1]); w1.y = cvt_pk_bf16(o1[2], o1[3]); w1.z = cvt_pk_bf16(o1[4], o1[5]); w1.w = cvt_pk_bf16(o1[6], o1[7]);
                    w2.x = cvt_pk_bf16(o2[0], o2[1]); w2.y = cvt_pk_bf16(o2[2], o2[3]); w2.z = cvt_pk_bf16(o2[4], o2[5]); w2.w = cvt_pk_bf16(o2[6], o2[7]);
                    *(u32x4*)dst = w1; *(u32x4*)(dst + 32) = w2;
                }
            return;
        }
        bf16* tile = ZB + (size_t)row0 * N_IN + pn * BM + wc * 64 + 8 * fq;
        if (pn >= 22) store_gate_tile(acc, (unsigned char*)ZB + (size_t)row0 * (N_IN * 2) + 2 * C_GATE + (pn * BM - C_GATE) + wc * 64 + 8 * fq);
        else if (pn < 12 || (pn >= 16 && pn < 18)) store_tile<0>(acc, tile);
        else if (pn < 16) store_tile<1>(acc, tile);
        else store_tile<2>(acc, tile);
    }
    __device__ __forceinline__ void store_gate_tile(f32x4 (&acc)[2][2][4][2], unsigned char* tile) const {
#pragma unroll
        for (int ai = 0; ai < 2; ++ai)
#pragma unroll
            for (int m = 0; m < 4; ++m) {
                unsigned char* rowp = tile + (size_t)(ai * HALF + m * 16) * (N_IN * 2);
#pragma unroll
                for (int bj = 0; bj < 2; ++bj) {
                    unsigned q[8];
#pragma unroll
                    for (int j = 0; j < 8; ++j) { const float z = j < 4 ? acc[ai][bj][m][0][j] : acc[ai][bj][m][1][j - 4];
                        const float g = __builtin_amdgcn_rcpf(1.f + __builtin_amdgcn_exp2f(z * -LOG2E));
                        q[j] = (unsigned)__builtin_amdgcn_fmed3f(g * 255.f + 0.5f, 1.f, 255.f); }
                    u32x2 w; w.x = q[0] | (q[1] << 8) | (q[2] << 16) | (q[3] << 24); w.y = q[4] | (q[5] << 8) | (q[6] << 16) | (q[7] << 24);
                    *(u32x2*)(rowp + bj * 32) = w;
                }
            }
    }
    template <int MODE>
    __device__ __forceinline__ void store_tile(f32x4 (&acc)[2][2][4][2], bf16* tile) const {
#pragma unroll
        for (int ai = 0; ai < 2; ++ai)
#pragma unroll
            for (int m = 0; m < 4; ++m) {
                bf16* rowp = tile + (size_t)(ai * HALF + m * 16) * N_IN;
#pragma unroll
                for (int bj = 0; bj < 2; ++bj) {
                    float v[8];
#pragma unroll
                    for (int j = 0; j < 4; ++j) { v[j] = acc[ai][bj][m][0][j]; v[4 + j] = acc[ai][bj][m][1][j]; }
#pragma unroll
                    for (int j = 0; j < 8; ++j) {
                        if (MODE == 1) v[j] = silu_f(v[j]);
                        else if (MODE == 2) v[j] = gelu_tanh_f(v[j]);
                        else if (MODE == 3) v[j] = 1.f + __expf(-fminf(fmaxf(v[j], -30.f), 30.f));
                    }
                    u32x4 w; w.x = cvt_pk_bf16(v[0], v[1]); w.y = cvt_pk_bf16(v[2], v[3]); w.z = cvt_pk_bf16(v[4], v[5]); w.w = cvt_pk_bf16(v[6], v[7]);
                    *(u32x4*)(rowp + bj * 32) = w;
                }
            }
    }
};
struct EpiBranch { static constexpr bool PRETOUCH = false;          P2(0)
    static constexpr bool PERM = true, KEEP = true;
    const bf16* ZB; bf16* Y;
    __device__ __forceinline__ bool keep(const Unit& u) const { return u.kind < 2; }
    __device__ __forceinline__ void operator()(f32x4 (&acc)[2][2][4][2], const Unit& u, int wr, int wc, int fr, int fq) const {
        const int kind = u.kind, rowu = u.pm * BM + wr * 64, colu = u.pn * BM + wc * 64;
        const unsigned char* gb = (const unsigned char*)ZB + (size_t)rowu * (N_IN * 2) + 2 * C_GATE + colu + kind * D;
        const int dstep = kind < 2 ? D : 0;
        const unsigned glo = (unsigned)(fr * (N_IN * 2) + 8 * fq);
        const bool fin = kind == 2;
#pragma unroll
        for (int ai = 0; ai < 2; ++ai) {
            u32x2 nm[4][2], dn[4][2];
#pragma unroll
            for (int m = 0; m < 4; ++m)
#pragma unroll
                for (int bj = 0; bj < 2; ++bj) { const unsigned char* p = gb + (size_t)(ai * HALF + m * 16) * (N_IN * 2) + bj * 32;
                    nm[m][bj] = *(const u32x2*)(p + glo); dn[m][bj] = *(const u32x2*)(p + dstep + glo); }
#pragma unroll
            for (int m = 0; m < 4; ++m)
#pragma unroll
                for (int bj = 0; bj < 2; ++bj) {
                    float sc[8];
#pragma unroll
                    for (int q = 0; q < 8; ++q) { const float n = (float)((nm[m][bj][q >> 2] >> (8 * (q & 3))) & 255u), r = __builtin_amdgcn_rcpf((float)((dn[m][bj][q >> 2] >> (8 * (q & 3))) & 255u));
                        sc[q] = n * (fin ? (1.f / 255.f) : r); }
#pragma unroll
                    for (int j = 0; j < 4; ++j) { acc[ai][bj][m][0][j] *= sc[j]; acc[ai][bj][m][1][j] *= sc[4 + j]; }
                }
        }
        if (fin) {
            bf16* yb = Y + (size_t)rowu * D + colu; const unsigned ylo = (unsigned)(fr * (D * 2) + 16 * fq);
#pragma unroll
            for (int ai = 0; ai < 2; ++ai)
#pragma unroll
                for (int m = 0; m < 4; ++m)
#pragma unroll
                    for (int bj = 0; bj < 2; ++bj) { const f32x4 a = acc[ai][bj][m][0], b = acc[ai][bj][m][1]; u32x4 w; w.x = cvt_pk_bf16(a[0], a[1]); w.y = cvt_pk_bf16(a[2], a[3]); w.z = cvt_pk_bf16(b[0], b[1]); w.w = cvt_pk_bf16(b[2], b[3]);
                        *(u32x4*)((unsigned char*)(yb + (size_t)(ai * HALF + m * 16) * D + bj * 32) + ylo) = w; }
        }
    }
};
struct EpiResid {            P2(0)
    static constexpr bool PERM = true, KEEP = false;
    bf16* X; const float* modl; int gi; float dry;
    __device__ __forceinline__ bool keep(const Unit&) const { return false; }
    __device__ __forceinline__ void operator()(f32x4 (&acc)[2][2][4][2], const Unit& u, int wr, int wc, int fr, int fq) const {
        const int row0 = u.pm * BM + wr * 64 + fr, col0 = u.pn * BM + wc * 64 + 8 * fq;
        const float* gate = modl + (size_t)(u.pm > 0 ? 1 : 0) * 6 * D + gi * D + col0;
        f32x4 gv[2][2];
#pragma unroll
        for (int bj = 0; bj < 2; ++bj)
#pragma unroll
            for (int n = 0; n < 2; ++n) gv[bj][n] = *(const f32x4*)(gate + bj * 32 + n * 4) * dry;
#pragma unroll
        for (int ai = 0; ai < 2; ++ai) {
            u32x4 xa[4][2];
#pragma unroll
            for (int m = 0; m < 4; ++m)
#pragma unroll
                for (int bj = 0; bj < 2; ++bj) xa[m][bj] = *(const u32x4*)(X + (size_t)(row0 + ai * HALF + m * 16) * D + col0 + bj * 32);
#pragma unroll
            for (int m = 0; m < 4; ++m) { bf16* rowp = X + (size_t)(row0 + ai * HALF + m * 16) * D + col0;
#pragma unroll
                for (int bj = 0; bj < 2; ++bj) { const f32x4 a = acc[ai][bj][m][0] * gv[bj][0], b = acc[ai][bj][m][1] * gv[bj][1]; const u32x4 x = xa[m][bj]; u32x4 w;
                    w.x = cvt_pk_bf16(bflo(x.x) + a[0], bfhi(x.x) + a[1]); w.y = cvt_pk_bf16(bflo(x.y) + a[2], bfhi(x.y) + a[3]);
                    w.z = cvt_pk_bf16(bflo(x.z) + b[0], bfhi(x.z) + b[1]); w.w = cvt_pk_bf16(bflo(x.w) + b[2], bfhi(x.w) + b[3]);
                    *(u32x4*)(rowp + bj * 32) = w; }
            }
        }
    }
};
template <bool FINAL>
struct EpiResidNorm {
    static constexpr bool PERM = true, KEEP = false;
    bf16* X; const float* modl; int gi; const float* ng; float* out; unsigned* xch; unsigned* cnt; LAS unsigned char* tab; unsigned want; bf16* H; const float* sc; const float* sh;
    __device__ __forceinline__ bool keep(const Unit&) const { return false; }
    __device__ __forceinline__ void operator()(f32x4 (&acc)[2][2][4][2], const Unit& u, int wr, int wc, int fr, int fq) const {
        const int lane = fq * 16 + fr, wid = wr * 4 + wc;
        const int row0 = u.pm * BM + wr * 64 + fr, col0 = u.pn * BM + wc * 64 + 8 * fq;
        LAS float* P = (LAS float*)tab; LAS float* S = (LAS float*)(tab + 4096);
        {
            const float* gate = modl + (size_t)6 * D + gi * D + col0;
            f32x4 gv[2][2];
#pragma unroll
            for (int bj = 0; bj < 2; ++bj)
#pragma unroll
                for (int n = 0; n < 2; ++n) gv[bj][n] = *(const f32x4*)(gate + bj * 32 + n * 4);
#pragma unroll
            for (int ai = 0; ai < 2; ++ai) {
                u32x4 xa[4][2];
#pragma unroll
                for (int m = 0; m < 4; ++m)
#pragma unroll
                    for (int bj = 0; bj < 2; ++bj) xa[m][bj] = *(const u32x4*)(X + (size_t)(row0 + ai * HALF + m * 16) * D + col0 + bj * 32);
#pragma unroll
                for (int m = 0; m < 4; ++m) { float ss = 0.f;
#pragma unroll
                    for (int bj = 0; bj < 2; ++bj) { const f32x4 a = acc[ai][bj][m][0] * gv[bj][0], b = acc[ai][bj][m][1] * gv[bj][1]; const u32x4 x = xa[m][bj]; u32x4 w;
                        w.x = cvt_pk_bf16(bflo(x.x) + a[0], bfhi(x.x) + a[1]); w.y = cvt_pk_bf16(bflo(x.y) + a[2], bfhi(x.y) + a[3]);
                        w.z = cvt_pk_bf16(bflo(x.z) + b[0], bfhi(x.z) + b[1]); w.w = cvt_pk_bf16(bflo(x.w) + b[2], bfhi(x.w) + b[3]);
                        if (!FINAL) *(u32x4*)(X + (size_t)(row0 + ai * HALF + m * 16) * D + col0 + bj * 32) = w;
                        const f32x4 v0 = (f32x4){bflo(w.x), bfhi(w.x), bflo(w.y), bfhi(w.y)}, v1 = (f32x4){bflo(w.z), bfhi(w.z), bflo(w.w), bfhi(w.w)};
                        acc[ai][bj][m][0] = v0; acc[ai][bj][m][1] = v1;
                        ss += ((v0[0] * v0[0] + v0[1] * v0[1]) + (v0[2] * v0[2] + v0[3] * v0[3])) + ((v1[0] * v1[0] + v1[1] * v1[1]) + (v1[2] * v1[2] + v1[3] * v1[3])); }
                    ss += __shfl_xor(ss, 16); ss += __shfl_xor(ss, 32);
                    if (fq == 0) P[(ai * HALF + wr * 64 + m * 16 + fr) * 4 + wc] = ss; }
            }
        }
        asm volatile("s_waitcnt lgkmcnt(0)" ::: "memory"); __builtin_amdgcn_s_barrier(); asm volatile("" ::: "memory");
        const int prow = wid * 32 + (lane & 31);
        if (lane < 32) { const float t = (P[prow * 4 + 0] + P[prow * 4 + 1]) + (P[prow * 4 + 2] + P[prow * 4 + 3]);
            __hip_atomic_store(xch + (size_t)(u.pm * BM + prow) * 8 + u.pn, __float_as_uint(t), __ATOMIC_RELAXED, __HIP_MEMORY_SCOPE_AGENT); }
        asm volatile("s_waitcnt vmcnt(0)" ::: "memory");
        if (lane == 0) __hip_atomic_fetch_add(cnt + 64 * u.pm, 1u, __ATOMIC_RELAXED, __HIP_MEMORY_SCOPE_AGENT);
        if (wid == 0) { unsigned sp = 0;
            while ((unsigned)__builtin_amdgcn_readfirstlane(__hip_atomic_load(cnt + 64 * u.pm, __ATOMIC_RELAXED, __HIP_MEMORY_SCOPE_AGENT)) < want && ++sp < (1u << 20)) __builtin_amdgcn_s_sleep(2);
            __builtin_amdgcn_fence(__ATOMIC_ACQUIRE, "agent"); }
        asm volatile("s_waitcnt vmcnt(0) lgkmcnt(0)" ::: "memory"); __builtin_amdgcn_s_barrier(); asm volatile("" ::: "memory");
        if (lane < 32) { const unsigned* sl = xch + (size_t)(u.pm * BM + prow) * 8; float tot = 0.f;
#pragma unroll
            for (int t = 0; t < 8; ++t) tot += __uint_as_float(__hip_atomic_load(sl + t, __ATOMIC_RELAXED, __HIP_MEMORY_SCOPE_AGENT));
            S[prow] = rsqrtf(tot * (1.f / D) + EPS); }
        asm volatile("s_waitcnt vmcnt(0) lgkmcnt(0)" ::: "memory"); __builtin_amdgcn_s_barrier(); asm volatile("" ::: "memory");
        f32x4 gg[2][2], hh[2][2];
#pragma unroll
        for (int bj = 0; bj < 2; ++bj)
#pragma unroll
            for (int n = 0; n < 2; ++n) { gg[bj][n] = *(const f32x4*)(ng + col0 + bj * 32 + n * 4);
                if (!FINAL) { gg[bj][n] = gg[bj][n] * (*(const f32x4*)(sc + col0 + bj * 32 + n * 4) + 1.f); hh[bj][n] = *(const f32x4*)(sh + col0 + bj * 32 + n * 4); } }
#pragma unroll
        for (int ai = 0; ai < 2; ++ai)
#pragma unroll
            for (int m = 0; m < 4; ++m) { const float r = S[ai * HALF + wr * 64 + m * 16 + fr]; const size_t ro = (size_t)(row0 + ai * HALF + m * 16);
#pragma unroll
                for (int bj = 0; bj < 2; ++bj) {
                    if (FINAL) { float* op = out + (ro - CTX) * D + col0 + bj * 32; *(f32x4*)op = acc[ai][bj][m][0] * r * gg[bj][0]; *(f32x4*)(op + 4) = acc[ai][bj][m][1] * r * gg[bj][1]; }
                    else { const f32x4 a = acc[ai][bj][m][0] * r * gg[bj][0] + hh[bj][0], b = acc[ai][bj][m][1] * r * gg[bj][1] + hh[bj][1]; u32x4 w;
                        w.x = cvt_pk_bf16(a[0], a[1]); w.y = cvt_pk_bf16(a[2], a[3]); w.z = cvt_pk_bf16(b[0], b[1]); w.w = cvt_pk_bf16(b[2], b[3]);
                        *(u32x4*)(H + ro * D + col0 + bj * 32) = w; } } }
    }
};
struct EpiRelu2 {            P2(2)
    static constexpr bool PERM = true, KEEP = false;
    bf16* O;
    __device__ __forceinline__ bool keep(const Unit&) const { return false; }
    __device__ __forceinline__ void operator()(f32x4 (&acc)[2][2][4][2], const Unit& u, int wr, int wc, int fr, int fq) const {
        const int row0 = u.pm * BM + wr * 64 + fr, col0 = u.pn * BM + wc * 64 + 8 * fq;
#pragma unroll
        for (int ai = 0; ai < 2; ++ai)
#pragma unroll
            for (int m = 0; m < 4; ++m) { bf16* rowp = O + (size_t)(row0 + ai * HALF + m * 16) * DFF + col0;
#pragma unroll
                for (int bj = 0; bj < 2; ++bj) { f32x4 a = acc[ai][bj][m][0], b = acc[ai][bj][m][1];
#pragma unroll
                    for (int j = 0; j < 4; ++j) { const float x = fmaxf(a[j], 0.f), y = fmaxf(b[j], 0.f); a[j] = x * x; b[j] = y * y; }
                    u32x4 w; w.x = cvt_pk_bf16(a[0], a[1]); w.y = cvt_pk_bf16(a[2], a[3]); w.z = cvt_pk_bf16(b[0], b[1]); w.w = cvt_pk_bf16(b[2], b[3]);
                    *(u32x4*)(rowp + bj * 32) = w; } }
    }
};

__device__ __forceinline__ int rope_src_col(int nv) {
    if (nv >= 2048) return nv;
    const int v = nv & 127, wc = v >> 5, fq = (v >> 3) & 3, n = (v >> 2) & 1, j = v & 3;
    return (nv & ~127) + 64 * (wc >> 1) + 16 * (wc & 1) + 4 * fq + j + 32 * n;
}
__device__ __forceinline__ void p0_transpose_item(const float* W, int N, bf16* WT, int ld, int koff, bool ropeperm, LAS float* scr, int item, int lane) {
    const int nblk = N / 32, kb = item / nblk, nb = item % nblk, k0 = 64 * kb, n0 = 32 * nb;
    const int nsrc = ropeperm ? rope_src_col(n0 + (lane & 31)) : n0 + (lane & 31);
#pragma unroll 8
    for (int i = 0; i < 32; ++i) { const int kk = 2 * i + (lane >> 5); scr[kk * 33 + (lane & 31)] = W[(size_t)(k0 + kk) * N + nsrc]; }
    LDS_WAIT(); asm volatile("" ::: "memory");
    const int c = lane & 7;
#pragma unroll
    for (int j = 0; j < 4; ++j) { const int n = (lane >> 3) + 8 * j; const LAS float* s = scr + (8 * c) * 33 + n;
        u32x4 o; o.x = pk2(s[0 * 33], s[1 * 33]); o.y = pk2(s[2 * 33], s[3 * 33]); o.z = pk2(s[4 * 33], s[5 * 33]); o.w = pk2(s[6 * 33], s[7 * 33]);
        *(u32x4*)(WT + (size_t)(n0 + n) * ld + koff + k0 + 8 * c) = o; }
    LDS_WAIT(); asm volatile("" ::: "memory");
}
__device__ __forceinline__ void p0_prologue(Frame& F) {
    const float* const __attribute__((address_space(4)))* in = F.in;
    const int gw = F.bid * 8 + F.wave, NGW = F.G * 8, lane = F.lane;
    const int gt = F.bid * 512 + F.tid, NGT = F.G * 512;
    {
        float* MOD = (float*)(F.ws + WS_MODP);
        constexpr int NJB = 6 * D / 256, NKQ = 16, KS = D / NKQ;
        for (int it = gw; it < DEPTH * NJB * NKQ; it += NGW) {
            const int l = it / (NJB * NKQ), r = it % (NJB * NKQ), jb = r / NKQ, kq = r % NKQ;
            const float* W = in[I_WADA] + ((size_t)l * D + kq * KS) * 6 * D + jb * 256 + lane * 4;
            f32x4 a0 = (f32x4){0.f, 0.f, 0.f, 0.f}, a1 = a0;
#pragma unroll 16
            for (int k = 0; k < KS; ++k) { const f32x4 w = *(const f32x4*)(W + (size_t)k * 6 * D); const float s0 = silu_f(in[I_CCTX][kq * KS + k]), s1 = silu_f(in[I_C][kq * KS + k]); a0 += w * s0; a1 += w * s1; }
            if (kq == 0) { const f32x4 b = *(const f32x4*)(in[I_BADA] + (size_t)l * 6 * D + jb * 256 + lane * 4); a0 += b; a1 += b; }
            float* o0 = MOD + (size_t)kq * (DEPTH * 2 * 6 * D) + ((size_t)l * 2 + 0) * 6 * D + jb * 256 + lane * 4;
            *(f32x4*)o0 = a0; *(f32x4*)(o0 + 6 * D) = a1;
        }
    }
    {
        LAS float* scr = (LAS float*)(F.lds + F.wave * 16640);
        constexpr int I_IN = (D / 64) * (N_IN / 64), I_BR = (RET_W / 64) * (D / 64), I_BP = (POOL_W / 64) * (D / 64), I_SQ = (D / 64) * (D / 64), I_F1 = (D / 64) * (DFF / 64), I_F2 = (DFF / 64) * (D / 64);
        constexpr int PER_L = I_IN + I_BR + 2 * I_BP + I_SQ + I_F1 + I_F2, TOTAL = DEPTH * PER_L;
        static_assert(8 * 16640 <= SCR_BYTES, "transposer LDS");
        unsigned char* ws = F.ws;
        auto decode = [&](int it, const float*& src, bf16*& dst, int& N, int& ld) {
            const int l = it / PER_L; int r = it % PER_L; const float* W; bf16* WT; int koff = 0, kb, nb;
            if (r < I_IN) { W = in[I_WIN] + (size_t)l * D * N_IN; N = N_IN; WT = (bf16*)(ws + WS_WIN + l * SZ_WIN); ld = D; kb = r / (N_IN / 64); nb = r % (N_IN / 64); }
            else if ((r -= I_IN) < I_BR) { W = in[I_WBR] + (size_t)l * RET_W * D; N = D; WT = (bf16*)(ws + WS_WCAT + l * SZ_WSQ); ld = D; kb = r / (D / 64); nb = r % (D / 64); }
            else if ((r -= I_BR) < I_BP) { W = in[I_WBP] + (size_t)l * POOL_W * D; N = D; WT = (bf16*)(ws + WS_WCAT + l * SZ_WSQ); ld = D; koff = RET_W; kb = r / (D / 64); nb = r % (D / 64); }
            else if ((r -= I_BP) < I_BP) { W = in[I_WBS] + (size_t)l * SG_W * D; N = D; WT = (bf16*)(ws + WS_WCAT + l * SZ_WSQ); ld = D; koff = RET_W + POOL_W; kb = r / (D / 64); nb = r % (D / 64); }
            else if ((r -= I_BP) < I_SQ) { W = in[I_WOUT] + (size_t)l * D * D; N = D; WT = (bf16*)(ws + WS_WOUT + l * SZ_WSQ); ld = D; kb = r / (D / 64); nb = r % (D / 64); }
            else if ((r -= I_SQ) < I_F1) { W = in[I_W1] + (size_t)l * D * DFF; N = DFF; WT = (bf16*)(ws + WS_W1 + l * SZ_WFF); ld = D; kb = r / (DFF / 64); nb = r % (DFF / 64); }
            else { r -= I_F1; W = in[I_W2] + (size_t)l * DFF * D; N = D; WT = (bf16*)(ws + WS_W2 + l * SZ_WFF); ld = DFF; kb = r / (D / 64); nb = r % (D / 64); }
            const int k0 = 64 * kb, n0 = 64 * nb;
            src = W + (size_t)k0 * N + n0;
            dst = WT + (size_t)n0 * ld + koff + k0;
        };
#define P0_LOAD(buf, srcu, Nu) do { const unsigned loff_ = (unsigned)(((lane >> 5) * (Nu) + 2 * (lane & 31)) * 4); \
            _Pragma("unroll") for (int i = 0; i < 32; ++i) buf[i] = *(const f32x2*)((const char*)((srcu) + (size_t)(2 * i) * (Nu)) + loff_); } while (0)
        f32x2 bufA[32], bufB[32];
        const float* sA; bf16* dA; int NA, ldA; const float* sB; bf16* dB; int NB, ldB;
        auto process = [&](f32x2 (&buf)[32], bf16* dst, int ld) {
#pragma unroll
            for (int i = 0; i < 32; ++i) { LAS float* q = scr + (2 * i + (lane >> 5)) * 65 + 2 * (lane & 31); q[0] = buf[i][0]; q[1] = buf[i][1]; }
            LDS_WAIT(); asm volatile("" ::: "memory");
            const int c = lane & 7;
#pragma unroll
            for (int j = 0; j < 8; ++j) { const int n = (lane >> 3) + 8 * j; const LAS float* p = scr + (8 * c) * 65 + n;
                u32x4 o; o.x = pk2(p[0 * 65], p[1 * 65]); o.y = pk2(p[2 * 65], p[3 * 65]); o.z = pk2(p[4 * 65], p[5 * 65]); o.w = pk2(p[6 * 65], p[7 * 65]);
                *(u32x4*)(dst + (size_t)n * ld + 8 * c) = o; }
            LDS_WAIT(); asm volatile("" ::: "memory");
        };
        int it = gw;
        if (it < TOTAL) {
            decode(it, sA, dA, NA, ldA);
            P0_LOAD(bufA, sA, NA);
            for (;;) {
                const int i1 = it + NGW;
                decode(i1 < TOTAL ? i1 : it, sB, dB, NB, ldB);
                P0_LOAD(bufB, sB, NB);
                process(bufA, dA, ldA);
                if (i1 >= TOTAL) break;
                const int i2 = i1 + NGW;
                decode(i2 < TOTAL ? i2 : i1, sA, dA, NA, ldA);
                P0_LOAD(bufA, sA, NA);
                process(bufB, dB, ldB);
                if (i2 >= TOTAL) break;
                it = i2;
            }
        }
#undef P0_LOAD
    }
    {
        bf16* PWT = (bf16*)(F.ws + WS_PWT); bf16* SGW = (bf16*)(F.ws + WS_SGW); float* ROPE = (float*)(F.ws + WS_ROPE);
        for (int i = gt; i < DEPTH * 4 * 128 * 128; i += NGT) {
            const int lg = i >> 14, d = (i >> 7) & 127, c = i & 127;
            PWT[i] = (bf16)f2bf(in[I_PW][(size_t)lg * 16384 + c * 128 + d]);
            SGW[i] = (bf16)f2bf(in[I_SGW][i]);
        }
        for (int i = gt; i < 128 * 32; i += NGT) { const int pos = i >> 5, f = i & 31; const float inv = powf(10000.f, -(float)f / 32.f); const float ang = (float)pos * inv; ROPE[2 * i] = cosf(ang); ROPE[2 * i + 1] = sinf(ang); }
    }
}

__device__ __forceinline__ void mod_reduce_phase(Frame& F) {
    const float* P = (const float*)(F.ws + WS_MODP); float* MOD = (float*)(F.ws + WS_MOD);
    for (int i = F.bid * 512 + F.tid; i < DEPTH * 2 * 6 * D; i += F.G * 512) { float s = 0.f;
#pragma unroll
        for (int k = 0; k < 16; ++k) s += P[(size_t)k * (DEPTH * 2 * 6 * D) + i];
        MOD[i] = s; }
}
__device__ __forceinline__ void norm_phase(Frame& F, const float* g, const float* modl, int si, bool first, const float* slab_gate = nullptr) {
    bf16* X = (bf16*)(F.ws + WS_X); bf16* H = (bf16*)(F.ws + WS_H);
    const int gw = F.bid * 8 + F.wave, NGW = F.G * 8, lane = F.lane;
    if (slab_gate) {
        LAS float* red = (LAS float*)F.lds;
        for (int row = F.bid; row < CTX; row += F.G) {
            const int c = 256 * F.wave + 4 * lane;
            const float* SL = (const float*)(F.ws + WS_SLAB) + (size_t)row * D + c;
            f32x4 sm = *(const f32x4*)SL;
#pragma unroll
            for (int k = 1; k < 4; ++k) sm += *(const f32x4*)(SL + (size_t)k * CTX * D);
            const u32x2 xo = *(const u32x2*)(X + (size_t)row * D + c); const f32x4 gt = *(const f32x4*)(slab_gate + c);
            u32x2 xn; xn.x = cvt_pk_bf16(bflo(xo.x) + gt[0] * sm[0], bfhi(xo.x) + gt[1] * sm[1]); xn.y = cvt_pk_bf16(bflo(xo.y) + gt[2] * sm[2], bfhi(xo.y) + gt[3] * sm[3]);
            *(u32x2*)(X + (size_t)row * D + c) = xn;
            const float v0 = bflo(xn.x), v1 = bfhi(xn.x), v2 = bflo(xn.y), v3 = bfhi(xn.y);
            const float ps = wave_sum((v0 * v0 + v1 * v1) + (v2 * v2 + v3 * v3));
            __syncthreads();
            if (lane == 0) red[F.wave] = ps;
            __syncthreads();
            float tot = 0.f;
#pragma unroll
            for (int k = 0; k < 8; ++k) tot += red[k];
            const float r = rsqrtf(tot * (1.f / D) + EPS);
            const f32x4 gg = *(const f32x4*)(g + c), sc = *(const f32x4*)(modl + (si + 1) * D + c), sh = *(const f32x4*)(modl + si * D + c);
            u32x2 w; w.x = cvt_pk_bf16(v0 * r * gg[0] * (sc[0] + 1.f) + sh[0], v1 * r * gg[1] * (sc[1] + 1.f) + sh[1]); w.y = cvt_pk_bf16(v2 * r * gg[2] * (sc[2] + 1.f) + sh[2], v3 * r * gg[3] * (sc[3] + 1.f) + sh[3]);
            *(u32x2*)(H + (size_t)row * D + c) = w;
        }
    }
    if (!first) {
        int row = slab_gate ? CTX + gw : gw;
        u32x4 cur[4], nxt[4];
        if (row < MROWS) {
#pragma unroll
            for (int j = 0; j < 4; ++j) cur[j] = *(const u32x4*)(X + (size_t)row * D + j * 512 + lane * 8);
        }
        while (row < MROWS) {
            const int nrow = row + NGW;
            if (nrow < MROWS) {
#pragma unroll
                for (int j = 0; j < 4; ++j) nxt[j] = *(const u32x4*)(X + (size_t)nrow * D + j * 512 + lane * 8);
            }
            float v[32]; float s = 0.f;
#pragma unroll
            for (int j = 0; j < 4; ++j)
#pragma unroll
                for (int e = 0; e < 4; ++e) { v[8 * j + 2 * e] = bflo(cur[j][e]); v[8 * j + 2 * e + 1] = bfhi(cur[j][e]); }
#pragma unroll
            for (int e = 0; e < 32; ++e) s += v[e] * v[e];
            const float r = rsqrtf(wave_sum(s) * (1.f / D) + EPS);
            const float* m = modl + (size_t)(row < CTX ? 0 : 1) * 6 * D;
#pragma unroll
            for (int j = 0; j < 4; ++j) { const int c = j * 512 + lane * 8; float o[8];
#pragma unroll
                for (int h = 0; h < 2; ++h) { const f32x4 gg = *(const f32x4*)(g + c + 4 * h), sc = *(const f32x4*)(m + (si + 1) * D + c + 4 * h), sh = *(const f32x4*)(m + si * D + c + 4 * h);
#pragma unroll
                    for (int e = 0; e < 4; ++e) o[4 * h + e] = v[8 * j + 4 * h + e] * r * gg[e] * (sc[e] + 1.f) + sh[e]; }
                u32x4 w; w.x = cvt_pk_bf16(o[0], o[1]); w.y = cvt_pk_bf16(o[2], o[3]); w.z = cvt_pk_bf16(o[4], o[5]); w.w = cvt_pk_bf16(o[6], o[7]);
                *(u32x4*)(H + (size_t)row * D + c) = w; }
#pragma unroll
            for (int j = 0; j < 4; ++j) cur[j] = nxt[j];
            row = nrow;
        }
        return;
    }
    for (int row = slab_gate ? CTX + gw : gw; row < MROWS; row += NGW) {
        float v[32]; float s = 0.f;
        if (first) {
            const float* src = row < CTX ? F.in[I_CTX] + (size_t)row * D : F.in[I_X] + (size_t)(row - CTX) * D;
#pragma unroll
            for (int j = 0; j < 4; ++j) { const f32x4 a = *(const f32x4*)(src + j * 512 + lane * 8), b = *(const f32x4*)(src + j * 512 + lane * 8 + 4);
#pragma unroll
                for (int e = 0; e < 4; ++e) { v[8 * j + e] = a[e]; v[8 * j + 4 + e] = b[e]; }
                u32x4 w; w.x = cvt_pk_bf16(a[0], a[1]); w.y = cvt_pk_bf16(a[2], a[3]); w.z = cvt_pk_bf16(b[0], b[1]); w.w = cvt_pk_bf16(b[2], b[3]);
                *(u32x4*)(X + (size_t)row * D + j * 512 + lane * 8) = w; }
        } else {
#pragma unroll
            for (int j = 0; j < 4; ++j) { const u32x4 x = *(const u32x4*)(X + (size_t)row * D + j * 512 + lane * 8);
#pragma unroll
                for (int e = 0; e < 4; ++e) { v[8 * j + 2 * e] = bflo(x[e]); v[8 * j + 2 * e + 1] = bfhi(x[e]); } }
        }
#pragma unroll
        for (int e = 0; e < 32; ++e) s += v[e] * v[e];
        const float r = rsqrtf(wave_sum(s) * (1.f / D) + EPS);
        const float* m = modl + (size_t)(row < CTX ? 0 : 1) * 6 * D;
#pragma unroll
        for (int j = 0; j < 4; ++j) { const int c = j * 512 + lane * 8; float o[8];
#pragma unroll
            for (int h = 0; h < 2; ++h) { const f32x4 gg = *(const f32x4*)(g + c + 4 * h), sc = *(const f32x4*)(m + (si + 1) * D + c + 4 * h), sh = *(const f32x4*)(m + si * D + c + 4 * h);
#pragma unroll
                for (int e = 0; e < 4; ++e) o[4 * h + e] = v[8 * j + 4 * h + e] * r * gg[e] * (sc[e] + 1.f) + sh[e]; }
            u32x4 w; w.x = cvt_pk_bf16(o[0], o[1]); w.y = cvt_pk_bf16(o[2], o[3]); w.z = cvt_pk_bf16(o[4], o[5]); w.w = cvt_pk_bf16(o[6], o[7]);
            *(u32x4*)(H + (size_t)row * D + c) = w; }
    }
}
#ifndef FUSE_FINAL
#define FUSE_FINAL 1
#endif
__device__ __forceinline__ void final_norm_phase(Frame& F, float* out) {
    if (FUSE_FINAL) return;
    const bf16* X = (const bf16*)(F.ws + WS_X); const float* g = F.in[I_FNG];
    const int gw = F.bid * 8 + F.wave, NGW = F.G * 8, lane = F.lane;
    u32x4 cur[4], nxt[4];
    if (gw < SEQ) {
#pragma unroll
        for (int j = 0; j < 4; ++j) cur[j] = *(const u32x4*)(X + (size_t)(gw + CTX) * D + j * 512 + lane * 8);
    }
    for (int row = gw; row < SEQ; row += NGW) {
        if (row + NGW < SEQ) {
#pragma unroll
            for (int j = 0; j < 4; ++j) nxt[j] = *(const u32x4*)(X + (size_t)(row + NGW + CTX) * D + j * 512 + lane * 8);
        }
        float v[32]; float s = 0.f;
#pragma unroll
        for (int j = 0; j < 4; ++j) { const u32x4 x = cur[j];
#pragma unroll
            for (int e = 0; e < 4; ++e) { v[8 * j + 2 * e] = bflo(x[e]); v[8 * j + 2 * e + 1] = bfhi(x[e]); } }
#pragma unroll
        for (int e = 0; e < 32; ++e) s += v[e] * v[e];
        const float r = rsqrtf(wave_sum(s) * (1.f / D) + EPS);
#pragma unroll
        for (int j = 0; j < 4; ++j) { const int c = j * 512 + lane * 8;
#pragma unroll
            for (int h = 0; h < 2; ++h) { const f32x4 gg = *(const f32x4*)(g + c + 4 * h); f32x4 o;
#pragma unroll
                for (int e = 0; e < 4; ++e) o[e] = v[8 * j + 4 * h + e] * r * gg[e];
                *(f32x4*)(out + (size_t)row * D + c + 4 * h) = o; } }
#pragma unroll
        for (int j = 0; j < 4; ++j) cur[j] = nxt[j];
    }
}

#define MFMA16(a, b, c) __builtin_amdgcn_mfma_f32_16x16x32_bf16((a), (b), (c), 0, 0, 0)
template <bool TWO>
__device__ __forceinline__ void fill_transposed(LAS unsigned char* T0, LAS unsigned char* T1, const bf16* src, size_t ld, int tid, float sc0, float sc1, bool scaled) {
    const int s = tid & 127, dq = tid >> 7;
    const bf16* rp = src + (size_t)s * ld + 32 * dq;
    u32x4 v[4];
#pragma unroll
    for (int kk = 0; kk < 4; ++kk) v[kk] = *(const u32x4*)(rp + 8 * kk);
#pragma unroll
    for (int kk = 0; kk < 4; ++kk)
#pragma unroll
        for (int q = 0; q < 4; ++q) {
            const int d = 32 * dq + 8 * kk + 2 * q; const unsigned w = v[kk][q];
            if (scaled) { const float lo = bflo(w), hi = bfhi(w);
                *(LAS bf16*)(T0 + d * TP + s * 2) = (bf16)f2bf(lo * sc0); *(LAS bf16*)(T0 + (d + 1) * TP + s * 2) = (bf16)f2bf(hi * sc0);
                if (TWO) { *(LAS bf16*)(T1 + d * TP + s * 2) = (bf16)f2bf(lo * sc1); *(LAS bf16*)(T1 + (d + 1) * TP + s * 2) = (bf16)f2bf(hi * sc1); } }
            else { *(LAS bf16*)(T0 + d * TP + s * 2) = (bf16)(w & 0xffffu); *(LAS bf16*)(T0 + (d + 1) * TP + s * 2) = (bf16)(w >> 16); }
        }
}
__device__ __forceinline__ void fill_rows(LAS unsigned char* T, const bf16* src, size_t ld, int tid) {
    const int r = tid >> 4, sg = tid & 15;
    const bf16* rp = src + (size_t)r * ld + sg * 8;
    u32x4 v[4];
#pragma unroll
    for (int q = 0; q < 4; ++q) v[q] = *(const u32x4*)(rp + (size_t)(32 * q) * ld);
#pragma unroll
    for (int q = 0; q < 4; ++q) *(LAS u32x4*)(T + (r + 32 * q) * TP + sg * 16) = v[q];
}

typedef short s16x4 __attribute__((ext_vector_type(4)));
__device__ __forceinline__ bf16x8 tr_frag(const LAS unsigned char* T, int rowa, int rowb, int col0, int lane) {
    const int i = lane & 15;
    const LAS unsigned char* pa = T + (rowa + (i >> 2)) * TP + (col0 + 4 * (i & 3)) * 2;
    const LAS unsigned char* pb = T + (rowb + (i >> 2)) * TP + (col0 + 4 * (i & 3)) * 2;
    const s16x4 lo = __builtin_amdgcn_ds_read_tr16_b64_v4i16((LAS s16x4*)pa), hi = __builtin_amdgcn_ds_read_tr16_b64_v4i16((LAS s16x4*)pb);
    return (bf16x8){lo[0], lo[1], lo[2], lo[3], hi[0], hi[1], hi[2], hi[3]};
}
__device__ __forceinline__ void kv_item(Frame& F, int l, int c, int h) {
    LAS unsigned char* Kt = F.lds; LAS unsigned char* Vt = F.lds + TILE_B;
    const bf16* ZB = (const bf16*)(F.ws + WS_ZB) + (size_t)c * 128 * N_IN;
    const float* lg = F.in[I_RLOG] + (size_t)l * 2 * RET_H;
    const float l2f = log_sigmoid_f(lg[h]) * LOG2E, l2b = log_sigmoid_f(lg[RET_H + h]) * LOG2E;
    fill_rows(Kt, ZB + C_K + h * HD, N_IN, F.tid);
    fill_rows(Vt, ZB + C_V + h * HD, N_IN, F.tid);
    __syncthreads();
    const int w = F.wave, fr = F.lane & 15, fq = F.lane >> 4;
    bf16x8 vf[4], vb[4];
    float gpf[8], gpb[8];
    { const float gf = exp2f(l2f), gb = exp2f(l2b); gpf[0] = 1.f; gpb[0] = 1.f;
#pragma unroll
      for (int k = 1; k < 8; ++k) { gpf[k] = gpf[k - 1] * gf; gpb[k] = gpb[k - 1] * gb; } }
#pragma unroll
    for (int t = 0; t < 4; ++t) {
        const bf16x8 raw = tr_frag(Vt, 32 * t + 8 * fq, 32 * t + 8 * fq + 4, 16 * w, F.lane);
        const u32x4 rw = __builtin_bit_cast(u32x4, raw); u32x4 pf, pb;
        const int sg0 = 32 * t + 8 * fq;
        const float wf7 = exp2f(l2f * (float)(120 - sg0)), wb0 = exp2f(l2b * (float)sg0);
#pragma unroll
        for (int q = 0; q < 4; ++q) { const float lo = bflo(rw[q]), hi = bfhi(rw[q]);
            pf[q] = cvt_pk_bf16(lo * (wf7 * gpf[7 - 2 * q]), hi * (wf7 * gpf[6 - 2 * q]));
            pb[q] = cvt_pk_bf16(lo * (wb0 * gpb[2 * q]), hi * (wb0 * gpb[2 * q + 1])); }
        vf[t] = __builtin_bit_cast(bf16x8, pf); vb[t] = __builtin_bit_cast(bf16x8, pb);
    }
    bf16* KVT = (bf16*)(F.ws + WS_KVT) + (((size_t)c * RET_H + h) * 2) * 16384 + (size_t)(16 * w + fr) * 128 + 4 * fq;
#pragma unroll
    for (int db = 0; db < 8; ++db) {
        f32x4 af = (f32x4){0.f, 0.f, 0.f, 0.f}, ab = af;
#pragma unroll
        for (int t = 0; t < 4; ++t) {
            const bf16x8 kf = tr_frag(Kt, 32 * t + 8 * fq, 32 * t + 8 * fq + 4, 16 * db, F.lane);
            af = MFMA16(kf, vf[t], af); ab = MFMA16(kf, vb[t], ab);
        }
        u32x2 of, ob; of.x = pk2(af[0], af[1]); of.y = pk2(af[2], af[3]); ob.x = pk2(ab[0], ab[1]); ob.y = pk2(ab[2], ab[3]);
        *(u32x2*)(KVT + 16 * db) = of; *(u32x2*)(KVT + 16384 + 16 * db) = ob;
    }
    __syncthreads();
}
__device__ __forceinline__ void pool_item(Frame& F, int l, int c, int g) {
    LAS unsigned char* Pin = F.lds; LAS unsigned char* PWT = F.lds + 144 * TP; LAS unsigned char* Yl = PWT + TILE_B;
    const bf16* ZB = (const bf16*)(F.ws + WS_ZB);
    const int row0 = c * 128, tid = F.tid;
    for (int p = tid; p < 144 * 16; p += 512) { const int rr = p >> 4, sg = p & 15, grow = row0 - 8 + rr;
        if (grow >= 0 && grow < MROWS) *(LAS u32x4*)(Pin + rr * TP + sg * 16) = *(const u32x4*)(ZB + (size_t)grow * N_IN + C_P + g * 128 + sg * 8); }
    fill_rows(PWT, (const bf16*)(F.ws + WS_PWT) + (size_t)(l * 4 + g) * 16384, 128, tid);
    __syncthreads();
    {
        const int t = tid >> 2, cq = tid & 3, grow = row0 + t;
        int seg0, seglen, pos;
        if (grow < CTX) { seg0 = 0; seglen = CTX; pos = grow; } else { const int tok = grow - CTX; seg0 = CTX + (tok / GRID_W) * GRID_W; seglen = GRID_W; pos = tok % GRID_W; }
        const int w = 2 << g; int lo = pos - w / 2; if (lo < 0) lo = 0; int hi = pos + w / 2 - 1; if (hi > seglen - 1) hi = seglen - 1;
        const float inv = 1.f / (float)(hi - lo + 1);
        float sum[32];
#pragma unroll
        for (int j = 0; j < 32; ++j) sum[j] = 0.f;
        for (int p = lo; p <= hi; ++p) { const LAS unsigned char* rp = Pin + (seg0 + p - (row0 - 8)) * TP + cq * 64;
#pragma unroll
            for (int q = 0; q < 4; ++q) { const u32x4 v = *(const LAS u32x4*)(rp + q * 16);
#pragma unroll
                for (int e = 0; e < 4; ++e) { sum[q * 8 + 2 * e] += bflo(v[e]); sum[q * 8 + 2 * e + 1] += bfhi(v[e]); } } }
        const LAS unsigned char* sp = Pin + (t + 8) * TP + cq * 64;
#pragma unroll
        for (int q = 0; q < 4; ++q) { const u32x4 v = *(const LAS u32x4*)(sp + q * 16); u32x4 o;
#pragma unroll
            for (int e = 0; e < 4; ++e) o[e] = cvt_pk_bf16(sum[q * 8 + 2 * e] * inv - bflo(v[e]), sum[q * 8 + 2 * e + 1] * inv - bfhi(v[e]));
            *(LAS u32x4*)(Yl + t * TP + cq * 64 + q * 16) = o; }
    }
    __syncthreads();
    const int w = F.wave, fr = F.lane & 15, fq = F.lane >> 4;
    bf16x8 yb[4];
#pragma unroll
    for (int t = 0; t < 4; ++t) yb[t] = *(const LAS bf16x8*)(Yl + (16 * w + fr) * TP + (32 * t + 8 * fq) * 2);
    bf16* MIX = (bf16*)(F.ws + WS_MIX) + (size_t)(row0 + 16 * w + fr) * D + RET_W + g * 128 + 4 * fq;
    const float* ps = F.in[I_PS] + (size_t)l * POOL_W + g * 128 + 4 * fq;
    f32x4 scv[8];
#pragma unroll
    for (int db = 0; db < 8; ++db) scv[db] = *(const f32x4*)(ps + 16 * db);
#pragma unroll
    for (int db = 0; db < 8; ++db) {
        f32x4 a = (f32x4){0.f, 0.f, 0.f, 0.f};
#pragma unroll
        for (int t = 0; t < 4; ++t) a = MFMA16(*(const LAS bf16x8*)(PWT + (16 * db + fr) * TP + (32 * t + 8 * fq) * 2), yb[t], a);
        a = a * scv[db];
        u32x2 o; o.x = cvt_pk_bf16(a[0], a[1]); o.y = cvt_pk_bf16(a[2], a[3]);
        *(u32x2*)(MIX + 16 * db) = o;
    }
    __syncthreads();
}
__device__ __forceinline__ void sg_item(Frame& F, int l, int c, int g) {
    LAS unsigned char* VN = F.lds;
    const bf16* ZB = (const bf16*)(F.ws + WS_ZB) + (size_t)c * 128 * N_IN;
    const int tid = F.tid;
    {
        const int w0 = F.wave * 16, lane = F.lane;
        u32x4 rv[16];
#pragma unroll
        for (int i = 0; i < 16; ++i) rv[i] = *(const u32x4*)(ZB + (size_t)(w0 + i) * N_IN + C_SV + 8 * lane);
        const float* ng = F.in[I_SGNG] + (size_t)l * SG_W + 8 * lane;
        const f32x4 n0 = *(const f32x4*)ng, n1 = *(const f32x4*)(ng + 4);
        float ss[16];
#pragma unroll
        for (int i = 0; i < 16; ++i) { const u32x4 v = rv[i]; ss[i] = 0.f;
#pragma unroll
            for (int e = 0; e < 4; ++e) { const float a = bflo(v[e]), b = bfhi(v[e]); ss[i] += a * a + b * b; } }
#pragma unroll
        for (int o = 1; o < 64; o <<= 1)
#pragma unroll
            for (int i = 0; i < 16; ++i) ss[i] += __shfl_xor(ss[i], o);
        if ((lane >> 4) == g) {
#pragma unroll
            for (int i = 0; i < 16; ++i) { const u32x4 v = rv[i]; const float r = rsqrtf(ss[i] * (1.f / SG_W) + EPS); u32x4 o;
                o.x = cvt_pk_bf16(bflo(v.x) * r * n0[0], bfhi(v.x) * r * n0[1]); o.y = cvt_pk_bf16(bflo(v.y) * r * n0[2], bfhi(v.y) * r * n0[3]);
                o.z = cvt_pk_bf16(bflo(v.z) * r * n1[0], bfhi(v.z) * r * n1[1]); o.w = cvt_pk_bf16(bflo(v.w) * r * n1[2], bfhi(v.w) * r * n1[3]);
                *(LAS u32x4*)(VN + (w0 + i) * TP + (lane & 15) * 16) = o; }
        }
    }
    __syncthreads();
    const int w = F.wave, fr = F.lane & 15, fq = F.lane >> 4;
    const bf16* SGW = (const bf16*)(F.ws + WS_SGW) + ((size_t)(l * 4 + g) * 128 + 16 * w + fr) * 128;
    bf16x8 wf[4];
#pragma unroll
    for (int t = 0; t < 4; ++t) wf[t] = *(const bf16x8*)(SGW + 32 * t + 8 * fq);
    const float bias = F.in[I_SGB][(size_t)(l * 4 + g) * 128 + 16 * w + fr];
    const bf16* U = ZB + (size_t)(16 * w + fr) * N_IN + C_U + g * 128 + 4 * fq;
    u32x2 uvv[8];
#pragma unroll
    for (int cb = 0; cb < 8; ++cb) uvv[cb] = *(const u32x2*)(U + 16 * cb);
    bf16* MIX = (bf16*)(F.ws + WS_MIX) + (size_t)(c * 128 + 16 * w + fr) * D + RET_W + POOL_W + g * 128 + 4 * fq;
#pragma unroll
    for (int cb = 0; cb < 8; ++cb) {
        f32x4 a = (f32x4){0.f, 0.f, 0.f, 0.f};
#pragma unroll
        for (int t = 0; t < 4; ++t) a = MFMA16(tr_frag(VN, 32 * t + 8 * fq, 32 * t + 8 * fq + 4, 16 * cb, F.lane), wf[t], a);
        const u32x2 uv = uvv[cb];
        u32x2 o; o.x = cvt_pk_bf16((a[0] + bias) * bflo(uv.x), (a[1] + bias) * bfhi(uv.x)); o.y = cvt_pk_bf16((a[2] + bias) * bflo(uv.y), (a[3] + bias) * bfhi(uv.y));
        *(u32x2*)(MIX + 16 * cb) = o;
    }
    __syncthreads();
}
__device__ __forceinline__ void scan_phase(Frame& F, int l, int nskip) {
    const bf16* KVT = (const bf16*)(F.ws + WS_KVT); bf16* ST = (bf16*)(F.ws + WS_ST);
    const float* lg = F.in[I_RLOG] + (size_t)l * 2 * RET_H;
    if (F.bid < nskip) return;
    const int nw = F.G - nskip, per = (65536 + nw - 1) / nw, p = (F.bid - nskip) * per + F.tid;
    if (F.tid < per && p < 65536) {
        const int hd = p >> 12, h = hd >> 1, dir = hd & 1;
        const float g128 = expf(128.f * log_sigmoid_f(lg[dir * RET_H + h]));
        const size_t e0 = (size_t)p * 4;
        u32x2 kvw[NCHUNK];
#pragma unroll
        for (int c = 0; c < NCHUNK; ++c) kvw[c] = *(const u32x2*)(KVT + (size_t)c * 262144 + e0);
        f32x4 S = (f32x4){0.f, 0.f, 0.f, 0.f};
        if (dir == 0) {
#pragma unroll
            for (int c = 0; c < NCHUNK; ++c) { u32x2 o; o.x = cvt_pk_bf16(S[0], S[1]); o.y = cvt_pk_bf16(S[2], S[3]); *(u32x2*)(ST + (size_t)c * 262144 + e0) = o;
                S = S * g128 + (f32x4){bflo(kvw[c].x), bfhi(kvw[c].x), bflo(kvw[c].y), bfhi(kvw[c].y)}; }
        } else {
#pragma unroll
            for (int i = 0; i < NCHUNK; ++i) { const int c = i < 2 ? 1 - i : NCHUNK + 1 - i; u32x2 o; o.x = cvt_pk_bf16(S[0], S[1]); o.y = cvt_pk_bf16(S[2], S[3]); *(u32x2*)(ST + (size_t)c * 262144 + e0) = o;
                S = S * g128 + (f32x4){bflo(kvw[c].x), bfhi(kvw[c].x), bflo(kvw[c].y), bfhi(kvw[c].y)}; }
        }
    }
}
__device__ __forceinline__ void fill_rows_f32(LAS unsigned char* T, const float* src, int tid) {
    const int r = tid >> 2, sg = tid & 3;
#pragma unroll
    for (int q = 0; q < 4; ++q) { unsigned z = 0u; asm volatile("" : "+v"(z));
        u32x4 w = (u32x4){z, z, z, z};
        if (src) { const f32x4 a = *(const f32x4*)(src + (size_t)r * 128 + sg * 32 + q * 8), b = *(const f32x4*)(src + (size_t)r * 128 + sg * 32 + q * 8 + 4);
            w.x = cvt_pk_bf16(a[0], a[1]); w.y = cvt_pk_bf16(a[2], a[3]); w.z = cvt_pk_bf16(b[0], b[1]); w.w = cvt_pk_bf16(b[2], b[3]); }
        *(LAS u32x4*)(T + r * TP + sg * 64 + q * 16) = w; }
}
template <bool CTXSRC>
__device__ __forceinline__ void ret_item(Frame& F, int l, int c, int h) {
    LAS unsigned char* Kt = F.lds; LAS unsigned char* VT = F.lds + TILE_B; LAS unsigned char* SF = F.lds + 2 * TILE_B; LAS unsigned char* SB = F.lds + 3 * TILE_B;
    const bf16* ZB = (const bf16*)(F.ws + WS_ZB) + (size_t)c * 128 * N_IN;
    const bf16* ST = (const bf16*)(F.ws + WS_ST) + (((size_t)c * RET_H + h) * 2) * 16384;
    const float* lg = F.in[I_RLOG] + (size_t)l * 2 * RET_H;
    const float l2f = log_sigmoid_f(lg[h]) * LOG2E, l2b = log_sigmoid_f(lg[RET_H + h]) * LOG2E;
    const int tid = F.tid, w = F.wave, fr = F.lane & 15, fq = F.lane >> 4;
    fill_rows(Kt, ZB + C_K + h * HD, N_IN, tid);
    if (CTXSRC) {
        const bf16* KV = (const bf16*)(F.ws + WS_KVT) + (((size_t)(1 - c) * RET_H + h) * 2) * 16384;
        if (c == 1) fill_rows(SF, KV, 128, tid); else fill_rows_f32(SF, nullptr, tid);
        if (c == 0) fill_rows(SB, KV + 16384, 128, tid); else fill_rows_f32(SB, nullptr, tid);
    } else {
        fill_rows(SF, ST, 128, tid);
        fill_rows(SB, ST + 16384, 128, tid);
    }
    fill_rows(VT, ZB + C_V + h * HD, N_IN, tid);
    bf16x8 qf[4];
    { const bf16* qp = ZB + (size_t)(16 * w + fr) * N_IN + C_Q + h * HD + 8 * fq;
#pragma unroll
      for (int t = 0; t < 4; ++t) qf[t] = *(const bf16x8*)(qp + 32 * t); }
    const int i = 16 * w + fr;
    u32x2 gvv[8];
    { const bf16* G = ZB + (size_t)i * N_IN + C_G + h * HD + 4 * fq;
#pragma unroll
      for (int eb = 0; eb < 8; ++eb) gvv[eb] = *(const u32x2*)(G + 16 * eb); }
    __syncthreads();
    bf16x8 pf[4];
#pragma unroll
    for (int tp = 0; tp < 4; ++tp) {
        unsigned pw[4];
#pragma unroll
        for (int bb = 0; bb < 2; ++bb) {
            const int b = 2 * tp + bb;
            f32x4 s = (f32x4){0.f, 0.f, 0.f, 0.f};
#pragma unroll
            for (int t = 0; t < 4; ++t) s = MFMA16(*(const LAS bf16x8*)(Kt + (16 * b + fr) * TP + (32 * t + 8 * fq) * 2), qf[t], s);
            float pv[4];
#pragma unroll
            for (int r = 0; r < 4; ++r) { const int j = 16 * b + 4 * fq + r; const int dd = i - j;
                const float dm = dd > 0 ? exp2f(l2f * (float)dd) : (dd < 0 ? exp2f(l2b * (float)(-dd)) : 2.f); pv[r] = s[r] * dm; }
            pw[2 * bb] = cvt_pk_bf16(pv[0], pv[1]); pw[2 * bb + 1] = cvt_pk_bf16(pv[2], pv[3]);
        }
        u32x4 pk; pk.x = pw[0]; pk.y = pw[1]; pk.z = pw[2]; pk.w = pw[3];
        pf[tp] = __builtin_bit_cast(bf16x8, pk);
    }
    const float af = exp2f(l2f * (float)(i + 1)), ab = exp2f(l2b * (float)(128 - i));
    f32x4 o[8]; float ss = 0.f;
#pragma unroll
    for (int eb = 0; eb < 8; ++eb) {
        f32x4 a0 = (f32x4){0.f, 0.f, 0.f, 0.f}, a1 = a0, a2 = a0;
#pragma unroll
        for (int t = 0; t < 4; ++t) {
            a0 = MFMA16(tr_frag(VT, 32 * t + 4 * fq, 32 * t + 16 + 4 * fq, 16 * eb, F.lane), pf[t], a0);
            a1 = MFMA16(*(const LAS bf16x8*)(SF + (16 * eb + fr) * TP + (32 * t + 8 * fq) * 2), qf[t], a1);
            a2 = MFMA16(*(const LAS bf16x8*)(SB + (16 * eb + fr) * TP + (32 * t + 8 * fq) * 2), qf[t], a2);
        }
        o[eb] = a0 + a1 * af + a2 * ab;
        ss += (o[eb][0] * o[eb][0] + o[eb][1] * o[eb][1]) + (o[eb][2] * o[eb][2] + o[eb][3] * o[eb][3]);
    }
    ss += __shfl_xor(ss, 16); ss += __shfl_xor(ss, 32);
    const float r = rsqrtf(ss * (1.f / HD) + EPS);
    bf16* MIX = (bf16*)(F.ws + WS_MIX) + (size_t)(c * 128 + i) * D + h * HD + 4 * fq;
    f32x4 n4v[8];
    { const float* ng = F.in[I_RNG] + (size_t)l * RET_W + h * HD + 4 * fq;
#pragma unroll
      for (int eb = 0; eb < 8; ++eb) n4v[eb] = *(const f32x4*)(ng + 16 * eb); }
#pragma unroll
    for (int eb = 0; eb < 8; ++eb) {
        const u32x2 gv = gvv[eb]; const f32x4 n4 = n4v[eb];
        const f32x4 v = o[eb] * r * n4;
        u32x2 ov; ov.x = cvt_pk_bf16(v[0] * bflo(gv.x), v[1] * bfhi(gv.x)); ov.y = cvt_pk_bf16(v[2] * bflo(gv.y), v[3] * bfhi(gv.y));
        *(u32x2*)(MIX + 16 * eb) = ov;
    }
    __syncthreads();
}


template <int R, int C, int WR, int WC, int KC>
__device__ __forceinline__ void skinny_acc(Frame& F, f32x4 (&acc)[WR][WC], const bf16* A, int lda, const bf16* Bt, int ldb, int K) {
    constexpr int PITCH = KC * 2 + 16, SEGS = KC / 8, PIECES = (R + C) * SEGS, PPT = PIECES / 512, STAGE = (R + C) * PITCH, WGC = C / 16 / WC;
    static_assert(PIECES % 512 == 0 && (R / 16 / WR) * WGC == 8 && 2 * STAGE <= SCR_BYTES, "skinny geometry");
    const int tid = F.tid, fr = F.lane & 15, fq = F.lane >> 4, wgr = F.wave / WGC, wgc = F.wave % WGC;
    u32x4 rg0[PPT], rg1[PPT];
    const bf16* src[PPT]; int dst[PPT];
#pragma unroll
    for (int q = 0; q < PPT; ++q) { const int p = tid + 512 * q, row = p / SEGS, sg = p % SEGS;
        src[q] = row < R ? A + (size_t)row * lda + sg * 8 : Bt + (size_t)(row - R) * ldb + sg * 8; dst[q] = row * PITCH + sg * 16; }
#define SK_GLOAD(rg, k0) do { _Pragma("unroll") for (int q = 0; q < PPT; ++q) rg[q] = *(const u32x4*)(src[q] + (k0)); } while (0)
#define SK_LSTORE(rg, buf) do { _Pragma("unroll") for (int q = 0; q < PPT; ++q) *(LAS u32x4*)(F.lds + (buf) * STAGE + dst[q]) = rg[q]; } while (0)
#define SK_COMPUTE(buf) do { const LAS unsigned char* bA = F.lds + (buf) * STAGE; const LAS unsigned char* bB = bA + R * PITCH; \
        _Pragma("unroll") for (int t = 0; t < KC / 32; ++t) { bf16x8 af[WR], bfr[WC]; \
            _Pragma("unroll") for (int i = 0; i < WR; ++i) af[i] = *(const LAS bf16x8*)(bA + (16 * (wgr * WR + i) + fr) * PITCH + (32 * t + 8 * fq) * 2); \
            _Pragma("unroll") for (int j = 0; j < WC; ++j) bfr[j] = *(const LAS bf16x8*)(bB + (16 * (wgc * WC + j) + fr) * PITCH + (32 * t + 8 * fq) * 2); \
            _Pragma("unroll") for (int i = 0; i < WR; ++i) _Pragma("unroll") for (int j = 0; j < WC; ++j) acc[i][j] = MFMA16(bfr[j], af[i], acc[i][j]); } } while (0)
    const int nch = K / KC;
    __syncthreads();
    SK_GLOAD(rg0, 0); SK_GLOAD(rg1, KC);
    for (int ch = 0; ch < nch; ch += 2) {
        SK_LSTORE(rg0, 0); __syncthreads();
        if (ch + 2 < nch) SK_GLOAD(rg0, (ch + 2) * KC);
        SK_COMPUTE(0);
        SK_LSTORE(rg1, 1); __syncthreads();
        if (ch + 3 < nch) SK_GLOAD(rg1, (ch + 3) * KC);
        SK_COMPUTE(1);
    }
#undef SK_GLOAD
#undef SK_LSTORE
#undef SK_COMPUTE
}
template <int MODE>
__device__ __forceinline__ void ctx_n2048(Frame& F, int l, const bf16* A, const bf16* Bt, int gi, float dry) {
    if (F.G != 256) return;
    constexpr int AP = D * 2 + 16, PART = 32 * AP;
    static_assert(PART + 8 * 64 * 16 <= SCR_BYTES, "ctx_n2048 LDS");
    const int r0 = 32 * (F.bid >> 5), c0 = 64 * (F.bid & 31), fr = F.lane & 15, fq = F.lane >> 4, j = F.wave & 3, kh = F.wave >> 2, tid = F.tid;
    u32x4 av[16];
#pragma unroll
    for (int q = 0; q < 16; ++q) { const int p = tid + 512 * q; av[q] = *(const u32x4*)(A + (size_t)(r0 + (p >> 8)) * D + (p & 255) * 8); }
    const bf16* bp = Bt + (size_t)(c0 + 16 * j + fr) * D + 1024 * kh + 8 * fq;
    bf16x8 bfv[32];
#pragma unroll
    for (int t = 0; t < 16; ++t) bfv[t] = *(const bf16x8*)(bp + 32 * t);
    const int col = c0 + 16 * j + 4 * fq;
    unsigned g0[2], g1[2]; u32x2 xo[2]; f32x4 gt = (f32x4){0.f, 0.f, 0.f, 0.f};
#pragma unroll
    for (int i = 0; i < 2; ++i) { const int row = r0 + 16 * i + fr;
        if (MODE == 0) { const unsigned char* gp = (const unsigned char*)(F.ws + WS_ZB) + (size_t)row * (N_IN * 2) + 2 * C_GATE + col;
            g0[i] = *(const unsigned*)(gp + kh * D); g1[i] = *(const unsigned*)(gp + 2 * kh * D); }
        else xo[i] = *(const u32x2*)((const bf16*)(F.ws + WS_X) + (size_t)row * D + col); }
    if (MODE == 1) gt = *(const f32x4*)((const float*)(F.ws + WS_MOD) + ((size_t)l * 2 + 0) * 6 * D + gi * D + col) * dry;
    __syncthreads();
#pragma unroll
    for (int q = 0; q < 16; ++q) { const int p = tid + 512 * q; *(LAS u32x4*)(F.lds + (p >> 8) * AP + (p & 255) * 16) = av[q]; }
#pragma unroll
    for (int t = 16; t < 32; ++t) bfv[t] = *(const bf16x8*)(bp + 32 * t);
    __syncthreads();
    f32x4 acc[2][2];
#pragma unroll
    for (int s2 = 0; s2 < 2; ++s2)
#pragma unroll
        for (int i = 0; i < 2; ++i) acc[s2][i] = (f32x4){0.f, 0.f, 0.f, 0.f};
    const LAS unsigned char* ap = F.lds + fr * AP + (1024 * kh + 8 * fq) * 2;
#pragma unroll
    for (int t = 0; t < 32; ++t) { const int s2 = (MODE == 0 && t >= 16) ? 1 : 0;
        const bf16x8 a0 = *(const LAS bf16x8*)(ap + 64 * t), a1 = *(const LAS bf16x8*)(ap + 16 * AP + 64 * t);
        acc[s2][0] = MFMA16(bfv[t], a0, acc[s2][0]); acc[s2][1] = MFMA16(bfv[t], a1, acc[s2][1]); }
    f32x4 y[2];
#pragma unroll
    for (int i = 0; i < 2; ++i) {
        if (MODE == 0) {
#pragma unroll
            for (int e = 0; e < 4; ++e) y[i][e] = (acc[0][i][e] * (float)((g0[i] >> (8 * e)) & 255u) + acc[1][i][e] * (float)((g1[i] >> (8 * e)) & 255u)) * (1.f / 255.f);
        } else y[i] = acc[0][i];
    }
    LAS f32x4* part = (LAS f32x4*)(F.lds + PART);
    if (kh == 1) { part[(j * 2 + 0) * 64 + F.lane] = y[0]; part[(j * 2 + 1) * 64 + F.lane] = y[1]; }
    __syncthreads();
    if (kh == 0) {
#pragma unroll
        for (int i = 0; i < 2; ++i) { const int row = r0 + 16 * i + fr; const f32x4 v = y[i] + part[(j * 2 + i) * 64 + F.lane];
            if (MODE == 0) { u32x2 o; o.x = cvt_pk_bf16(v[0], v[1]); o.y = cvt_pk_bf16(v[2], v[3]); *(u32x2*)((bf16*)(F.ws + WS_Y) + (size_t)row * D + col) = o; }
            else { const f32x4 d = gt * v; u32x2 xn; xn.x = cvt_pk_bf16(bflo(xo[i].x) + d[0], bfhi(xo[i].x) + d[1]); xn.y = cvt_pk_bf16(bflo(xo[i].y) + d[2], bfhi(xo[i].y) + d[3]);
                *(u32x2*)((bf16*)(F.ws + WS_X) + (size_t)row * D + col) = xn; }
        }
    }
    __syncthreads();
}
__device__ __forceinline__ void ctx_up(Frame& F, const bf16* Bt) {
    if (F.G != 256) return;
    const int r0 = 64 * (F.bid >> 6), c0 = 128 * (F.bid & 63), fr = F.lane & 15, fq = F.lane >> 4, wgr = F.wave >> 2, wgc = F.wave & 3;
    f32x4 acc[2][2];
#pragma unroll
    for (int i = 0; i < 2; ++i)
#pragma unroll
        for (int j = 0; j < 2; ++j) acc[i][j] = (f32x4){0.f, 0.f, 0.f, 0.f};
    skinny_acc<64, 128, 2, 2, 128>(F, acc, (const bf16*)(F.ws + WS_H) + (size_t)r0 * D, D, Bt + (size_t)c0 * D, D, D);
#pragma unroll
    for (int i = 0; i < 2; ++i)
#pragma unroll
        for (int j = 0; j < 2; ++j) { const int row = r0 + 16 * (wgr * 2 + i) + fr, col = c0 + 16 * (wgc * 2 + j) + 4 * fq; f32x4 a = acc[i][j];
#pragma unroll
            for (int q = 0; q < 4; ++q) { const float x = fmaxf(a[q], 0.f); a[q] = x * x; }
            u32x2 o; o.x = cvt_pk_bf16(a[0], a[1]); o.y = cvt_pk_bf16(a[2], a[3]);
            *(u32x2*)((bf16*)(F.ws + WS_A1) + (size_t)row * DFF + col) = o; }
}

__device__ __forceinline__ void ctx_down_splitk(Frame& F, const bf16* Bt) {
    if (F.G != 256) return;
    const int ks = F.bid >> 6, r0 = 64 * ((F.bid >> 4) & 3), c0 = 128 * (F.bid & 15), fr = F.lane & 15, fq = F.lane >> 4, wgr = F.wave >> 2, wgc = F.wave & 3;
    f32x4 acc[2][2];
#pragma unroll
    for (int i = 0; i < 2; ++i)
#pragma unroll
        for (int j = 0; j < 2; ++j) acc[i][j] = (f32x4){0.f, 0.f, 0.f, 0.f};
    skinny_acc<64, 128, 2, 2, 128>(F, acc, (const bf16*)(F.ws + WS_A1) + (size_t)r0 * DFF + ks * 2048, DFF, Bt + (size_t)c0 * DFF + ks * 2048, DFF, 2048);
    float* SL = (float*)(F.ws + WS_SLAB) + (size_t)ks * CTX * D;
#pragma unroll
    for (int i = 0; i < 2; ++i)
#pragma unroll
        for (int j = 0; j < 2; ++j) { const int row = r0 + 16 * (wgr * 2 + i) + fr, col = c0 + 16 * (wgc * 2 + j) + 4 * fq; *(f32x4*)(SL + (size_t)row * D + col) = acc[i][j]; }
}

constexpr int PH_PER_LAYER = 10, PH_PRE = 3, N_PHASES = PH_PRE + DEPTH * PH_PER_LAYER;
__global__ void __launch_bounds__(512, 2) mk_fwd(Args args) {
    extern __shared__ __attribute__((aligned(16))) unsigned char lds_raw[];
    LAS unsigned char* const ldsb = (LAS unsigned char*)lds_raw;
    volatile LAS unsigned* MISC = (volatile LAS unsigned*)(ldsb + MISC_OFF);
    for (int u = threadIdx.x; u < 64; u += 512) MISC[u] = 0u;
    __syncthreads();
    unsigned* barw = (unsigned*)(args.ws + WS_BAR);
    XcdBarrier bar; bar.bar = barw; bar.x = 0; bar.st = MISC + 8;
    if (!MK_SPLIT) bar = xcd_barrier_post(barw, MISC + 8);
    const int lo = args.ph_lo, hi = args.ph_hi;
#define IN(k) (lo <= (k) && (k) < hi)
#define SEAM(k) do { if (IN((k) + 1)) xcd_barrier(bar); } while (0)
#define MODP(F) ((const float*)((F).ws + WS_MOD))

    if (IN(0) && (PMASK & 1)) { for (int rep = 0; rep < ((DUP >> 12) & 1) + 1; ++rep) { Frame F; make_frame(F, ldsb); p0_prologue(F); __syncthreads(); } SEAM(0); }
    if (IN(1) && (PMASK & 1)) { Frame F; make_frame(F, ldsb); mod_reduce_phase(F); SEAM(1); }
    if (IN(2) && (PMASK & 2)) { Frame F; make_frame(F, ldsb); norm_phase(F, F.in[I_N1G], MODP(F), 0, true); SEAM(2); }

    for (int l = 0; l < DEPTH; ++l) {
        const int pb = PH_PRE + l * PH_PER_LAYER;
        if (IN(pb + 0) && (PMASK & 4)) for (int rep = 0; rep < ((DUP >> 0) & 1) + 1; ++rep) {
            Frame F; make_frame(F, ldsb);
            pg8::GemmSched S; S.T.init(MROWS / 256, N_IN / 256, F.G, F.bid); S.A = (const char*)(F.ws + WS_H); S.B = (const char*)(F.ws + WS_WIN + l * SZ_WIN);
            S.a_tile = (size_t)256 * D * 2; S.b_tile = (size_t)256 * D * 2; S.nt = D / 64; S.pm0 = 0;
            EpiInProj E{(bf16*)(F.ws + WS_ZB), (const float*)(F.ws + WS_ROPE)};
            pg8::gemm_phase(F.lds, F.tid, D, D, S, E);
            SEAM(pb + 0);
        }
        if (IN(pb + 1) && (PMASK & 8)) for (int rep = 0; rep < ((DUP >> 1) & 1) + 1; ++rep) {
            Frame F; make_frame(F, ldsb);
            constexpr int N_KV = NCHUNK * RET_H, N_PG = (NCHUNK - 4) * 4;
            for (int it = F.bid; it < N_KV + 2 * N_PG; it += F.G) {
                if (it < N_KV) kv_item(F, l, it / RET_H, it % RET_H);
                else if (it < N_KV + N_PG) { const int r = it - N_KV + 16; pool_item(F, l, r >> 2, r & 3); }
                else { const int r = it - N_KV - N_PG + 16; sg_item(F, l, r >> 2, r & 3); }
            }
            SEAM(pb + 1);
        }
        if (IN(pb + 2) && (PMASK & 16)) for (int rep = 0; rep < ((DUP >> 2) & 1) + 1; ++rep) { Frame F; make_frame(F, ldsb);
            const bool ctx_live = l + 1 < DEPTH;
            const int nctx = ctx_live ? 2 * RET_H : 0, ndef = ctx_live ? 32 : 16;
            if (F.bid < nctx) ret_item<true>(F, l, F.bid >> 3, F.bid & 7);
            else if (F.bid < nctx + ndef) { const int j = F.bid - nctx, d = ctx_live ? j : (j < 8 ? 8 + j : 16 + j);
                if (d < 16) pool_item(F, l, d >> 2, d & 3); else sg_item(F, l, (d - 16) >> 2, d & 3); }
            scan_phase(F, l, nctx + ndef); SEAM(pb + 2); }
        if (IN(pb + 3) && (PMASK & 32)) for (int rep = 0; rep < ((DUP >> 3) & 1) + 1; ++rep) {
            Frame F; make_frame(F, ldsb);
            for (int it = F.bid; it < SEQ / 128 * RET_H; it += F.G) { const int itx = 2 * RET_H + it; ret_item<false>(F, l, itx / RET_H, itx % RET_H); }
            SEAM(pb + 3);
        }
        if (IN(pb + 4) && (PMASK & 64)) for (int rep = 0; rep < ((DUP >> 4) & 1) + 1; ++rep) {
            Frame F; make_frame(F, ldsb);
            pg8::BranchSched S; S.T.init(SEQ / 256, D / 256, F.G, F.bid); S.A = (const char*)(F.ws + WS_MIX); S.B = (const char*)(F.ws + WS_WCAT + l * SZ_WSQ);
            S.a_tile = (size_t)256 * D * 2; S.b_tile = (size_t)256 * D * 2; S.pm0 = 1;
            EpiBranch E{(const bf16*)(F.ws + WS_ZB), (bf16*)(F.ws + WS_Y)};
            pg8::gemm_phase(F.lds, F.tid, D, D, S, E);
            if (l + 1 < DEPTH) ctx_n2048<0>(F, l, (const bf16*)(F.ws + WS_MIX), (const bf16*)(F.ws + WS_WCAT + l * SZ_WSQ), 0, 1.f);
            SEAM(pb + 4);
        }
        if (IN(pb + 5) && (PMASK & 128)) for (int rep = 0; rep < ((DUP >> 5) & 1) + 1; ++rep) {
            Frame F; make_frame(F, ldsb);
            pg8::GemmSched S; S.T.init(SEQ / 256, D / 256, F.G, F.bid); S.A = (const char*)(F.ws + WS_Y); S.B = (const char*)(F.ws + WS_WOUT + l * SZ_WSQ);
            S.a_tile = (size_t)256 * D * 2; S.b_tile = (size_t)256 * D * 2; S.nt = D / 64; S.pm0 = 1;
            if (l + 1 < DEPTH || !FUSE_FINAL) {
                EpiResid E{(bf16*)(F.ws + WS_X), MODP(F) + (size_t)l * 2 * 6 * D, 2, rep ? 0.f : 1.f};
                pg8::gemm_phase(F.lds, F.tid, D, D, S, E);
                if (l + 1 < DEPTH) ctx_n2048<1>(F, l, (const bf16*)(F.ws + WS_Y), (const bf16*)(F.ws + WS_WOUT + l * SZ_WSQ), 2, rep ? 0.f : 1.f);
            } else {
                const float* ml = MODP(F) + (size_t)l * 2 * 6 * D;
                EpiResidNorm<false> E{(bf16*)(F.ws + WS_X), ml, 2, F.in[I_N2G] + (size_t)l * D, nullptr, (unsigned*)(F.ws + WS_XCH), (unsigned*)(F.ws + WS_CNT), F.lds + 131072, 64u, (bf16*)(F.ws + WS_H), ml + 6 * D + 4 * D, ml + 6 * D + 3 * D};
                pg8::gemm_phase(F.lds, F.tid, D, D, S, E);
            }
            SEAM(pb + 5);
        }
        if (IN(pb + 6) && (PMASK & 256) && (l + 1 < DEPTH || !FUSE_FINAL)) for (int rep = 0; rep < ((DUP >> 6) & 1) + 1; ++rep) { Frame F; make_frame(F, ldsb); norm_phase(F, F.in[I_N2G] + (size_t)l * D, MODP(F) + (size_t)l * 2 * 6 * D, 3, false); SEAM(pb + 6); }
        if (IN(pb + 7) && (PMASK & 512)) for (int rep = 0; rep < ((DUP >> 7) & 1) + 1; ++rep) {
            Frame F; make_frame(F, ldsb);
            pg8::GemmSched S; S.T.init(SEQ / 256, DFF / 256, F.G, F.bid); S.A = (const char*)(F.ws + WS_H); S.B = (const char*)(F.ws + WS_W1 + l * SZ_WFF);
            S.a_tile = (size_t)256 * D * 2; S.b_tile = (size_t)256 * D * 2; S.nt = D / 64; S.pm0 = 1;
            EpiRelu2 E{(bf16*)(F.ws + WS_A1)};
            pg8::gemm_phase(F.lds, F.tid, D, D, S, E);
            if (l + 1 < DEPTH) ctx_up(F, (const bf16*)(F.ws + WS_W1 + l * SZ_WFF));
            SEAM(pb + 7);
        }
        if (IN(pb + 8) && (PMASK & 1024)) for (int rep = 0; rep < ((DUP >> 8) & 1) + 1; ++rep) {
            Frame F; make_frame(F, ldsb);
            pg8::GemmSched S; S.T.init(SEQ / 256, D / 256, F.G, F.bid); S.A = (const char*)(F.ws + WS_A1); S.B = (const char*)(F.ws + WS_W2 + l * SZ_WFF);
            S.a_tile = (size_t)256 * DFF * 2; S.b_tile = (size_t)256 * DFF * 2; S.nt = DFF / 64; S.pm0 = 1;
            if (l + 1 < DEPTH) {
                EpiResid E{(bf16*)(F.ws + WS_X), MODP(F) + (size_t)l * 2 * 6 * D, 5, rep ? 0.f : 1.f};
                pg8::gemm_phase(F.lds, F.tid, DFF, DFF, S, E);
                ctx_down_splitk(F, (const bf16*)(F.ws + WS_W2 + l * SZ_WFF));
            } else {
                EpiResidNorm<true> E{(bf16*)(F.ws + WS_X), MODP(F) + (size_t)l * 2 * 6 * D, 5, F.in[I_FNG], ((KArgs)__builtin_amdgcn_kernarg_segment_ptr())->out, (unsigned*)(F.ws + WS_XCH), (unsigned*)(F.ws + WS_CNT), F.lds + 131072, 128u, nullptr, nullptr, nullptr};
                pg8::gemm_phase(F.lds, F.tid, DFF, DFF, S, E);
            }
            if (l + 1 < DEPTH || !FUSE_FINAL) SEAM(pb + 8);
        }
        if (IN(pb + 9) && (PMASK & 2048)) for (int rep = 0; rep < ((DUP >> 9) & 1) + 1; ++rep) {
            Frame F; make_frame(F, ldsb);
            if (l + 1 < DEPTH) { norm_phase(F, F.in[I_N1G] + (size_t)(l + 1) * D, MODP(F) + (size_t)(l + 1) * 2 * 6 * D, 0, false, MODP(F) + (size_t)l * 2 * 6 * D + 5 * D); SEAM(pb + 9); }
            else final_norm_phase(F, ((KArgs)__builtin_amdgcn_kernarg_segment_ptr())->out);
        }
    }
#undef IN
#undef SEAM
}

extern "C" void kernel_launch(void* const* d_in, const int* in_sizes, int n_in, void* d_out, int out_size, void* d_ws, size_t ws_size, hipStream_t stream) {
    static int grid = 0;
    if (grid == 0) {
        if (n_in != 23 || out_size != SEQ * D || ws_size < WS_END) { fprintf(stderr, "kernel_launch: unexpected problem (n_in %d, out %d, ws %zu < %zu)\n", n_in, out_size, ws_size, (size_t)WS_END); grid = -1; return; }
        int dev = 0, cus = 0, per_cu = 0;
        if (hipGetDevice(&dev) != hipSuccess || hipDeviceGetAttribute(&cus, hipDeviceAttributeMultiprocessorCount, dev) != hipSuccess) { grid = -1; return; }
        if (hipFuncSetAttribute((const void*)mk_fwd, hipFuncAttributeMaxDynamicSharedMemorySize, LDS_BYTES) != hipSuccess) { fprintf(stderr, "kernel_launch: hipFuncSetAttribute failed\n"); grid = -1; return; }
        if (hipOccupancyMaxActiveBlocksPerMultiprocessor(&per_cu, (const void*)mk_fwd, 512, LDS_BYTES) != hipSuccess || per_cu < 1) { fprintf(stderr, "kernel_launch: occupancy query reports %d blocks per CU\n", per_cu); (void)hipGetLastError(); grid = -1; return; }
        grid = cus;
    }
    if (grid < 0) return;
    if (hipMemsetAsync((char*)d_ws + WS_CTL, 0, CTL_ZERO_BYTES, stream) != hipSuccess) return;
    Args a{};
    for (int i = 0; i < 23; ++i) a.in[i] = (const float*)d_in[i];
    a.out = (float*)d_out; a.ws = (unsigned char*)d_ws;
#if MK_SPLIT
    for (int p = 0; p < N_PHASES; ++p) { a.ph_lo = p; a.ph_hi = p + 1; hipLaunchKernelGGL(mk_fwd, dim3(grid), dim3(512), LDS_BYTES, stream, a); }
#else
    a.ph_lo = 0; a.ph_hi = N_PHASES;
    hipLaunchKernelGGL(mk_fwd, dim3(grid), dim3(512), LDS_BYTES, stream, a);
#endif
}
```

```cpp
#include <hip/hip_runtime.h>
#include <cstdio>
#include <cstdint>

#ifndef PMASK
#define PMASK 0xFFFF
#endif
#ifndef DUP
#define DUP 0
#endif
#ifndef MK_SPLIT
#define MK_SPLIT 0
#endif

constexpr int D = 2048, SEQ = 8192, CTX = 256, DEPTH = 4, GRID_W = 64;
constexpr int MROWS = CTX + SEQ;
constexpr int NCHUNK = MROWS / 128;
constexpr int RET_W = 1024, RET_H = 8, HD = 128;
constexpr int POOL_W = 512, SG_W = 512, DFF = 8192;
constexpr int N_IN = 4 * RET_W + POOL_W + 2 * SG_W + 3 * D;
constexpr int C_Q = 0, C_K = 1024, C_V = 2048, C_G = 3072, C_P = 4096, C_U = 4608, C_SV = 5120, C_GATE = 5632;
constexpr float EPS = 1e-6f;
constexpr float K_SCALE = 0.08838834764831845f;
constexpr float LOG2E = 1.4426950408889634f;

#define LAS __attribute__((address_space(3)))
#define GAS __attribute__((address_space(1)))
typedef unsigned short bf16;
typedef short bf16x8 __attribute__((ext_vector_type(8)));
typedef short bf16x4 __attribute__((ext_vector_type(4)));
typedef float f32x4 __attribute__((ext_vector_type(4)));
typedef float f32x2 __attribute__((ext_vector_type(2)));
typedef unsigned u32x4 __attribute__((ext_vector_type(4)));
typedef unsigned u32x2 __attribute__((ext_vector_type(2)));

__device__ __forceinline__ unsigned f2bf(float f) { unsigned u = __builtin_bit_cast(unsigned, f); return (u + 0x7fffu + ((u >> 16) & 1u)) >> 16; }
__device__ __forceinline__ unsigned pk2(float lo, float hi) { return f2bf(lo) | (f2bf(hi) << 16); }
__device__ __forceinline__ unsigned cvt_pk_bf16(float lo, float hi) { unsigned r; asm volatile("v_cvt_pk_bf16_f32 %0, %1, %2" : "=v"(r) : "v"(lo), "v"(hi)); return r; }
__device__ __forceinline__ float bflo(unsigned w) { return __uint_as_float(w << 16); }
__device__ __forceinline__ float bfhi(unsigned w) { return __uint_as_float(w & 0xffff0000u); }
__device__ __forceinline__ float silu_f(float x) { return x * __builtin_amdgcn_rcpf(1.f + __expf(-x)); }
__device__ __forceinline__ float gelu_tanh_f(float x) { const float u = 1.5957691216057308f * (x + 0.044715f * x * x * x); return x * __builtin_amdgcn_rcpf(1.f + __expf(-u)); }
__device__ __forceinline__ float log_sigmoid_f(float x) { return x >= 0.f ? -log1pf(expf(-x)) : x - log1pf(expf(x)); }
__device__ __forceinline__ float wave_sum(float v) {
#pragma unroll
    for (int o = 1; o < 64; o <<= 1) v += __shfl_xor(v, o);
    return v;
}
#define LDS_WAIT() asm volatile("s_waitcnt lgkmcnt(0)" ::: "memory")
#define VM_WAIT() asm volatile("s_waitcnt vmcnt(0)" ::: "memory")

namespace pg8 {
constexpr int BM = 256, BK = 64, HALF = 128, HTB = HALF * BK * 2  , STAGE_BYTES = 8 * HTB, NXCD = 8, WGM = 8;
__host__ __device__ __forceinline__ int lds_byte(int r, int c) { const int st = (r >> 4) * 2 + (c >> 5), rr = r & 15, cc = c & 31, ob = rr * 64 + cc * 2; return st * 1024 + (ob ^ (((ob >> 9) & 1) << 5)); }
__host__ __device__ __forceinline__ void stage_rc(int b, int& R, int& C) { const int st = b / 1024, sb = b % 1024, swz = sb ^ (((sb >> 9) & 1) << 5); R = (st >> 1) * 16 + swz / 64; C = (st & 1) * 32 + (swz % 64) / 2; }
__host__ __device__ __forceinline__ int perm32(int rho) { const int n = rho >> 4, i = rho & 15; return 8 * (i >> 2) + 4 * n + (i & 3); }

struct Unit { const char* A; const char* B; int nt, pm, pn, kind; };

struct TileOrder {
    int nM, nN, nwg, G, c;
    __device__ void init(int nM_, int nN_, int G_, int c_) { nM = nM_; nN = nN_; nwg = nM * nN; G = G_; c = c_; }
    __device__ bool tile(int i, int& pm, int& pn) const {
        const long L = (long)i * G + c; if (L >= nwg) return false;
        int wgid = (int)L; { const int q = nwg / NXCD, r = nwg % NXCD, xcd = wgid % NXCD, off = wgid / NXCD; wgid = (xcd < r ? xcd * (q + 1) : r * (q + 1) + (xcd - r) * q) + off; }
        const int nig = WGM * nN, gid = wgid / nig, fm = gid * WGM, gsz = (nM - fm) < WGM ? (nM - fm) : WGM;
        pm = fm + ((wgid % nig) % gsz); pn = (wgid % nig) / gsz; return true;
    }
};
struct GemmSched {
    TileOrder T; const char* A; const char* B; size_t a_tile, b_tile; int nt, pm0;
    __device__ __forceinline__ bool next(int i, Unit& u) const { int pm, pn; if (!T.tile(i, pm, pn)) return false; pm += pm0; u.A = A + (size_t)pm * a_tile; u.B = B + (size_t)pn * b_tile; u.nt = nt; u.pm = pm; u.pn = pn; u.kind = 0; return true; }
};
struct BranchSched {
    TileOrder T; const char* A; const char* B; size_t a_tile, b_tile; int pm0;
    __device__ __forceinline__ bool next(int i, Unit& u) const { int pm, pn; const int ti = i / 3, seg = i - 3 * ti; if (!T.tile(ti, pm, pn)) return false; pm += pm0;
        const int koff = seg == 0 ? 0 : (seg == 1 ? 1024 : 1536);
        u.A = A + (size_t)pm * a_tile + koff * 2; u.B = B + (size_t)pn * b_tile + koff * 2; u.nt = seg == 0 ? 16 : 8; u.pm = pm; u.pn = pn; u.kind = seg; return true; }
};

template <class Epi, class Sched>
__device__ __forceinline__ void gemm_phase(LAS unsigned char* lds, const int tid, const int lda, const int ldb, const Sched& S, const Epi& E) {
    const int wid = __builtin_amdgcn_readfirstlane(tid >> 6), lane = tid & 63, wr = wid >> 2, wc = wid & 3, fr = lane & 15, fq = lane >> 4;
    unsigned voffA[2], voffB[2];
#pragma unroll
    for (int i = 0; i < 2; ++i) { int R, C; stage_rc(tid * 16 + i * 8192, R, C); const int Rb = Epi::PERM ? (64 * (R >> 5) + perm32(R & 31)) : R;
        voffA[i] = (unsigned)(R * lda + C) * 2u; voffB[i] = (unsigned)(Rb * ldb + C) * 2u; }
    const size_t kstep = (size_t)(BK * 2);
    const size_t hstepA = (size_t)HALF * lda * 2, hstepB = (size_t)(Epi::PERM ? 32 : HALF) * ldb * 2;
    const unsigned ldsw = (unsigned)wid * 1024u;
    const int aoff = lds_byte(wr * 64 + fr, fq * 8), boff = lds_byte(wc * 32 + fr, fq * 8);
#define PG8_SA(b, h) (((b) * 2 + (h)) * HTB)
#define PG8_SB(b, h) ((4 + (b) * 2 + (h)) * HTB)
#define PG8_STAGE(bufoff, gbase, voff) do { _Pragma("unroll") for (int _i = 0; _i < 2; ++_i) \
        __builtin_amdgcn_global_load_lds((const unsigned*)((const char*)(gbase) + (voff)[_i]), (LAS unsigned*)(lds + (bufoff) + ldsw + _i * 8192), 16, 0, 0); } while (0)
#define PG8_LDA(dst, b, h) do { _Pragma("unroll") for (int m = 0; m < 4; ++m) _Pragma("unroll") for (int k = 0; k < 2; ++k) dst[m][k] = *(const LAS bf16x8*)(lds + PG8_SA(b, h) + aoff + m * 2048 + k * 1024); } while (0)
#define PG8_LDB(dst, b, h) do { _Pragma("unroll") for (int n = 0; n < 2; ++n) _Pragma("unroll") for (int k = 0; k < 2; ++k) dst[n][k] = *(const LAS bf16x8*)(lds + PG8_SB(b, h) + boff + n * 2048 + k * 1024); } while (0)
#define PG8_MMA(ai, bj, At, Bt) do { __builtin_amdgcn_s_setprio(1); _Pragma("unroll") for (int m = 0; m < 4; ++m) _Pragma("unroll") for (int n = 0; n < 2; ++n) _Pragma("unroll") for (int k = 0; k < 2; ++k) \
        acc[ai][bj][m][n] = __builtin_amdgcn_mfma_f32_16x16x32_bf16(Bt[n][k], At[m][k], acc[ai][bj][m][n], 0, 0, 0); __builtin_amdgcn_s_setprio(0); } while (0)
#define PG8_WAIT_V(n) asm volatile("s_waitcnt vmcnt(" #n ")" ::: "memory")
#define PG8_WAIT_L(n) asm volatile("s_waitcnt lgkmcnt(" #n ")" ::: "memory")
#define PG8_BAR __builtin_amdgcn_s_barrier()
#define PG8_SCHED __builtin_amdgcn_sched_barrier(0)
    Unit cur, nxt; int ui = 0;
    if (!S.next(0, cur)) return;
    f32x4 acc[2][2][4][2];
#pragma unroll
    for (int a = 0; a < 2; ++a)
#pragma unroll
        for (int b = 0; b < 2; ++b)
#pragma unroll
            for (int m = 0; m < 4; ++m)
#pragma unroll
                for (int n = 0; n < 2; ++n) acc[a][b][m][n] = (f32x4){0.f, 0.f, 0.f, 0.f};
    bf16x8 At[4][2], B0[2][2], B1[2][2];
    const char* cA = cur.A; const char* cB = cur.B;
    PG8_STAGE(PG8_SB(0, 0), cB, voffB); PG8_STAGE(PG8_SB(0, 1), cB + hstepB, voffB); PG8_STAGE(PG8_SA(0, 0), cA, voffA); PG8_STAGE(PG8_SA(0, 1), cA + hstepA, voffA);
    if (wr == 1) PG8_BAR;
    PG8_WAIT_V(2); PG8_BAR;
    PG8_STAGE(PG8_SB(1, 0), cB + kstep, voffB); PG8_STAGE(PG8_SA(1, 0), cA + kstep, voffA); PG8_STAGE(PG8_SB(1, 1), cB + hstepB + kstep, voffB);
    PG8_WAIT_V(6); PG8_BAR;
    for (;;) {
        const bool has_next = S.next(ui + 1, nxt);
        const char* nA = has_next ? nxt.A : cA; const char* nB = has_next ? nxt.B : cB;
        const int nt = cur.nt;
        for (int t = 0; t < nt; t += 2) {
            const bool last = (t == nt - 2);
            const char* a1 = cA + (size_t)(t + 1) * kstep;
            const char* a2 = last ? nA : cA + (size_t)(t + 2) * kstep; const char* b2 = last ? nB : cB + (size_t)(t + 2) * kstep;
            const char* a3 = a2 + kstep; const char* b3 = b2 + kstep;
            PG8_LDB(B0, 0, 0); PG8_LDB(B1, 0, 1); PG8_SCHED; PG8_LDA(At, 0, 0); PG8_STAGE(PG8_SA(1, 1), a1 + hstepA, voffA);
            PG8_WAIT_V(8); PG8_WAIT_L(0); PG8_BAR; PG8_MMA(0, 0, At, B0); PG8_MMA(0, 1, At, B1); PG8_BAR; PG8_SCHED;
            PG8_LDA(At, 0, 1); PG8_STAGE(PG8_SB(0, 0), b2, voffB); PG8_STAGE(PG8_SB(0, 1), b2 + hstepB, voffB); PG8_STAGE(PG8_SA(0, 0), a2, voffA);
            PG8_WAIT_V(8); PG8_WAIT_L(0); PG8_BAR; PG8_MMA(1, 0, At, B0); PG8_MMA(1, 1, At, B1); PG8_BAR; PG8_SCHED;
            PG8_LDB(B0, 1, 0); PG8_LDB(B1, 1, 1); PG8_SCHED; PG8_LDA(At, 1, 0); PG8_STAGE(PG8_SA(0, 1), a2 + hstepA, voffA);
            PG8_WAIT_V(8); PG8_WAIT_L(0); PG8_BAR; PG8_MMA(0, 0, At, B0); PG8_MMA(0, 1, At, B1); PG8_BAR; PG8_SCHED;
            PG8_LDA(At, 1, 1); PG8_STAGE(PG8_SB(1, 0), b3, voffB); PG8_STAGE(PG8_SB(1, 1), b3 + hstepB, voffB); PG8_STAGE(PG8_SA(1, 0), a3, voffA);
            PG8_WAIT_V(8); PG8_WAIT_L(0); PG8_BAR; PG8_MMA(1, 0, At, B0); PG8_MMA(1, 1, At, B1); PG8_BAR; PG8_SCHED;
        }
        if (wr == 0) PG8_BAR;
        E(acc, cur, wr, wc, fr, fq);
#if defined(EPI2)
        if (Epi::PROBE2) E(acc, cur, wr, wc, fr, fq);
#endif
        if (!has_next) break;
        if (!(Epi::KEEP && E.keep(cur))) {
#pragma unroll
            for (int a = 0; a < 2; ++a)
#pragma unroll
                for (int b = 0; b < 2; ++b)
#pragma unroll
                    for (int m = 0; m < 4; ++m)
#pragma unroll
                        for (int n = 0; n < 2; ++n) acc[a][b][m][n] = (f32x4){0.f, 0.f, 0.f, 0.f};
        }
        cur = nxt; cA = nA; cB = nB; ++ui;
        if (wr == 1) PG8_BAR;
    }
    PG8_WAIT_V(0);
    PG8_BAR;
#undef PG8_SA
#undef PG8_SB
#undef PG8_STAGE
#undef PG8_LDA
#undef PG8_LDB
#undef PG8_MMA
#undef PG8_WAIT_V
#undef PG8_WAIT_L
#undef PG8_BAR
#undef PG8_SCHED
}
}

constexpr size_t KiB = 1024, MiB = 1u << 20;
constexpr size_t WS_CTL = 0, CTL_ZERO_BYTES = 128 * KiB;
constexpr size_t WS_BAR = 64 * KiB;
constexpr size_t WS_MOD = 256 * KiB;
constexpr size_t WS_ROPE = 1 * MiB;
constexpr size_t WS_PWT = WS_ROPE + 64 * KiB;
constexpr size_t WS_SGW = WS_PWT + 512 * KiB;
constexpr size_t WS_WIN = 4 * MiB;
constexpr size_t SZ_WIN = (size_t)N_IN * D * 2;
constexpr size_t WS_WCAT = WS_WIN + DEPTH * SZ_WIN;
constexpr size_t SZ_WSQ = (size_t)D * D * 2;
constexpr size_t WS_WOUT = WS_WCAT + DEPTH * SZ_WSQ;
constexpr size_t WS_W1 = WS_WOUT + DEPTH * SZ_WSQ;
constexpr size_t SZ_WFF = (size_t)DFF * D * 2;
constexpr size_t WS_W2 = WS_W1 + DEPTH * SZ_WFF;
constexpr size_t WS_X = WS_W2 + DEPTH * SZ_WFF;
constexpr size_t WS_H = WS_X + (size_t)MROWS * D * 4;
constexpr size_t WS_ZB = WS_H + (size_t)MROWS * D * 2;
constexpr size_t WS_KVT = WS_ZB + (size_t)MROWS * N_IN * 2;
constexpr size_t WS_ST = WS_KVT + (size_t)NCHUNK * 16 * 16384 * 4;
constexpr size_t WS_MIX = WS_ST + (size_t)NCHUNK * 16 * 16384 * 2;
constexpr size_t WS_Y = WS_MIX + (size_t)MROWS * D * 2;
constexpr size_t WS_A1 = WS_Y + (size_t)MROWS * D * 2;
constexpr size_t WS_MODP = WS_A1 + (size_t)MROWS * DFF * 2;
constexpr size_t WS_SLAB = WS_MODP + (size_t)16 * DEPTH * 2 * 6 * D * 4;
constexpr size_t WS_XCH = WS_SLAB + (size_t)4 * CTX * D * 4;
constexpr size_t WS_END = WS_XCH + (size_t)MROWS * 8 * 4;
constexpr size_t WS_CNT = 0;

constexpr int SCR_BYTES = 147456;
constexpr int MISC_OFF = SCR_BYTES;
constexpr int LDS_BYTES = SCR_BYTES + 256;
constexpr int TP = 272;
constexpr int TILE_B = 128 * TP;

#define XB_TMO      128
#define XB_XCNT(j)  (256  + 64 * (j))
#define XB_XSUB(j)  (1280 + 64 * (j))
#define XB_XGEN(j)  (2304 + 64 * (j))
#define XB_TOP      3328
#define XB_TOPGEN   3392
#define XCD_BAR_WORDS 3456
#define XB_SPIN_CAP (1u << 18)
__device__ __forceinline__ unsigned xb_ld(unsigned* p)              { return __hip_atomic_load(p, __ATOMIC_RELAXED, __HIP_MEMORY_SCOPE_AGENT); }
__device__ __forceinline__ unsigned xb_add(unsigned* p, unsigned v) { return __hip_atomic_fetch_add(p, v, __ATOMIC_RELAXED, __HIP_MEMORY_SCOPE_AGENT); }
__device__ __forceinline__ unsigned xb_xcc_id() { return (unsigned)__builtin_amdgcn_s_getreg((3 << 11) | 20) & 0xFu; }
#define XB_SPIN(cond, bar) do { unsigned _sp = 0; while (cond) { __builtin_amdgcn_s_sleep(1); \
    if ((++_sp & 255u) == 0u) { if (xb_ld(&(bar)[XB_TMO])) break; if (_sp > XB_SPIN_CAP) { atomicAdd(&(bar)[XB_TMO], 1u); break; } } } } while (0)
struct XcdBarrier { unsigned* bar; unsigned x; volatile LAS unsigned* st; };
__device__ __forceinline__ XcdBarrier xcd_barrier_post(unsigned* bar, volatile LAS unsigned* st) {
    XcdBarrier b; b.bar = bar; b.x = xb_xcc_id(); b.st = st;
    if (threadIdx.x == 0) (void)xb_add(&bar[XB_XCNT(b.x)], 1u);
    return b;
}
__device__ __forceinline__ void xcd_barrier_complete(unsigned* bar, unsigned x, unsigned& nloc, unsigned& nx) {
    const unsigned G = gridDim.x * gridDim.y * gridDim.z;
    unsigned sum, cnt, mine, sp = 0u;
    for (;;) {
        sum = 0u; cnt = 0u; mine = 0u;
#pragma unroll
        for (unsigned j = 0; j < 16; ++j) { const unsigned c = xb_ld(&bar[XB_XCNT(j)]); sum += c; cnt += (c > 0u) ? 1u : 0u; mine = (j == x) ? c : mine; }
        if (sum == G) break;
        __builtin_amdgcn_s_sleep(1);
        if ((++sp & 255u) == 0u) { if (xb_ld(&bar[XB_TMO])) break; if (sp > XB_SPIN_CAP) { atomicAdd(&bar[XB_TMO], 1u); break; } }
    }
    nloc = mine > 0u ? mine : 1u; nx = cnt > 0u ? cnt : 1u;
}
__device__ __forceinline__ void xcd_barrier(const XcdBarrier& b) {
    asm volatile("s_waitcnt vmcnt(0)" ::: "memory");
    __syncthreads();
    if (threadIdx.x == 0) {
        unsigned* bar = b.bar;
        __builtin_amdgcn_s_waitcnt(0);
        unsigned nloc = b.st[0], nx = b.st[1];
        if (nloc == 0u) { xcd_barrier_complete(bar, b.x, nloc, nx); b.st[0] = nloc; b.st[1] = nx; }
        const unsigned old = xb_add(&bar[XB_XSUB(b.x)], 1u);
        const unsigned gen = old / nloc;
        if (old + 1u == (gen + 1u) * nloc) {
            __builtin_amdgcn_fence(__ATOMIC_RELEASE, "agent");
            asm volatile("s_waitcnt vmcnt(0)" ::: "memory");
            const unsigned og = xb_add(&bar[XB_TOP], 1u);
            const unsigned tg = og / nx;
            if (og + 1u == (tg + 1u) * nx) xb_add(&bar[XB_TOPGEN], 1u);
            else XB_SPIN(xb_ld(&bar[XB_TOPGEN]) == tg, bar);
            __builtin_amdgcn_fence(__ATOMIC_ACQUIRE, "agent");
            xb_add(&bar[XB_XGEN(b.x)], 1u);
            asm volatile("s_waitcnt vmcnt(0)" ::: "memory");
        } else {
            XB_SPIN(xb_ld(&bar[XB_XGEN(b.x)]) == gen, bar);
            __builtin_amdgcn_fence(__ATOMIC_ACQUIRE, "agent");
            asm volatile("s_waitcnt vmcnt(0)" ::: "memory");
        }
    }
    __syncthreads();
}

struct Args { const float* in[23]; float* out; unsigned char* ws; int ph_lo, ph_hi; };
typedef const __attribute__((address_space(4))) Args* KArgs;
struct Frame {
    LAS unsigned char* lds;
    int tid, lane, wave, G, bid;
    unsigned char* ws;
    const float* const __attribute__((address_space(4)))* in;
};
__device__ __forceinline__ void make_frame(Frame& F, LAS unsigned char* lds) {
    int t = threadIdx.x; asm volatile("" : "+v"(t));
    KArgs ka = (KArgs)__builtin_amdgcn_kernarg_segment_ptr(); asm volatile("" : "+s"(ka));
    F.lds = lds; F.tid = t; F.lane = t & 63; F.wave = __builtin_amdgcn_readfirstlane(t >> 6); F.G = gridDim.x; F.bid = blockIdx.x;
    F.ws = ka->ws; F.in = ka->in;
}
enum { I_X = 0, I_C, I_CTX, I_CCTX, I_WADA, I_BADA, I_N1G, I_WIN, I_RLOG, I_RNG, I_PW, I_PS, I_SGNG, I_SGW, I_SGB, I_WBR, I_WBP, I_WBS, I_WOUT, I_N2G, I_W1, I_W2, I_FNG };

using pg8::Unit; using pg8::BM; using pg8::HALF;
#if defined(EPI2)
#define P2(x) static constexpr bool PROBE2 = (EPI2 == x);
#else
#define P2(x)
#endif
struct EpiInProj {           P2(1)
    static constexpr bool PERM = true, KEEP = false;
    bf16* ZB; const float* rope;
    __device__ __forceinline__ bool keep(const Unit&) const { return false; }
    __device__ __forceinline__ void operator()(f32x4 (&acc)[2][2][4][2], const Unit& u, int wr, int wc, int fr, int fq) const {
        const int pn = u.pn, row0 = u.pm * BM + wr * 64 + fr;
        if (pn < 8) {
            const int half = wc & 1; const float ks = pn >= 4 ? K_SCALE : 1.f; const bool latent = u.pm > 0;
            f32x4 csn[4];
            auto ldcs = [&](int step, f32x4 (&c4)[4]) { const int row = row0 + (step >> 2) * HALF + (step & 3) * 16;
#pragma unroll
                for (int q = 0; q < 4; ++q) c4[q] = (f32x4){1.f, 0.f, 1.f, 0.f};
                if (latent) { const int tok = row - CTX; const int pos = half ? (tok & (GRID_W - 1)) : (tok / GRID_W); const float* rp = rope + (size_t)(pos * 32 + 8 * fq) * 2;
#pragma unroll
                    for (int q = 0; q < 4; ++q) c4[q] = *(const f32x4*)(rp + 4 * q); } };
            ldcs(0, csn);
#pragma unroll
            for (int ai = 0; ai < 2; ++ai)
#pragma unroll
                for (int m = 0; m < 4; ++m) {
                    const int row = row0 + ai * HALF + m * 16;
                    f32x4 cs[4];
#pragma unroll
                    for (int q = 0; q < 4; ++q) cs[q] = csn[q];
                    if (ai * 4 + m < 7) ldcs(ai * 4 + m + 1, csn);
                    float o1[8], o2[8];
#pragma unroll
                    for (int n = 0; n < 2; ++n) { const f32x4 t1 = acc[ai][0][m][n] * ks, t2 = acc[ai][1][m][n] * ks;
#pragma unroll
                        for (int j = 0; j < 4; ++j) { const int e = 4 * n + j; const float c = cs[e >> 1][2 * (e & 1)], sn = cs[e >> 1][2 * (e & 1) + 1];
                            o1[e] = t1[j] * c - t2[j] * sn; o2[e] = t1[j] * sn + t2[j] * c; } }
                    bf16* dst = ZB + (size_t)row * N_IN + pn * BM + 64 * wc + 8 * fq;
                    u32x4 w1, w2; w1.x = cvt_pk_bf16(o1[0], o1[1]); w1.y = cvt_pk_bf16(o1[2], o1[3]); w1.z = cvt_pk_bf16(o1[4], o1[5]); w1.w = cvt_pk_bf16(o1[6], o1[7]);
                    w2.x = cvt_pk_bf16(o2[0], o2[1]); w2.y = cvt_pk_bf16(o2[2], o2[3]); w2.z = cvt_pk_bf16(o2[4], o2[5]); w2.w = cvt_pk_bf16(o2[6], o2[7]);
                    *(u32x4*)dst = w1; *(u32x4*)(dst + 32) = w2;
                }
            return;
        }
        bf16* tile = ZB + (size_t)row0 * N_IN + pn * BM + wc * 64 + 8 * fq;
        if (pn >= 22) store_gate_tile(acc, (unsigned char*)ZB + (size_t)row0 * (N_IN * 2) + 2 * C_GATE + (pn * BM - C_GATE) + wc * 64 + 8 * fq);
        else if (pn < 12 || (pn >= 16 && pn < 18)) store_tile<0>(acc, tile);
        else if (pn < 16) store_tile<1>(acc, tile);
        else store_tile<2>(acc, tile);
    }
    __device__ __forceinline__ void store_gate_tile(f32x4 (&acc)[2][2][4][2], unsigned char* tile) const {
#pragma unroll
        for (int ai = 0; ai < 2; ++ai)
#pragma unroll
            for (int m = 0; m < 4; ++m) {
                unsigned char* rowp = tile + (size_t)(ai * HALF + m * 16) * (N_IN * 2);
#pragma unroll
                for (int bj = 0; bj < 2; ++bj) {
                    unsigned q[8];
#pragma unroll
                    for (int j = 0; j < 8; ++j) { const float z = j < 4 ? acc[ai][bj][m][0][j] : acc[ai][bj][m][1][j - 4];
                        const float g = __builtin_amdgcn_rcpf(1.f + __builtin_amdgcn_exp2f(z * -LOG2E));
                        q[j] = (unsigned)__builtin_amdgcn_fmed3f(g * 255.f + 0.5f, 1.f, 255.f); }
                    u32x2 w; w.x = q[0] | (q[1] << 8) | (q[2] << 16) | (q[3] << 24); w.y = q[4] | (q[5] << 8) | (q[6] << 16) | (q[7] << 24);
                    *(u32x2*)(rowp + bj * 32) = w;
                }
            }
    }
    template <int MODE>
    __device__ __forceinline__ void store_tile(f32x4 (&acc)[2][2][4][2], bf16* tile) const {
#pragma unroll
        for (int ai = 0; ai < 2; ++ai)
#pragma unroll
            for (int m = 0; m < 4; ++m) {
                bf16* rowp = tile + (size_t)(ai * HALF + m * 16) * N_IN;
#pragma unroll
                for (int bj = 0; bj < 2; ++bj) {
                    float v[8];
#pragma unroll
                    for (int j = 0; j < 4; ++j) { v[j] = acc[ai][bj][m][0][j]; v[4 + j] = acc[ai][bj][m][1][j]; }
#pragma unroll
                    for (int j = 0; j < 8; ++j) {
                        if (MODE == 1) v[j] = silu_f(v[j]);
                        else if (MODE == 2) v[j] = gelu_tanh_f(v[j]);
                        else if (MODE == 3) v[j] = 1.f + __expf(-fminf(fmaxf(v[j], -30.f), 30.f));
                    }
                    u32x4 w; w.x = cvt_pk_bf16(v[0], v[1]); w.y = cvt_pk_bf16(v[2], v[3]); w.z = cvt_pk_bf16(v[4], v[5]); w.w = cvt_pk_bf16(v[6], v[7]);
                    *(u32x4*)(rowp + bj * 32) = w;
                }
            }
    }
};
struct EpiBranch { static constexpr bool PRETOUCH = false;          P2(0)
    static constexpr bool PERM = true, KEEP = true;
    const bf16* ZB; bf16* Y;
    __device__ __forceinline__ bool keep(const Unit& u) const { return u.kind < 2; }
    __device__ __forceinline__ void operator()(f32x4 (&acc)[2][2][4][2], const Unit& u, int wr, int wc, int fr, int fq) const {
        const int kind = u.kind, rowu = u.pm * BM + wr * 64, colu = u.pn * BM + wc * 64;
        const unsigned char* gb = (const unsigned char*)ZB + (size_t)rowu * (N_IN * 2) + 2 * C_GATE + colu + kind * D;
        const int dstep = kind < 2 ? D : 0;
        const unsigned glo = (unsigned)(fr * (N_IN * 2) + 8 * fq);
        const bool fin = kind == 2;
#pragma unroll
        for (int ai = 0; ai < 2; ++ai) {
            u32x2 nm[4][2], dn[4][2];
#pragma unroll
            for (int m = 0; m < 4; ++m)
#pragma unroll
                for (int bj = 0; bj < 2; ++bj) { const unsigned char* p = gb + (size_t)(ai * HALF + m * 16) * (N_IN * 2) + bj * 32;
                    nm[m][bj] = *(const u32x2*)(p + glo); dn[m][bj] = *(const u32x2*)(p + dstep + glo); }
#pragma unroll
            for (int m = 0; m < 4; ++m)
#pragma unroll
                for (int bj = 0; bj < 2; ++bj) {
                    float sc[8];
#pragma unroll
                    for (int q = 0; q < 8; ++q) { const float n = (float)((nm[m][bj][q >> 2] >> (8 * (q & 3))) & 255u), r = __builtin_amdgcn_rcpf((float)((dn[m][bj][q >> 2] >> (8 * (q & 3))) & 255u));
                        sc[q] = n * (fin ? (1.f / 255.f) : r); }
#pragma unroll
                    for (int j = 0; j < 4; ++j) { acc[ai][bj][m][0][j] *= sc[j]; acc[ai][bj][m][1][j] *= sc[4 + j]; }
                }
        }
        if (fin) {
            bf16* yb = Y + (size_t)rowu * D + colu; const unsigned ylo = (unsigned)(fr * (D * 2) + 16 * fq);
#pragma unroll
            for (int ai = 0; ai < 2; ++ai)
#pragma unroll
                for (int m = 0; m < 4; ++m)
#pragma unroll
                    for (int bj = 0; bj < 2; ++bj) { const f32x4 a = acc[ai][bj][m][0], b = acc[ai][bj][m][1]; u32x4 w; w.x = cvt_pk_bf16(a[0], a[1]); w.y = cvt_pk_bf16(a[2], a[3]); w.z = cvt_pk_bf16(b[0], b[1]); w.w = cvt_pk_bf16(b[2], b[3]);
                        *(u32x4*)((unsigned char*)(yb + (size_t)(ai * HALF + m * 16) * D + bj * 32) + ylo) = w; }
        }
    }
};
struct EpiResid {            P2(0)
    static constexpr bool PERM = true, KEEP = false;
    bf16* X; const float* modl; int gi; float dry;
    __device__ __forceinline__ bool keep(const Unit&) const { return false; }
    __device__ __forceinline__ void operator()(f32x4 (&acc)[2][2][4][2], const Unit& u, int wr, int wc, int fr, int fq) const {
        const int row0 = u.pm * BM + wr * 64 + fr, col0 = u.pn * BM + wc * 64 + 8 * fq;
        const float* gate = modl + (size_t)(u.pm > 0 ? 1 : 0) * 6 * D + gi * D + col0;
        f32x4 gv[2][2];
#pragma unroll
        for (int bj = 0; bj < 2; ++bj)
#pragma unroll
            for (int n = 0; n < 2; ++n) gv[bj][n] = *(const f32x4*)(gate + bj * 32 + n * 4) * dry;
#pragma unroll
        for (int ai = 0; ai < 2; ++ai) {
            u32x4 xa[4][2];
#pragma unroll
            for (int m = 0; m < 4; ++m)
#pragma unroll
                for (int bj = 0; bj < 2; ++bj) xa[m][bj] = *(const u32x4*)(X + (size_t)(row0 + ai * HALF + m * 16) * D + col0 + bj * 32);
#pragma unroll
            for (int m = 0; m < 4; ++m) { bf16* rowp = X + (size_t)(row0 + ai * HALF + m * 16) * D + col0;
#pragma unroll
                for (int bj = 0; bj < 2; ++bj) { const f32x4 a = acc[ai][bj][m][0] * gv[bj][0], b = acc[ai][bj][m][1] * gv[bj][1]; const u32x4 x = xa[m][bj]; u32x4 w;
                    w.x = cvt_pk_bf16(bflo(x.x) + a[0], bfhi(x.x) + a[1]); w.y = cvt_pk_bf16(bflo(x.y) + a[2], bfhi(x.y) + a[3]);
                    w.z = cvt_pk_bf16(bflo(x.z) + b[0], bfhi(x.z) + b[1]); w.w = cvt_pk_bf16(bflo(x.w) + b[2], bfhi(x.w) + b[3]);
                    *(u32x4*)(rowp + bj * 32) = w; }
            }
        }
    }
};
template <bool FINAL>
struct EpiResidNorm {
    static constexpr bool PERM = true, KEEP = false;
    bf16* X; const float* modl; int gi; const float* ng; float* out; unsigned* xch; unsigned* cnt; LAS unsigned char* tab; unsigned want; bf16* H; const float* sc; const float* sh;
    __device__ __forceinline__ bool keep(const Unit&) const { return false; }
    __device__ __forceinline__ void operator()(f32x4 (&acc)[2][2][4][2], const Unit& u, int wr, int wc, int fr, int fq) const {
        const int lane = fq * 16 + fr, wid = wr * 4 + wc;
        const int row0 = u.pm * BM + wr * 64 + fr, col0 = u.pn * BM + wc * 64 + 8 * fq;
        LAS float* P = (LAS float*)tab; LAS float* S = (LAS float*)(tab + 4096);
        {
            const float* gate = modl + (size_t)6 * D + gi * D + col0;
            f32x4 gv[2][2];
#pragma unroll
            for (int bj = 0; bj < 2; ++bj)
#pragma unroll
                for (int n = 0; n < 2; ++n) gv[bj][n] = *(const f32x4*)(gate + bj * 32 + n * 4);
#pragma unroll
            for (int ai = 0; ai < 2; ++ai) {
                u32x4 xa[4][2];
#pragma unroll
                for (int m = 0; m < 4; ++m)
#pragma unroll
                    for (int bj = 0; bj < 2; ++bj) xa[m][bj] = *(const u32x4*)(X + (size_t)(row0 + ai * HALF + m * 16) * D + col0 + bj * 32);
#pragma unroll
                for (int m = 0; m < 4; ++m) { float ss = 0.f;
#pragma unroll
                    for (int bj = 0; bj < 2; ++bj) { const f32x4 a = acc[ai][bj][m][0] * gv[bj][0], b = acc[ai][bj][m][1] * gv[bj][1]; const u32x4 x = xa[m][bj]; u32x4 w;
                        w.x = cvt_pk_bf16(bflo(x.x) + a[0], bfhi(x.x) + a[1]); w.y = cvt_pk_bf16(bflo(x.y) + a[2], bfhi(x.y) + a[3]);
                        w.z = cvt_pk_bf16(bflo(x.z) + b[0], bfhi(x.z) + b[1]); w.w = cvt_pk_bf16(bflo(x.w) + b[2], bfhi(x.w) + b[3]);
                        if (!FINAL) *(u32x4*)(X + (size_t)(row0 + ai * HALF + m * 16) * D + col0 + bj * 32) = w;
                        const f32x4 v0 = (f32x4){bflo(w.x), bfhi(w.x), bflo(w.y), bfhi(w.y)}, v1 = (f32x4){bflo(w.z), bfhi(w.z), bflo(w.w), bfhi(w.w)};
                        acc[ai][bj][m][0] = v0; acc[ai][bj][m][1] = v1;
                        ss += ((v0[0] * v0[0] + v0[1] * v0[1]) + (v0[2] * v0[2] + v0[3] * v0[3])) + ((v1[0] * v1[0] + v1[1] * v1[1]) + (v1[2] * v1[2] + v1[3] * v1[3])); }
                    ss += __shfl_xor(ss, 16); ss += __shfl_xor(ss, 32);
                    if (fq == 0) P[(ai * HALF + wr * 64 + m * 16 + fr) * 4 + wc] = ss; }
            }
        }
        asm volatile("s_waitcnt lgkmcnt(0)" ::: "memory"); __builtin_amdgcn_s_barrier(); asm volatile("" ::: "memory");
        const int prow = wid * 32 + (lane & 31);
        if (lane < 32) { const float t = (P[prow * 4 + 0] + P[prow * 4 + 1]) + (P[prow * 4 + 2] + P[prow * 4 + 3]);
            __hip_atomic_store(xch + (size_t)(u.pm * BM + prow) * 8 + u.pn, __float_as_uint(t), __ATOMIC_RELAXED, __HIP_MEMORY_SCOPE_AGENT); }
        asm volatile("s_waitcnt vmcnt(0)" ::: "memory");
        if (lane == 0) __hip_atomic_fetch_add(cnt + 64 * u.pm, 1u, __ATOMIC_RELAXED, __HIP_MEMORY_SCOPE_AGENT);
        if (wid == 0) { unsigned sp = 0;
            while ((unsigned)__builtin_amdgcn_readfirstlane(__hip_atomic_load(cnt + 64 * u.pm, __ATOMIC_RELAXED, __HIP_MEMORY_SCOPE_AGENT)) < want && ++sp < (1u << 20)) __builtin_amdgcn_s_sleep(2);
            __builtin_amdgcn_fence(__ATOMIC_ACQUIRE, "agent"); }
        asm volatile("s_waitcnt vmcnt(0) lgkmcnt(0)" ::: "memory"); __builtin_amdgcn_s_barrier(); asm volatile("" ::: "memory");
        if (lane < 32) { const unsigned* sl = xch + (size_t)(u.pm * BM + prow) * 8; float tot = 0.f;
#pragma unroll
            for (int t = 0; t < 8; ++t) tot += __uint_as_float(__hip_atomic_load(sl + t, __ATOMIC_RELAXED, __HIP_MEMORY_SCOPE_AGENT));
            S[prow] = rsqrtf(tot * (1.f / D) + EPS); }
        asm volatile("s_waitcnt vmcnt(0) lgkmcnt(0)" ::: "memory"); __builtin_amdgcn_s_barrier(); asm volatile("" ::: "memory");
        f32x4 gg[2][2], hh[2][2];
#pragma unroll
        for (int bj = 0; bj < 2; ++bj)
#pragma unroll
            for (int n = 0; n < 2; ++n) { gg[bj][n] = *(const f32x4*)(ng + col0 + bj * 32 + n * 4);
                if (!FINAL) { gg[bj][n] = gg[bj][n] * (*(const f32x4*)(sc + col0 + bj * 32 + n * 4) + 1.f); hh[bj][n] = *(const f32x4*)(sh + col0 + bj * 32 + n * 4); } }
#pragma unroll
        for (int ai = 0; ai < 2; ++ai)
#pragma unroll
            for (int m = 0; m < 4; ++m) { const float r = S[ai * HALF + wr * 64 + m * 16 + fr]; const size_t ro = (size_t)(row0 + ai * HALF + m * 16);
#pragma unroll
                for (int bj = 0; bj < 2; ++bj) {
                    if (FINAL) { float* op = out + (ro - CTX) * D + col0 + bj * 32; *(f32x4*)op = acc[ai][bj][m][0] * r * gg[bj][0]; *(f32x4*)(op + 4) = acc[ai][bj][m][1] * r * gg[bj][1]; }
                    else { const f32x4 a = acc[ai][bj][m][0] * r * gg[bj][0] + hh[bj][0], b = acc[ai][bj][m][1] * r * gg[bj][1] + hh[bj][1]; u32x4 w;
                        w.x = cvt_pk_bf16(a[0], a[1]); w.y = cvt_pk_bf16(a[2], a[3]); w.z = cvt_pk_bf16(b[0], b[1]); w.w = cvt_pk_bf16(b[2], b[3]);
                        *(u32x4*)(H + ro * D + col0 + bj * 32) = w; } } }
    }
};
struct EpiRelu2 {            P2(2)
    static constexpr bool PERM = true, KEEP = false;
    bf16* O;
    __device__ __forceinline__ bool keep(const Unit&) const { return false; }
    __device__ __forceinline__ void operator()(f32x4 (&acc)[2][2][4][2], const Unit& u, int wr, int wc, int fr, int fq) const {
        const int row0 = u.pm * BM + wr * 64 + fr, col0 = u.pn * BM + wc * 64 + 8 * fq;
#pragma unroll
        for (int ai = 0; ai < 2; ++ai)
#pragma unroll
            for (int m = 0; m < 4; ++m) { bf16* rowp = O + (size_t)(row0 + ai * HALF + m * 16) * DFF + col0;
#pragma unroll
                for (int bj = 0; bj < 2; ++bj) { f32x4 a = acc[ai][bj][m][0], b = acc[ai][bj][m][1];
#pragma unroll
                    for (int j = 0; j < 4; ++j) { const float x = fmaxf(a[j], 0.f), y = fmaxf(b[j], 0.f); a[j] = x * x; b[j] = y * y; }
                    u32x4 w; w.x = cvt_pk_bf16(a[0], a[1]); w.y = cvt_pk_bf16(a[2], a[3]); w.z = cvt_pk_bf16(b[0], b[1]); w.w = cvt_pk_bf16(b[2], b[3]);
                    *(u32x4*)(rowp + bj * 32) = w; } }
    }
};

__device__ __forceinline__ int rope_src_col(int nv) {
    if (nv >= 2048) return nv;
    const int v = nv & 127, wc = v >> 5, fq = (v >> 3) & 3, n = (v >> 2) & 1, j = v & 3;
    return (nv & ~127) + 64 * (wc >> 1) + 16 * (wc & 1) + 4 * fq + j + 32 * n;
}
__device__ __forceinline__ void p0_transpose_item(const float* W, int N, bf16* WT, int ld, int koff, bool ropeperm, LAS float* scr, int item, int lane) {
    const int nblk = N / 32, kb = item / nblk, nb = item % nblk, k0 = 64 * kb, n0 = 32 * nb;
    const int nsrc = ropeperm ? rope_src_col(n0 + (lane & 31)) : n0 + (lane & 31);
#pragma unroll 8
    for (int i = 0; i < 32; ++i) { const int kk = 2 * i + (lane >> 5); scr[kk * 33 + (lane & 31)] = W[(size_t)(k0 + kk) * N + nsrc]; }
    LDS_WAIT(); asm volatile("" ::: "memory");
    const int c = lane & 7;
#pragma unroll
    for (int j = 0; j < 4; ++j) { const int n = (lane >> 3) + 8 * j; const LAS float* s = scr + (8 * c) * 33 + n;
        u32x4 o; o.x = pk2(s[0 * 33], s[1 * 33]); o.y = pk2(s[2 * 33], s[3 * 33]); o.z = pk2(s[4 * 33], s[5 * 33]); o.w = pk2(s[6 * 33], s[7 * 33]);
        *(u32x4*)(WT + (size_t)(n0 + n) * ld + koff + k0 + 8 * c) = o; }
    LDS_WAIT(); asm volatile("" ::: "memory");
}
__device__ __forceinline__ void p0_prologue(Frame& F) {
    const float* const __attribute__((address_space(4)))* in = F.in;
    const int gw = F.bid * 8 + F.wave, NGW = F.G * 8, lane = F.lane;
    const int gt = F.bid * 512 + F.tid, NGT = F.G * 512;
    {
        float* MOD = (float*)(F.ws + WS_MODP);
        constexpr int NJB = 6 * D / 256, NKQ = 16, KS = D / NKQ;
        for (int it = gw; it < DEPTH * NJB * NKQ; it += NGW) {
            const int l = it / (NJB * NKQ), r = it % (NJB * NKQ), jb = r / NKQ, kq = r % NKQ;
            const float* W = in[I_WADA] + ((size_t)l * D + kq * KS) * 6 * D + jb * 256 + lane * 4;
            f32x4 a0 = (f32x4){0.f, 0.f, 0.f, 0.f}, a1 = a0;
#pragma unroll 16
            for (int k = 0; k < KS; ++k) { const f32x4 w = __builtin_nontemporal_load((const f32x4*)(W + (size_t)k * 6 * D)); const float s0 = silu_f(in[I_CCTX][kq * KS + k]), s1 = silu_f(in[I_C][kq * KS + k]); a0 += w * s0; a1 += w * s1; }
            if (kq == 0) { const f32x4 b = *(const f32x4*)(in[I_BADA] + (size_t)l * 6 * D + jb * 256 + lane * 4); a0 += b; a1 += b; }
            float* o0 = MOD + (size_t)kq * (DEPTH * 2 * 6 * D) + ((size_t)l * 2 + 0) * 6 * D + jb * 256 + lane * 4;
            *(f32x4*)o0 = a0; *(f32x4*)(o0 + 6 * D) = a1;
        }
    }
    {
        LAS float* scr = (LAS float*)(F.lds + F.wave * 16640);
        constexpr int I_IN = (D / 64) * (N_IN / 64), I_BR = (RET_W / 64) * (D / 64), I_BP = (POOL_W / 64) * (D / 64), I_SQ = (D / 64) * (D / 64), I_F1 = (D / 64) * (DFF / 64), I_F2 = (DFF / 64) * (D / 64);
        constexpr int PER_L = I_IN + I_BR + 2 * I_BP + I_SQ + I_F1 + I_F2, TOTAL = DEPTH * PER_L;
        static_assert(8 * 16640 <= SCR_BYTES, "transposer LDS");
        unsigned char* ws = F.ws;
        auto decode = [&](int it, const float*& src, bf16*& dst, int& N, int& ld) {
            const int l = it / PER_L; int r = it % PER_L; const float* W; bf16* WT; int koff = 0, kb, nb;
            if (r < I_IN) { W = in[I_WIN] + (size_t)l * D * N_IN; N = N_IN; WT = (bf16*)(ws + WS_WIN + l * SZ_WIN); ld = D; kb = r / (N_IN / 64); nb = r % (N_IN / 64); }
            else if ((r -= I_IN) < I_BR) { W = in[I_WBR] + (size_t)l * RET_W * D; N = D; WT = (bf16*)(ws + WS_WCAT + l * SZ_WSQ); ld = D; kb = r / (D / 64); nb = r % (D / 64); }
            else if ((r -= I_BR) < I_BP) { W = in[I_WBP] + (size_t)l * POOL_W * D; N = D; WT = (bf16*)(ws + WS_WCAT + l * SZ_WSQ); ld = D; koff = RET_W; kb = r / (D / 64); nb = r % (D / 64); }
            else if ((r -= I_BP) < I_BP) { W = in[I_WBS] + (size_t)l * SG_W * D; N = D; WT = (bf16*)(ws + WS_WCAT + l * SZ_WSQ); ld = D; koff = RET_W + POOL_W; kb = r / (D / 64); nb = r % (D / 64); }
            else if ((r -= I_BP) < I_SQ) { W = in[I_WOUT] + (size_t)l * D * D; N = D; WT = (bf16*)(ws + WS_WOUT + l * SZ_WSQ); ld = D; kb = r / (D / 64); nb = r % (D / 64); }
            else if ((r -= I_SQ) < I_F1) { W = in[I_W1] + (size_t)l * D * DFF; N = DFF; WT = (bf16*)(ws + WS_W1 + l * SZ_WFF); ld = D; kb = r / (DFF / 64); nb = r % (DFF / 64); }
            else { r -= I_F1; W = in[I_W2] + (size_t)l * DFF * D; N = D; WT = (bf16*)(ws + WS_W2 + l * SZ_WFF); ld = DFF; kb = r / (D / 64); nb = r % (D / 64); }
            const int k0 = 64 * kb, n0 = 64 * nb;
            src = W + (size_t)k0 * N + n0;
            dst = WT + (size_t)n0 * ld + koff + k0;
        };
#define P0_LOAD(buf, srcu, Nu) do { const unsigned loff_ = (unsigned)(((lane >> 5) * (Nu) + 2 * (lane & 31)) * 4); \
            _Pragma("unroll") for (int i = 0; i < 32; ++i) buf[i] = __builtin_nontemporal_load((const f32x2*)((const char*)((srcu) + (size_t)(2 * i) * (Nu)) + loff_)); } while (0)
        f32x2 bufA[32], bufB[32];
        const float* sA; bf16* dA; int NA, ldA; const float* sB; bf16* dB; int NB, ldB;
        auto process = [&](f32x2 (&buf)[32], bf16* dst, int ld) {
#pragma unroll
            for (int i = 0; i < 32; ++i) { LAS float* q = scr + (2 * i + (lane >> 5)) * 65 + 2 * (lane & 31); q[0] = buf[i][0]; q[1] = buf[i][1]; }
            LDS_WAIT(); asm volatile("" ::: "memory");
            const int c = lane & 7;
#pragma unroll
            for (int j = 0; j < 8; ++j) { const int n = (lane >> 3) + 8 * j; const LAS float* p = scr + (8 * c) * 65 + n;
                u32x4 o; o.x = pk2(p[0 * 65], p[1 * 65]); o.y = pk2(p[2 * 65], p[3 * 65]); o.z = pk2(p[4 * 65], p[5 * 65]); o.w = pk2(p[6 * 65], p[7 * 65]);
                *(u32x4*)(dst + (size_t)n * ld + 8 * c) = o; }
            LDS_WAIT(); asm volatile("" ::: "memory");
        };
        int it = gw;
        if (it < TOTAL) {
            decode(it, sA, dA, NA, ldA);
            P0_LOAD(bufA, sA, NA);
            for (;;) {
                const int i1 = it + NGW;
                decode(i1 < TOTAL ? i1 : it, sB, dB, NB, ldB);
                P0_LOAD(bufB, sB, NB);
                process(bufA, dA, ldA);
                if (i1 >= TOTAL) break;
                const int i2 = i1 + NGW;
                decode(i2 < TOTAL ? i2 : i1, sA, dA, NA, ldA);
                P0_LOAD(bufA, sA, NA);
                process(bufB, dB, ldB);
                if (i2 >= TOTAL) break;
                it = i2;
            }
        }
#undef P0_LOAD
    }
    {
        bf16* PWT = (bf16*)(F.ws + WS_PWT); bf16* SGW = (bf16*)(F.ws + WS_SGW); float* ROPE = (float*)(F.ws + WS_ROPE);
        for (int i = gt; i < DEPTH * 4 * 128 * 128; i += NGT) {
            const int lg = i >> 14, d = (i >> 7) & 127, c = i & 127;
            PWT[i] = (bf16)f2bf(in[I_PW][(size_t)lg * 16384 + c * 128 + d]);
            SGW[i] = (bf16)f2bf(in[I_SGW][i]);
        }
        for (int i = gt; i < 128 * 32; i += NGT) { const int pos = i >> 5, f = i & 31; const float inv = powf(10000.f, -(float)f / 32.f); const float ang = (float)pos * inv; ROPE[2 * i] = cosf(ang); ROPE[2 * i + 1] = sinf(ang); }
    }
}

__device__ __forceinline__ void mod_reduce_phase(Frame& F) {
    const float* P = (const float*)(F.ws + WS_MODP); float* MOD = (float*)(F.ws + WS_MOD);
    for (int i = F.bid * 512 + F.tid; i < DEPTH * 2 * 6 * D; i += F.G * 512) { float s = 0.f;
#pragma unroll
        for (int k = 0; k < 16; ++k) s += P[(size_t)k * (DEPTH * 2 * 6 * D) + i];
        MOD[i] = s; }
}
__device__ __forceinline__ void norm_phase(Frame& F, const float* g, const float* modl, int si, bool first, const float* slab_gate = nullptr) {
    bf16* X = (bf16*)(F.ws + WS_X); bf16* H = (bf16*)(F.ws + WS_H);
    const int gw = F.bid * 8 + F.wave, NGW = F.G * 8, lane = F.lane;
    if (slab_gate) {
        LAS float* red = (LAS float*)F.lds;
        for (int row = F.bid; row < CTX; row += F.G) {
            const int c = 256 * F.wave + 4 * lane;
            const float* SL = (const float*)(F.ws + WS_SLAB) + (size_t)row * D + c;
            f32x4 sm = *(const f32x4*)SL;
#pragma unroll
            for (int k = 1; k < 4; ++k) sm += *(const f32x4*)(SL + (size_t)k * CTX * D);
            const u32x2 xo = *(const u32x2*)(X + (size_t)row * D + c); const f32x4 gt = *(const f32x4*)(slab_gate + c);
            u32x2 xn; xn.x = cvt_pk_bf16(bflo(xo.x) + gt[0] * sm[0], bfhi(xo.x) + gt[1] * sm[1]); xn.y = cvt_pk_bf16(bflo(xo.y) + gt[2] * sm[2], bfhi(xo.y) + gt[3] * sm[3]);
            *(u32x2*)(X + (size_t)row * D + c) = xn;
            const float v0 = bflo(xn.x), v1 = bfhi(xn.x), v2 = bflo(xn.y), v3 = bfhi(xn.y);
            const float ps = wave_sum((v0 * v0 + v1 * v1) + (v2 * v2 + v3 * v3));
            __syncthreads();
            if (lane == 0) red[F.wave] = ps;
            __syncthreads();
            float tot = 0.f;
#pragma unroll
            for (int k = 0; k < 8; ++k) tot += red[k];
            const float r = rsqrtf(tot * (1.f / D) + EPS);
            const f32x4 gg = *(const f32x4*)(g + c), sc = *(const f32x4*)(modl + (si + 1) * D + c), sh = *(const f32x4*)(modl + si * D + c);
            u32x2 w; w.x = cvt_pk_bf16(v0 * r * gg[0] * (sc[0] + 1.f) + sh[0], v1 * r * gg[1] * (sc[1] + 1.f) + sh[1]); w.y = cvt_pk_bf16(v2 * r * gg[2] * (sc[2] + 1.f) + sh[2], v3 * r * gg[3] * (sc[3] + 1.f) + sh[3]);
            *(u32x2*)(H + (size_t)row * D + c) = w;
        }
    }
    if (!first) {
        int row = slab_gate ? CTX + gw : gw;
        u32x4 cur[4], nxt[4];
        if (row < MROWS) {
#pragma unroll
            for (int j = 0; j < 4; ++j) cur[j] = *(const u32x4*)(X + (size_t)row * D + j * 512 + lane * 8);
        }
        while (row < MROWS) {
            const int nrow = row + NGW;
            if (nrow < MROWS) {
#pragma unroll
                for (int j = 0; j < 4; ++j) nxt[j] = *(const u32x4*)(X + (size_t)nrow * D + j * 512 + lane * 8);
            }
            float v[32]; float s = 0.f;
#pragma unroll
            for (int j = 0; j < 4; ++j)
#pragma unroll
                for (int e = 0; e < 4; ++e) { v[8 * j + 2 * e] = bflo(cur[j][e]); v[8 * j + 2 * e + 1] = bfhi(cur[j][e]); }
#pragma unroll
            for (int e = 0; e < 32; ++e) s += v[e] * v[e];
            const float r = rsqrtf(wave_sum(s) * (1.f / D) + EPS);
            const float* m = modl + (size_t)(row < CTX ? 0 : 1) * 6 * D;
#pragma unroll
            for (int j = 0; j < 4; ++j) { const int c = j * 512 + lane * 8; float o[8];
#pragma unroll
                for (int h = 0; h < 2; ++h) { const f32x4 gg = *(const f32x4*)(g + c + 4 * h), sc = *(const f32x4*)(m + (si + 1) * D + c + 4 * h), sh = *(const f32x4*)(m + si * D + c + 4 * h);
#pragma unroll
                    for (int e = 0; e < 4; ++e) o[4 * h + e] = v[8 * j + 4 * h + e] * r * gg[e] * (sc[e] + 1.f) + sh[e]; }
                u32x4 w; w.x = cvt_pk_bf16(o[0], o[1]); w.y = cvt_pk_bf16(o[2], o[3]); w.z = cvt_pk_bf16(o[4], o[5]); w.w = cvt_pk_bf16(o[6], o[7]);
                *(u32x4*)(H + (size_t)row * D + c) = w; }
#pragma unroll
            for (int j = 0; j < 4; ++j) cur[j] = nxt[j];
            row = nrow;
        }
        return;
    }
    for (int row = slab_gate ? CTX + gw : gw; row < MROWS; row += NGW) {
        float v[32]; float s = 0.f;
        if (first) {
            const float* src = row < CTX ? F.in[I_CTX] + (size_t)row * D : F.in[I_X] + (size_t)(row - CTX) * D;
#pragma unroll
            for (int j = 0; j < 4; ++j) { const f32x4 a = *(const f32x4*)(src + j * 512 + lane * 8), b = *(const f32x4*)(src + j * 512 + lane * 8 + 4);
#pragma unroll
                for (int e = 0; e < 4; ++e) { v[8 * j + e] = a[e]; v[8 * j + 4 + e] = b[e]; }
                u32x4 w; w.x = cvt_pk_bf16(a[0], a[1]); w.y = cvt_pk_bf16(a[2], a[3]); w.z = cvt_pk_bf16(b[0], b[1]); w.w = cvt_pk_bf16(b[2], b[3]);
                *(u32x4*)(X + (size_t)row * D + j * 512 + lane * 8) = w; }
        } else {
#pragma unroll
            for (int j = 0; j < 4; ++j) { const u32x4 x = *(const u32x4*)(X + (size_t)row * D + j * 512 + lane * 8);
#pragma unroll
                for (int e = 0; e < 4; ++e) { v[8 * j + 2 * e] = bflo(x[e]); v[8 * j + 2 * e + 1] = bfhi(x[e]); } }
        }
#pragma unroll
        for (int e = 0; e < 32; ++e) s += v[e] * v[e];
        const float r = rsqrtf(wave_sum(s) * (1.f / D) + EPS);
        const float* m = modl + (size_t)(row < CTX ? 0 : 1) * 6 * D;
#pragma unroll
        for (int j = 0; j < 4; ++j) { const int c = j * 512 + lane * 8; float o[8];
#pragma unroll
            for (int h = 0; h < 2; ++h) { const f32x4 gg = *(const f32x4*)(g + c + 4 * h), sc = *(const f32x4*)(m + (si + 1) * D + c + 4 * h), sh = *(const f32x4*)(m + si * D + c + 4 * h);
#pragma unroll
                for (int e = 0; e < 4; ++e) o[4 * h + e] = v[8 * j + 4 * h + e] * r * gg[e] * (sc[e] + 1.f) + sh[e]; }
            u32x4 w; w.x = cvt_pk_bf16(o[0], o[1]); w.y = cvt_pk_bf16(o[2], o[3]); w.z = cvt_pk_bf16(o[4], o[5]); w.w = cvt_pk_bf16(o[6], o[7]);
            *(u32x4*)(H + (size_t)row * D + c) = w; }
    }
}
#ifndef FUSE_FINAL
#define FUSE_FINAL 1
#endif
__device__ __forceinline__ void final_norm_phase(Frame& F, float* out) {
    if (FUSE_FINAL) return;
    const bf16* X = (const bf16*)(F.ws + WS_X); const float* g = F.in[I_FNG];
    const int gw = F.bid * 8 + F.wave, NGW = F.G * 8, lane = F.lane;
    u32x4 cur[4], nxt[4];
    if (gw < SEQ) {
#pragma unroll
        for (int j = 0; j < 4; ++j) cur[j] = *(const u32x4*)(X + (size_t)(gw + CTX) * D + j * 512 + lane * 8);
    }
    for (int row = gw; row < SEQ; row += NGW) {
        if (row + NGW < SEQ) {
#pragma unroll
            for (int j = 0; j < 4; ++j) nxt[j] = *(const u32x4*)(X + (size_t)(row + NGW + CTX) * D + j * 512 + lane * 8);
        }
        float v[32]; float s = 0.f;
#pragma unroll
        for (int j = 0; j < 4; ++j) { const u32x4 x = cur[j];
#pragma unroll
            for (int e = 0; e < 4; ++e) { v[8 * j + 2 * e] = bflo(x[e]); v[8 * j + 2 * e + 1] = bfhi(x[e]); } }
#pragma unroll
        for (int e = 0; e < 32; ++e) s += v[e] * v[e];
        const float r = rsqrtf(wave_sum(s) * (1.f / D) + EPS);
#pragma unroll
        for (int j = 0; j < 4; ++j) { const int c = j * 512 + lane * 8;
#pragma unroll
            for (int h = 0; h < 2; ++h) { const f32x4 gg = *(const f32x4*)(g + c + 4 * h); f32x4 o;
#pragma unroll
                for (int e = 0; e < 4; ++e) o[e] = v[8 * j + 4 * h + e] * r * gg[e];
                *(f32x4*)(out + (size_t)row * D + c + 4 * h) = o; } }
#pragma unroll
        for (int j = 0; j < 4; ++j) cur[j] = nxt[j];
    }
}

#define MFMA16(a, b, c) __builtin_amdgcn_mfma_f32_16x16x32_bf16((a), (b), (c), 0, 0, 0)
template <bool TWO>
__device__ __forceinline__ void fill_transposed(LAS unsigned char* T0, LAS unsigned char* T1, const bf16* src, size_t ld, int tid, float sc0, float sc1, bool scaled) {
    const int s = tid & 127, dq = tid >> 7;
    const bf16* rp = src + (size_t)s * ld + 32 * dq;
    u32x4 v[4];
#pragma unroll
    for (int kk = 0; kk < 4; ++kk) v[kk] = *(const u32x4*)(rp + 8 * kk);
#pragma unroll
    for (int kk = 0; kk < 4; ++kk)
#pragma unroll
        for (int q = 0; q < 4; ++q) {
            const int d = 32 * dq + 8 * kk + 2 * q; const unsigned w = v[kk][q];
            if (scaled) { const float lo = bflo(w), hi = bfhi(w);
                *(LAS bf16*)(T0 + d * TP + s * 2) = (bf16)f2bf(lo * sc0); *(LAS bf16*)(T0 + (d + 1) * TP + s * 2) = (bf16)f2bf(hi * sc0);
                if (TWO) { *(LAS bf16*)(T1 + d * TP + s * 2) = (bf16)f2bf(lo * sc1); *(LAS bf16*)(T1 + (d + 1) * TP + s * 2) = (bf16)f2bf(hi * sc1); } }
            else { *(LAS bf16*)(T0 + d * TP + s * 2) = (bf16)(w & 0xffffu); *(LAS bf16*)(T0 + (d + 1) * TP + s * 2) = (bf16)(w >> 16); }
        }
}
__device__ __forceinline__ void fill_rows(LAS unsigned char* T, const bf16* src, size_t ld, int tid) {
    const int r = tid >> 4, sg = tid & 15;
    const bf16* rp = src + (size_t)r * ld + sg * 8;
    u32x4 v[4];
#pragma unroll
    for (int q = 0; q < 4; ++q) v[q] = *(const u32x4*)(rp + (size_t)(32 * q) * ld);
#pragma unroll
    for (int q = 0; q < 4; ++q) *(LAS u32x4*)(T + (r + 32 * q) * TP + sg * 16) = v[q];
}

typedef short s16x4 __attribute__((ext_vector_type(4)));
__device__ __forceinline__ bf16x8 tr_frag(const LAS unsigned char* T, int rowa, int rowb, int col0, int lane) {
    const int i = lane & 15;
    const LAS unsigned char* pa = T + (rowa + (i >> 2)) * TP + (col0 + 4 * (i & 3)) * 2;
    const LAS unsigned char* pb = T + (rowb + (i >> 2)) * TP + (col0 + 4 * (i & 3)) * 2;
    const s16x4 lo = __builtin_amdgcn_ds_read_tr16_b64_v4i16((LAS s16x4*)pa), hi = __builtin_amdgcn_ds_read_tr16_b64_v4i16((LAS s16x4*)pb);
    return (bf16x8){lo[0], lo[1], lo[2], lo[3], hi[0], hi[1], hi[2], hi[3]};
}
__device__ __forceinline__ void kv_item(Frame& F, int l, int c, int h) {
    LAS unsigned char* Kt = F.lds; LAS unsigned char* Vt = F.lds + TILE_B;
    const bf16* ZB = (const bf16*)(F.ws + WS_ZB) + (size_t)c * 128 * N_IN;
    const float* lg = F.in[I_RLOG] + (size_t)l * 2 * RET_H;
    const float l2f = log_sigmoid_f(lg[h]) * LOG2E, l2b = log_sigmoid_f(lg[RET_H + h]) * LOG2E;
    fill_rows(Kt, ZB + C_K + h * HD, N_IN, F.tid);
    fill_rows(Vt, ZB + C_V + h * HD, N_IN, F.tid);
    __syncthreads();
    const int w = F.wave, fr = F.lane & 15, fq = F.lane >> 4;
    bf16x8 vf[4], vb[4];
    float gpf[8], gpb[8];
    { const float gf = exp2f(l2f), gb = exp2f(l2b); gpf[0] = 1.f; gpb[0] = 1.f;
#pragma unroll
      for (int k = 1; k < 8; ++k) { gpf[k] = gpf[k - 1] * gf; gpb[k] = gpb[k - 1] * gb; } }
#pragma unroll
    for (int t = 0; t < 4; ++t) {
        const bf16x8 raw = tr_frag(Vt, 32 * t + 8 * fq, 32 * t + 8 * fq + 4, 16 * w, F.lane);
        const u32x4 rw = __builtin_bit_cast(u32x4, raw); u32x4 pf, pb;
        const int sg0 = 32 * t + 8 * fq;
        const float wf7 = exp2f(l2f * (float)(120 - sg0)), wb0 = exp2f(l2b * (float)sg0);
#pragma unroll
        for (int q = 0; q < 4; ++q) { const float lo = bflo(rw[q]), hi = bfhi(rw[q]);
            pf[q] = cvt_pk_bf16(lo * (wf7 * gpf[7 - 2 * q]), hi * (wf7 * gpf[6 - 2 * q]));
            pb[q] = cvt_pk_bf16(lo * (wb0 * gpb[2 * q]), hi * (wb0 * gpb[2 * q + 1])); }
        vf[t] = __builtin_bit_cast(bf16x8, pf); vb[t] = __builtin_bit_cast(bf16x8, pb);
    }
    bf16* KVT = (bf16*)(F.ws + WS_KVT) + (((size_t)c * RET_H + h) * 2) * 16384 + (size_t)(16 * w + fr) * 128 + 4 * fq;
#pragma unroll
    for (int db = 0; db < 8; ++db) {
        f32x4 af = (f32x4){0.f, 0.f, 0.f, 0.f}, ab = af;
#pragma unroll
        for (int t = 0; t < 4; ++t) {
            const bf16x8 kf = tr_frag(Kt, 32 * t + 8 * fq, 32 * t + 8 * fq + 4, 16 * db, F.lane);
            af = MFMA16(kf, vf[t], af); ab = MFMA16(kf, vb[t], ab);
        }
        u32x2 of, ob; of.x = pk2(af[0], af[1]); of.y = pk2(af[2], af[3]); ob.x = pk2(ab[0], ab[1]); ob.y = pk2(ab[2], ab[3]);
        *(u32x2*)(KVT + 16 * db) = of; *(u32x2*)(KVT + 16384 + 16 * db) = ob;
    }
    __syncthreads();
}
__device__ __forceinline__ void pool_item(Frame& F, int l, int c, int g) {
    LAS unsigned char* Pin = F.lds; LAS unsigned char* PWT = F.lds + 144 * TP; LAS unsigned char* Yl = PWT + TILE_B;
    const bf16* ZB = (const bf16*)(F.ws + WS_ZB);
    const int row0 = c * 128, tid = F.tid;
    for (int p = tid; p < 144 * 16; p += 512) { const int rr = p >> 4, sg = p & 15, grow = row0 - 8 + rr;
        if (grow >= 0 && grow < MROWS) *(LAS u32x4*)(Pin + rr * TP + sg * 16) = *(const u32x4*)(ZB + (size_t)grow * N_IN + C_P + g * 128 + sg * 8); }
    fill_rows(PWT, (const bf16*)(F.ws + WS_PWT) + (size_t)(l * 4 + g) * 16384, 128, tid);
    __syncthreads();
    {
        const int t = tid >> 2, cq = tid & 3, grow = row0 + t;
        int seg0, seglen, pos;
        if (grow < CTX) { seg0 = 0; seglen = CTX; pos = grow; } else { const int tok = grow - CTX; seg0 = CTX + (tok / GRID_W) * GRID_W; seglen = GRID_W; pos = tok % GRID_W; }
        const int w = 2 << g; int lo = pos - w / 2; if (lo < 0) lo = 0; int hi = pos + w / 2 - 1; if (hi > seglen - 1) hi = seglen - 1;
        const float inv = 1.f / (float)(hi - lo + 1);
        float sum[32];
#pragma unroll
        for (int j = 0; j < 32; ++j) sum[j] = 0.f;
        for (int p = lo; p <= hi; ++p) { const LAS unsigned char* rp = Pin + (seg0 + p - (row0 - 8)) * TP + cq * 64;
#pragma unroll
            for (int q = 0; q < 4; ++q) { const u32x4 v = *(const LAS u32x4*)(rp + q * 16);
#pragma unroll
                for (int e = 0; e < 4; ++e) { sum[q * 8 + 2 * e] += bflo(v[e]); sum[q * 8 + 2 * e + 1] += bfhi(v[e]); } } }
        const LAS unsigned char* sp = Pin + (t + 8) * TP + cq * 64;
#pragma unroll
        for (int q = 0; q < 4; ++q) { const u32x4 v = *(const LAS u32x4*)(sp + q * 16); u32x4 o;
#pragma unroll
            for (int e = 0; e < 4; ++e) o[e] = cvt_pk_bf16(sum[q * 8 + 2 * e] * inv - bflo(v[e]), sum[q * 8 + 2 * e + 1] * inv - bfhi(v[e]));
            *(LAS u32x4*)(Yl + t * TP + cq * 64 + q * 16) = o; }
    }
    __syncthreads();
    const int w = F.wave, fr = F.lane & 15, fq = F.lane >> 4;
    bf16x8 yb[4];
#pragma unroll
    for (int t = 0; t < 4; ++t) yb[t] = *(const LAS bf16x8*)(Yl + (16 * w + fr) * TP + (32 * t + 8 * fq) * 2);
    bf16* MIX = (bf16*)(F.ws + WS_MIX) + (size_t)(row0 + 16 * w + fr) * D + RET_W + g * 128 + 4 * fq;
    const float* ps = F.in[I_PS] + (size_t)l * POOL_W + g * 128 + 4 * fq;
    f32x4 scv[8];
#pragma unroll
    for (int db = 0; db < 8; ++db) scv[db] = *(const f32x4*)(ps + 16 * db);
#pragma unroll
    for (int db = 0; db < 8; ++db) {
        f32x4 a = (f32x4){0.f, 0.f, 0.f, 0.f};
#pragma unroll
        for (int t = 0; t < 4; ++t) a = MFMA16(*(const LAS bf16x8*)(PWT + (16 * db + fr) * TP + (32 * t + 8 * fq) * 2), yb[t], a);
        a = a * scv[db];
        u32x2 o; o.x = cvt_pk_bf16(a[0], a[1]); o.y = cvt_pk_bf16(a[2], a[3]);
        *(u32x2*)(MIX + 16 * db) = o;
    }
    __syncthreads();
}
__device__ __forceinline__ void sg_item(Frame& F, int l, int c, int g) {
    LAS unsigned char* VN = F.lds;
    const bf16* ZB = (const bf16*)(F.ws + WS_ZB) + (size_t)c * 128 * N_IN;
    const int tid = F.tid;
    {
        const int w0 = F.wave * 16, lane = F.lane;
        u32x4 rv[16];
#pragma unroll
        for (int i = 0; i < 16; ++i) rv[i] = *(const u32x4*)(ZB + (size_t)(w0 + i) * N_IN + C_SV + 8 * lane);
        const float* ng = F.in[I_SGNG] + (size_t)l * SG_W + 8 * lane;
        const f32x4 n0 = *(const f32x4*)ng, n1 = *(const f32x4*)(ng + 4);
        float ss[16];
#pragma unroll
        for (int i = 0; i < 16; ++i) { const u32x4 v = rv[i]; ss[i] = 0.f;
#pragma unroll
            for (int e = 0; e < 4; ++e) { const float a = bflo(v[e]), b = bfhi(v[e]); ss[i] += a * a + b * b; } }
#pragma unroll
        for (int o = 1; o < 64; o <<= 1)
#pragma unroll
            for (int i = 0; i < 16; ++i) ss[i] += __shfl_xor(ss[i], o);
        if ((lane >> 4) == g) {
#pragma unroll
            for (int i = 0; i < 16; ++i) { const u32x4 v = rv[i]; const float r = rsqrtf(ss[i] * (1.f / SG_W) + EPS); u32x4 o;
                o.x = cvt_pk_bf16(bflo(v.x) * r * n0[0], bfhi(v.x) * r * n0[1]); o.y = cvt_pk_bf16(bflo(v.y) * r * n0[2], bfhi(v.y) * r * n0[3]);
                o.z = cvt_pk_bf16(bflo(v.z) * r * n1[0], bfhi(v.z) * r * n1[1]); o.w = cvt_pk_bf16(bflo(v.w) * r * n1[2], bfhi(v.w) * r * n1[3]);
                *(LAS u32x4*)(VN + (w0 + i) * TP + (lane & 15) * 16) = o; }
        }
    }
    __syncthreads();
    const int w = F.wave, fr = F.lane & 15, fq = F.lane >> 4;
    const bf16* SGW = (const bf16*)(F.ws + WS_SGW) + ((size_t)(l * 4 + g) * 128 + 16 * w + fr) * 128;
    bf16x8 wf[4];
#pragma unroll
    for (int t = 0; t < 4; ++t) wf[t] = *(const bf16x8*)(SGW + 32 * t + 8 * fq);
    const float bias = F.in[I_SGB][(size_t)(l * 4 + g) * 128 + 16 * w + fr];
    const bf16* U = ZB + (size_t)(16 * w + fr) * N_IN + C_U + g * 128 + 4 * fq;
    u32x2 uvv[8];
#pragma unroll
    for (int cb = 0; cb < 8; ++cb) uvv[cb] = *(const u32x2*)(U + 16 * cb);
    bf16* MIX = (bf16*)(F.ws + WS_MIX) + (size_t)(c * 128 + 16 * w + fr) * D + RET_W + POOL_W + g * 128 + 4 * fq;
#pragma unroll
    for (int cb = 0; cb < 8; ++cb) {
        f32x4 a = (f32x4){0.f, 0.f, 0.f, 0.f};
#pragma unroll
        for (int t = 0; t < 4; ++t) a = MFMA16(tr_frag(VN, 32 * t + 8 * fq, 32 * t + 8 * fq + 4, 16 * cb, F.lane), wf[t], a);
        const u32x2 uv = uvv[cb];
        u32x2 o; o.x = cvt_pk_bf16((a[0] + bias) * bflo(uv.x), (a[1] + bias) * bfhi(uv.x)); o.y = cvt_pk_bf16((a[2] + bias) * bflo(uv.y), (a[3] + bias) * bfhi(uv.y));
        *(u32x2*)(MIX + 16 * cb) = o;
    }
    __syncthreads();
}
__device__ __forceinline__ void scan_phase(Frame& F, int l, int nskip) {
    const bf16* KVT = (const bf16*)(F.ws + WS_KVT); bf16* ST = (bf16*)(F.ws + WS_ST);
    const float* lg = F.in[I_RLOG] + (size_t)l * 2 * RET_H;
    if (F.bid < nskip) return;
    const int nw = F.G - nskip, per = (65536 + nw - 1) / nw, p = (F.bid - nskip) * per + F.tid;
    if (F.tid < per && p < 65536) {
        const int hd = p >> 12, h = hd >> 1, dir = hd & 1;
        const float g128 = expf(128.f * log_sigmoid_f(lg[dir * RET_H + h]));
        const size_t e0 = (size_t)p * 4;
        u32x2 kvw[NCHUNK];
#pragma unroll
        for (int c = 0; c < NCHUNK; ++c) kvw[c] = *(const u32x2*)(KVT + (size_t)c * 262144 + e0);
        f32x4 S = (f32x4){0.f, 0.f, 0.f, 0.f};
        if (dir == 0) {
#pragma unroll
            for (int c = 0; c < NCHUNK; ++c) { u32x2 o; o.x = cvt_pk_bf16(S[0], S[1]); o.y = cvt_pk_bf16(S[2], S[3]); *(u32x2*)(ST + (size_t)c * 262144 + e0) = o;
                S = S * g128 + (f32x4){bflo(kvw[c].x), bfhi(kvw[c].x), bflo(kvw[c].y), bfhi(kvw[c].y)}; }
        } else {
#pragma unroll
            for (int i = 0; i < NCHUNK; ++i) { const int c = i < 2 ? 1 - i : NCHUNK + 1 - i; u32x2 o; o.x = cvt_pk_bf16(S[0], S[1]); o.y = cvt_pk_bf16(S[2], S[3]); *(u32x2*)(ST + (size_t)c * 262144 + e0) = o;
                S = S * g128 + (f32x4){bflo(kvw[c].x), bfhi(kvw[c].x), bflo(kvw[c].y), bfhi(kvw[c].y)}; }
        }
    }
}
__device__ __forceinline__ void fill_rows_f32(LAS unsigned char* T, const float* src, int tid) {
    const int r = tid >> 2, sg = tid & 3;
#pragma unroll
    for (int q = 0; q < 4; ++q) { unsigned z = 0u; asm volatile("" : "+v"(z));
        u32x4 w = (u32x4){z, z, z, z};
        if (src) { const f32x4 a = *(const f32x4*)(src + (size_t)r * 128 + sg * 32 + q * 8), b = *(const f32x4*)(src + (size_t)r * 128 + sg * 32 + q * 8 + 4);
            w.x = cvt_pk_bf16(a[0], a[1]); w.y = cvt_pk_bf16(a[2], a[3]); w.z = cvt_pk_bf16(b[0], b[1]); w.w = cvt_pk_bf16(b[2], b[3]); }
        *(LAS u32x4*)(T + r * TP + sg * 64 + q * 16) = w; }
}
template <bool CTXSRC>
__device__ __forceinline__ void ret_item(Frame& F, int l, int c, int h) {
    LAS unsigned char* Kt = F.lds; LAS unsigned char* VT = F.lds + TILE_B; LAS unsigned char* SF = F.lds + 2 * TILE_B; LAS unsigned char* SB = F.lds + 3 * TILE_B;
    const bf16* ZB = (const bf16*)(F.ws + WS_ZB) + (size_t)c * 128 * N_IN;
    const bf16* ST = (const bf16*)(F.ws + WS_ST) + (((size_t)c * RET_H + h) * 2) * 16384;
    const float* lg = F.in[I_RLOG] + (size_t)l * 2 * RET_H;
    const float l2f = log_sigmoid_f(lg[h]) * LOG2E, l2b = log_sigmoid_f(lg[RET_H + h]) * LOG2E;
    const int tid = F.tid, w = F.wave, fr = F.lane & 15, fq = F.lane >> 4;
    fill_rows(Kt, ZB + C_K + h * HD, N_IN, tid);
    if (CTXSRC) {
        const bf16* KV = (const bf16*)(F.ws + WS_KVT) + (((size_t)(1 - c) * RET_H + h) * 2) * 16384;
        if (c == 1) fill_rows(SF, KV, 128, tid); else fill_rows_f32(SF, nullptr, tid);
        if (c == 0) fill_rows(SB, KV + 16384, 128, tid); else fill_rows_f32(SB, nullptr, tid);
    } else {
        fill_rows(SF, ST, 128, tid);
        fill_rows(SB, ST + 16384, 128, tid);
    }
    fill_rows(VT, ZB + C_V + h * HD, N_IN, tid);
    bf16x8 qf[4];
    { const bf16* qp = ZB + (size_t)(16 * w + fr) * N_IN + C_Q + h * HD + 8 * fq;
#pragma unroll
      for (int t = 0; t < 4; ++t) qf[t] = *(const bf16x8*)(qp + 32 * t); }
    const int i = 16 * w + fr;
    u32x2 gvv[8];
    { const bf16* G = ZB + (size_t)i * N_IN + C_G + h * HD + 4 * fq;
#pragma unroll
      for (int eb = 0; eb < 8; ++eb) gvv[eb] = *(const u32x2*)(G + 16 * eb); }
    __syncthreads();
    bf16x8 pf[4];
#pragma unroll
    for (int tp = 0; tp < 4; ++tp) {
        unsigned pw[4];
#pragma unroll
        for (int bb = 0; bb < 2; ++bb) {
            const int b = 2 * tp + bb;
            f32x4 s = (f32x4){0.f, 0.f, 0.f, 0.f};
#pragma unroll
            for (int t = 0; t < 4; ++t) s = MFMA16(*(const LAS bf16x8*)(Kt + (16 * b + fr) * TP + (32 * t + 8 * fq) * 2), qf[t], s);
            float pv[4];
#pragma unroll
            for (int r = 0; r < 4; ++r) { const int j = 16 * b + 4 * fq + r; const int dd = i - j;
                const float dm = dd > 0 ? exp2f(l2f * (float)dd) : (dd < 0 ? exp2f(l2b * (float)(-dd)) : 2.f); pv[r] = s[r] * dm; }
            pw[2 * bb] = cvt_pk_bf16(pv[0], pv[1]); pw[2 * bb + 1] = cvt_pk_bf16(pv[2], pv[3]);
        }
        u32x4 pk; pk.x = pw[0]; pk.y = pw[1]; pk.z = pw[2]; pk.w = pw[3];
        pf[tp] = __builtin_bit_cast(bf16x8, pk);
    }
    const float af = exp2f(l2f * (float)(i + 1)), ab = exp2f(l2b * (float)(128 - i));
    f32x4 o[8]; float ss = 0.f;
#pragma unroll
    for (int eb = 0; eb < 8; ++eb) {
        f32x4 a0 = (f32x4){0.f, 0.f, 0.f, 0.f}, a1 = a0, a2 = a0;
#pragma unroll
        for (int t = 0; t < 4; ++t) {
            a0 = MFMA16(tr_frag(VT, 32 * t + 4 * fq, 32 * t + 16 + 4 * fq, 16 * eb, F.lane), pf[t], a0);
            a1 = MFMA16(*(const LAS bf16x8*)(SF + (16 * eb + fr) * TP + (32 * t + 8 * fq) * 2), qf[t], a1);
            a2 = MFMA16(*(const LAS bf16x8*)(SB + (16 * eb + fr) * TP + (32 * t + 8 * fq) * 2), qf[t], a2);
        }
        o[eb] = a0 + a1 * af + a2 * ab;
        ss += (o[eb][0] * o[eb][0] + o[eb][1] * o[eb][1]) + (o[eb][2] * o[eb][2] + o[eb][3] * o[eb][3]);
    }
    ss += __shfl_xor(ss, 16); ss += __shfl_xor(ss, 32);
    const float r = rsqrtf(ss * (1.f / HD) + EPS);
    bf16* MIX = (bf16*)(F.ws + WS_MIX) + (size_t)(c * 128 + i) * D + h * HD + 4 * fq;
    f32x4 n4v[8];
    { const float* ng = F.in[I_RNG] + (size_t)l * RET_W + h * HD + 4 * fq;
#pragma unroll
      for (int eb = 0; eb < 8; ++eb) n4v[eb] = *(const f32x4*)(ng + 16 * eb); }
#pragma unroll
    for (int eb = 0; eb < 8; ++eb) {
        const u32x2 gv = gvv[eb]; const f32x4 n4 = n4v[eb];
        const f32x4 v = o[eb] * r * n4;
        u32x2 ov; ov.x = cvt_pk_bf16(v[0] * bflo(gv.x), v[1] * bfhi(gv.x)); ov.y = cvt_pk_bf16(v[2] * bflo(gv.y), v[3] * bfhi(gv.y));
        *(u32x2*)(MIX + 16 * eb) = ov;
    }
    __syncthreads();
}


template <int R, int C, int WR, int WC, int KC>
__device__ __forceinline__ void skinny_acc(Frame& F, f32x4 (&acc)[WR][WC], const bf16* A, int lda, const bf16* Bt, int ldb, int K) {
    constexpr int PITCH = KC * 2 + 16, SEGS = KC / 8, PIECES = (R + C) * SEGS, PPT = PIECES / 512, STAGE = (R + C) * PITCH, WGC = C / 16 / WC;
    static_assert(PIECES % 512 == 0 && (R / 16 / WR) * WGC == 8 && 2 * STAGE <= SCR_BYTES, "skinny geometry");
    const int tid = F.tid, fr = F.lane & 15, fq = F.lane >> 4, wgr = F.wave / WGC, wgc = F.wave % WGC;
    u32x4 rg0[PPT], rg1[PPT];
    const bf16* src[PPT]; int dst[PPT];
#pragma unroll
    for (int q = 0; q < PPT; ++q) { const int p = tid + 512 * q, row = p / SEGS, sg = p % SEGS;
        src[q] = row < R ? A + (size_t)row * lda + sg * 8 : Bt + (size_t)(row - R) * ldb + sg * 8; dst[q] = row * PITCH + sg * 16; }
#define SK_GLOAD(rg, k0) do { _Pragma("unroll") for (int q = 0; q < PPT; ++q) rg[q] = *(const u32x4*)(src[q] + (k0)); } while (0)
#define SK_LSTORE(rg, buf) do { _Pragma("unroll") for (int q = 0; q < PPT; ++q) *(LAS u32x4*)(F.lds + (buf) * STAGE + dst[q]) = rg[q]; } while (0)
#define SK_COMPUTE(buf) do { const LAS unsigned char* bA = F.lds + (buf) * STAGE; const LAS unsigned char* bB = bA + R * PITCH; \
        _Pragma("unroll") for (int t = 0; t < KC / 32; ++t) { bf16x8 af[WR], bfr[WC]; \
            _Pragma("unroll") for (int i = 0; i < WR; ++i) af[i] = *(const LAS bf16x8*)(bA + (16 * (wgr * WR + i) + fr) * PITCH + (32 * t + 8 * fq) * 2); \
            _Pragma("unroll") for (int j = 0; j < WC; ++j) bfr[j] = *(const LAS bf16x8*)(bB + (16 * (wgc * WC + j) + fr) * PITCH + (32 * t + 8 * fq) * 2); \
            _Pragma("unroll") for (int i = 0; i < WR; ++i) _Pragma("unroll") for (int j = 0; j < WC; ++j) acc[i][j] = MFMA16(bfr[j], af[i], acc[i][j]); } } while (0)
    const int nch = K / KC;
    __syncthreads();
    SK_GLOAD(rg0, 0); SK_GLOAD(rg1, KC);
    for (int ch = 0; ch < nch; ch += 2) {
        SK_LSTORE(rg0, 0); __syncthreads();
        if (ch + 2 < nch) SK_GLOAD(rg0, (ch + 2) * KC);
        SK_COMPUTE(0);
        SK_LSTORE(rg1, 1); __syncthreads();
        if (ch + 3 < nch) SK_GLOAD(rg1, (ch + 3) * KC);
        SK_COMPUTE(1);
    }
#undef SK_GLOAD
#undef SK_LSTORE
#undef SK_COMPUTE
}
template <int MODE>
__device__ __forceinline__ void ctx_n2048(Frame& F, int l, const bf16* A, const bf16* Bt, int gi, float dry) {
    if (F.G != 256) return;
    constexpr int AP = D * 2 + 16, PART = 32 * AP;
    static_assert(PART + 8 * 64 * 16 <= SCR_BYTES, "ctx_n2048 LDS");
    const int r0 = 32 * (F.bid >> 5), c0 = 64 * (F.bid & 31), fr = F.lane & 15, fq = F.lane >> 4, j = F.wave & 3, kh = F.wave >> 2, tid = F.tid;
    u32x4 av[16];
#pragma unroll
    for (int q = 0; q < 16; ++q) { const int p = tid + 512 * q; av[q] = *(const u32x4*)(A + (size_t)(r0 + (p >> 8)) * D + (p & 255) * 8); }
    const bf16* bp = Bt + (size_t)(c0 + 16 * j + fr) * D + 1024 * kh + 8 * fq;
    bf16x8 bfv[32];
#pragma unroll
    for (int t = 0; t < 16; ++t) bfv[t] = *(const bf16x8*)(bp + 32 * t);
    const int col = c0 + 16 * j + 4 * fq;
    unsigned g0[2], g1[2]; u32x2 xo[2]; f32x4 gt = (f32x4){0.f, 0.f, 0.f, 0.f};
#pragma unroll
    for (int i = 0; i < 2; ++i) { const int row = r0 + 16 * i + fr;
        if (MODE == 0) { const unsigned char* gp = (const unsigned char*)(F.ws + WS_ZB) + (size_t)row * (N_IN * 2) + 2 * C_GATE + col;
            g0[i] = *(const unsigned*)(gp + kh * D); g1[i] = *(const unsigned*)(gp + 2 * kh * D); }
        else xo[i] = *(const u32x2*)((const bf16*)(F.ws + WS_X) + (size_t)row * D + col); }
    if (MODE == 1) gt = *(const f32x4*)((const float*)(F.ws + WS_MOD) + ((size_t)l * 2 + 0) * 6 * D + gi * D + col) * dry;
    __syncthreads();
#pragma unroll
    for (int q = 0; q < 16; ++q) { const int p = tid + 512 * q; *(LAS u32x4*)(F.lds + (p >> 8) * AP + (p & 255) * 16) = av[q]; }
#pragma unroll
    for (int t = 16; t < 32; ++t) bfv[t] = *(const bf16x8*)(bp + 32 * t);
    __syncthreads();
    f32x4 acc[2][2];
#pragma unroll
    for (int s2 = 0; s2 < 2; ++s2)
#pragma unroll
        for (int i = 0; i < 2; ++i) acc[s2][i] = (f32x4){0.f, 0.f, 0.f, 0.f};
    const LAS unsigned char* ap = F.lds + fr * AP + (1024 * kh + 8 * fq) * 2;
#pragma unroll
    for (int t = 0; t < 32; ++t) { const int s2 = (MODE == 0 && t >= 16) ? 1 : 0;
        const bf16x8 a0 = *(const LAS bf16x8*)(ap + 64 * t), a1 = *(const LAS bf16x8*)(ap + 16 * AP + 64 * t);
        acc[s2][0] = MFMA16(bfv[t], a0, acc[s2][0]); acc[s2][1] = MFMA16(bfv[t], a1, acc[s2][1]); }
    f32x4 y[2];
#pragma unroll
    for (int i = 0; i < 2; ++i) {
        if (MODE == 0) {
#pragma unroll
            for (int e = 0; e < 4; ++e) y[i][e] = (acc[0][i][e] * (float)((g0[i] >> (8 * e)) & 255u) + acc[1][i][e] * (float)((g1[i] >> (8 * e)) & 255u)) * (1.f / 255.f);
        } else y[i] = acc[0][i];
    }
    LAS f32x4* part = (LAS f32x4*)(F.lds + PART);
    if (kh == 1) { part[(j * 2 + 0) * 64 + F.lane] = y[0]; part[(j * 2 + 1) * 64 + F.lane] = y[1]; }
    __syncthreads();
    if (kh == 0) {
#pragma unroll
        for (int i = 0; i < 2; ++i) { const int row = r0 + 16 * i + fr; const f32x4 v = y[i] + part[(j * 2 + i) * 64 + F.lane];
            if (MODE == 0) { u32x2 o; o.x = cvt_pk_bf16(v[0], v[1]); o.y = cvt_pk_bf16(v[2], v[3]); *(u32x2*)((bf16*)(F.ws + WS_Y) + (size_t)row * D + col) = o; }
            else { const f32x4 d = gt * v; u32x2 xn; xn.x = cvt_pk_bf16(bflo(xo[i].x) + d[0], bfhi(xo[i].x) + d[1]); xn.y = cvt_pk_bf16(bflo(xo[i].y) + d[2], bfhi(xo[i].y) + d[3]);
                *(u32x2*)((bf16*)(F.ws + WS_X) + (size_t)row * D + col) = xn; }
        }
    }
    __syncthreads();
}
__device__ __forceinline__ void ctx_up(Frame& F, const bf16* Bt) {
    if (F.G != 256) return;
    const int r0 = 64 * (F.bid >> 6), c0 = 128 * (F.bid & 63), fr = F.lane & 15, fq = F.lane >> 4, wgr = F.wave >> 2, wgc = F.wave & 3;
    f32x4 acc[2][2];
#pragma unroll
    for (int i = 0; i < 2; ++i)
#pragma unroll
        for (int j = 0; j < 2; ++j) acc[i][j] = (f32x4){0.f, 0.f, 0.f, 0.f};
    skinny_acc<64, 128, 2, 2, 128>(F, acc, (const bf16*)(F.ws + WS_H) + (size_t)r0 * D, D, Bt + (size_t)c0 * D, D, D);
#pragma unroll
    for (int i = 0; i < 2; ++i)
#pragma unroll
        for (int j = 0; j < 2; ++j) { const int row = r0 + 16 * (wgr * 2 + i) + fr, col = c0 + 16 * (wgc * 2 + j) + 4 * fq; f32x4 a = acc[i][j];
#pragma unroll
            for (int q = 0; q < 4; ++q) { const float x = fmaxf(a[q], 0.f); a[q] = x * x; }
            u32x2 o; o.x = cvt_pk_bf16(a[0], a[1]); o.y = cvt_pk_bf16(a[2], a[3]);
            *(u32x2*)((bf16*)(F.ws + WS_A1) + (size_t)row * DFF + col) = o; }
}

__device__ __forceinline__ void ctx_down_splitk(Frame& F, const bf16* Bt) {
    if (F.G != 256) return;
    const int ks = F.bid >> 6, r0 = 64 * ((F.bid >> 4) & 3), c0 = 128 * (F.bid & 15), fr = F.lane & 15, fq = F.lane >> 4, wgr = F.wave >> 2, wgc = F.wave & 3;
    f32x4 acc[2][2];
#pragma unroll
    for (int i = 0; i < 2; ++i)
#pragma unroll
        for (int j = 0; j < 2; ++j) acc[i][j] = (f32x4){0.f, 0.f, 0.f, 0.f};
    skinny_acc<64, 128, 2, 2, 128>(F, acc, (const bf16*)(F.ws + WS_A1) + (size_t)r0 * DFF + ks * 2048, DFF, Bt + (size_t)c0 * DFF + ks * 2048, DFF, 2048);
    float* SL = (float*)(F.ws + WS_SLAB) + (size_t)ks * CTX * D;
#pragma unroll
    for (int i = 0; i < 2; ++i)
#pragma unroll
        for (int j = 0; j < 2; ++j) { const int row = r0 + 16 * (wgr * 2 + i) + fr, col = c0 + 16 * (wgc * 2 + j) + 4 * fq; *(f32x4*)(SL + (size_t)row * D + col) = acc[i][j]; }
}

constexpr int PH_PER_LAYER = 10, PH_PRE = 3, N_PHASES = PH_PRE + DEPTH * PH_PER_LAYER;
__global__ void __launch_bounds__(512, 2) mk_fwd(Args args) {
    extern __shared__ __attribute__((aligned(16))) unsigned char lds_raw[];
    LAS unsigned char* const ldsb = (LAS unsigned char*)lds_raw;
    volatile LAS unsigned* MISC = (volatile LAS unsigned*)(ldsb + MISC_OFF);
    for (int u = threadIdx.x; u < 64; u += 512) MISC[u] = 0u;
    __syncthreads();
    unsigned* barw = (unsigned*)(args.ws + WS_BAR);
    XcdBarrier bar; bar.bar = barw; bar.x = 0; bar.st = MISC + 8;
    if (!MK_SPLIT) bar = xcd_barrier_post(barw, MISC + 8);
    const int lo = args.ph_lo, hi = args.ph_hi;
#define IN(k) (lo <= (k) && (k) < hi)
#define SEAM(k) do { if (IN((k) + 1)) xcd_barrier(bar); } while (0)
#define MODP(F) ((const float*)((F).ws + WS_MOD))

    if (IN(0) && (PMASK & 1)) { for (int rep = 0; rep < ((DUP >> 12) & 1) + 1; ++rep) { Frame F; make_frame(F, ldsb); p0_prologue(F); __syncthreads(); } SEAM(0); }
    if (IN(1) && (PMASK & 1)) { Frame F; make_frame(F, ldsb); mod_reduce_phase(F); SEAM(1); }
    if (IN(2) && (PMASK & 2)) { Frame F; make_frame(F, ldsb); norm_phase(F, F.in[I_N1G], MODP(F), 0, true); SEAM(2); }

    for (int l = 0; l < DEPTH; ++l) {
        const int pb = PH_PRE + l * PH_PER_LAYER;
        if (IN(pb + 0) && (PMASK & 4)) for (int rep = 0; rep < ((DUP >> 0) & 1) + 1; ++rep) {
            Frame F; make_frame(F, ldsb);
            pg8::GemmSched S; S.T.init(MROWS / 256, N_IN / 256, F.G, F.bid); S.A = (const char*)(F.ws + WS_H); S.B = (const char*)(F.ws + WS_WIN + l * SZ_WIN);
            S.a_tile = (size_t)256 * D * 2; S.b_tile = (size_t)256 * D * 2; S.nt = D / 64; S.pm0 = 0;
            EpiInProj E{(bf16*)(F.ws + WS_ZB), (const float*)(F.ws + WS_ROPE)};
            pg8::gemm_phase(F.lds, F.tid, D, D, S, E);
            SEAM(pb + 0);
        }
        if (IN(pb + 1) && (PMASK & 8)) for (int rep = 0; rep < ((DUP >> 1) & 1) + 1; ++rep) {
            Frame F; make_frame(F, ldsb);
            constexpr int N_KV = NCHUNK * RET_H, N_PG = (NCHUNK - 4) * 4;
            for (int it = F.bid; it < N_KV + 2 * N_PG; it += F.G) {
                if (it < N_KV) kv_item(F, l, it / RET_H, it % RET_H);
                else if (it < N_KV + N_PG) { const int r = it - N_KV + 16; pool_item(F, l, r >> 2, r & 3); }
                else { const int r = it - N_KV - N_PG + 16; sg_item(F, l, r >> 2, r & 3); }
            }
            SEAM(pb + 1);
        }
        if (IN(pb + 2) && (PMASK & 16)) for (int rep = 0; rep < ((DUP >> 2) & 1) + 1; ++rep) { Frame F; make_frame(F, ldsb);
            const bool ctx_live = l + 1 < DEPTH;
            const int nctx = ctx_live ? 2 * RET_H : 0, ndef = ctx_live ? 32 : 16;
            if (F.bid < nctx) ret_item<true>(F, l, F.bid >> 3, F.bid & 7);
            else if (F.bid < nctx + ndef) { const int j = F.bid - nctx, d = ctx_live ? j : (j < 8 ? 8 + j : 16 + j);
                if (d < 16) pool_item(F, l, d >> 2, d & 3); else sg_item(F, l, (d - 16) >> 2, d & 3); }
            scan_phase(F, l, nctx + ndef); SEAM(pb + 2); }
        if (IN(pb + 3) && (PMASK & 32)) for (int rep = 0; rep < ((DUP >> 3) & 1) + 1; ++rep) {
            Frame F; make_frame(F, ldsb);
            for (int it = F.bid; it < SEQ / 128 * RET_H; it += F.G) { const int itx = 2 * RET_H + it; ret_item<false>(F, l, itx / RET_H, itx % RET_H); }
            SEAM(pb + 3);
        }
        if (IN(pb + 4) && (PMASK & 64)) for (int rep = 0; rep < ((DUP >> 4) & 1) + 1; ++rep) {
            Frame F; make_frame(F, ldsb);
            pg8::BranchSched S; S.T.init(SEQ / 256, D / 256, F.G, F.bid); S.A = (const char*)(F.ws + WS_MIX); S.B = (const char*)(F.ws + WS_WCAT + l * SZ_WSQ);
            S.a_tile = (size_t)256 * D * 2; S.b_tile = (size_t)256 * D * 2; S.pm0 = 1;
            EpiBranch E{(const bf16*)(F.ws + WS_ZB), (bf16*)(F.ws + WS_Y)};
            pg8::gemm_phase(F.lds, F.tid, D, D, S, E);
            if (l + 1 < DEPTH) ctx_n2048<0>(F, l, (const bf16*)(F.ws + WS_MIX), (const bf16*)(F.ws + WS_WCAT + l * SZ_WSQ), 0, 1.f);
            SEAM(pb + 4);
        }
        if (IN(pb + 5) && (PMASK & 128)) for (int rep = 0; rep < ((DUP >> 5) & 1) + 1; ++rep) {
            Frame F; make_frame(F, ldsb);
            pg8::GemmSched S; S.T.init(SEQ / 256, D / 256, F.G, F.bid); S.A = (const char*)(F.ws + WS_Y); S.B = (const char*)(F.ws + WS_WOUT + l * SZ_WSQ);
            S.a_tile = (size_t)256 * D * 2; S.b_tile = (size_t)256 * D * 2; S.nt = D / 64; S.pm0 = 1;
            if (l + 1 < DEPTH || !FUSE_FINAL) {
                EpiResid E{(bf16*)(F.ws + WS_X), MODP(F) + (size_t)l * 2 * 6 * D, 2, rep ? 0.f : 1.f};
                pg8::gemm_phase(F.lds, F.tid, D, D, S, E);
                if (l + 1 < DEPTH) ctx_n2048<1>(F, l, (const bf16*)(F.ws + WS_Y), (const bf16*)(F.ws + WS_WOUT + l * SZ_WSQ), 2, rep ? 0.f : 1.f);
            } else {
                const float* ml = MODP(F) + (size_t)l * 2 * 6 * D;
                EpiResidNorm<false> E{(bf16*)(F.ws + WS_X), ml, 2, F.in[I_N2G] + (size_t)l * D, nullptr, (unsigned*)(F.ws + WS_XCH), (unsigned*)(F.ws + WS_CNT), F.lds + 131072, 64u, (bf16*)(F.ws + WS_H), ml + 6 * D + 4 * D, ml + 6 * D + 3 * D};
                pg8::gemm_phase(F.lds, F.tid, D, D, S, E);
            }
            SEAM(pb + 5);
        }
        if (IN(pb + 6) && (PMASK & 256) && (l + 1 < DEPTH || !FUSE_FINAL)) for (int rep = 0; rep < ((DUP >> 6) & 1) + 1; ++rep) { Frame F; make_frame(F, ldsb); norm_phase(F, F.in[I_N2G] + (size_t)l * D, MODP(F) + (size_t)l * 2 * 6 * D, 3, false); SEAM(pb + 6); }
        if (IN(pb + 7) && (PMASK & 512)) for (int rep = 0; rep < ((DUP >> 7) & 1) + 1; ++rep) {
            Frame F; make_frame(F, ldsb);
            pg8::GemmSched S; S.T.init(SEQ / 256, DFF / 256, F.G, F.bid); S.A = (const char*)(F.ws + WS_H); S.B = (const char*)(F.ws + WS_W1 + l * SZ_WFF);
            S.a_tile = (size_t)256 * D * 2; S.b_tile = (size_t)256 * D * 2; S.nt = D / 64; S.pm0 = 1;
            EpiRelu2 E{(bf16*)(F.ws + WS_A1)};
            pg8::gemm_phase(F.lds, F.tid, D, D, S, E);
            if (l + 1 < DEPTH) ctx_up(F, (const bf16*)(F.ws + WS_W1 + l * SZ_WFF));
            SEAM(pb + 7);
        }
        if (IN(pb + 8) && (PMASK & 1024)) for (int rep = 0; rep < ((DUP >> 8) & 1) + 1; ++rep) {
            Frame F; make_frame(F, ldsb);
            pg8::GemmSched S; S.T.init(SEQ / 256, D / 256, F.G, F.bid); S.A = (const char*)(F.ws + WS_A1); S.B = (const char*)(F.ws + WS_W2 + l * SZ_WFF);
            S.a_tile = (size_t)256 * DFF * 2; S.b_tile = (size_t)256 * DFF * 2; S.nt = DFF / 64; S.pm0 = 1;
            if (l + 1 < DEPTH) {
                EpiResid E{(bf16*)(F.ws + WS_X), MODP(F) + (size_t)l * 2 * 6 * D, 5, rep ? 0.f : 1.f};
                pg8::gemm_phase(F.lds, F.tid, DFF, DFF, S, E);
                ctx_down_splitk(F, (const bf16*)(F.ws + WS_W2 + l * SZ_WFF));
            } else {
                EpiResidNorm<true> E{(bf16*)(F.ws + WS_X), MODP(F) + (size_t)l * 2 * 6 * D, 5, F.in[I_FNG], ((KArgs)__builtin_amdgcn_kernarg_segment_ptr())->out, (unsigned*)(F.ws + WS_XCH), (unsigned*)(F.ws + WS_CNT), F.lds + 131072, 128u, nullptr, nullptr, nullptr};
                pg8::gemm_phase(F.lds, F.tid, DFF, DFF, S, E);
            }
            if (l + 1 < DEPTH || !FUSE_FINAL) SEAM(pb + 8);
        }
        if (IN(pb + 9) && (PMASK & 2048)) for (int rep = 0; rep < ((DUP >> 9) & 1) + 1; ++rep) {
            Frame F; make_frame(F, ldsb);
            if (l + 1 < DEPTH) { norm_phase(F, F.in[I_N1G] + (size_t)(l + 1) * D, MODP(F) + (size_t)(l + 1) * 2 * 6 * D, 0, false, MODP(F) + (size_t)l * 2 * 6 * D + 5 * D); SEAM(pb + 9); }
            else final_norm_phase(F, ((KArgs)__builtin_amdgcn_kernarg_segment_ptr())->out);
        }
    }
#undef IN
#undef SEAM
}

extern "C" void kernel_launch(void* const* d_in, const int* in_sizes, int n_in, void* d_out, int out_size, void* d_ws, size_t ws_size, hipStream_t stream) {
    static int grid = 0;
    if (grid == 0) {
        if (n_in != 23 || out_size != SEQ * D || ws_size < WS_END) { fprintf(stderr, "kernel_launch: unexpected problem (n_in %d, out %d, ws %zu < %zu)\n", n_in, out_size, ws_size, (size_t)WS_END); grid = -1; return; }
        int dev = 0, cus = 0, per_cu = 0;
        if (hipGetDevice(&dev) != hipSuccess || hipDeviceGetAttribute(&cus, hipDeviceAttributeMultiprocessorCount, dev) != hipSuccess) { grid = -1; return; }
        if (hipFuncSetAttribute((const void*)mk_fwd, hipFuncAttributeMaxDynamicSharedMemorySize, LDS_BYTES) != hipSuccess) { fprintf(stderr, "kernel_launch: hipFuncSetAttribute failed\n"); grid = -1; return; }
        if (hipOccupancyMaxActiveBlocksPerMultiprocessor(&per_cu, (const void*)mk_fwd, 512, LDS_BYTES) != hipSuccess || per_cu < 1) { fprintf(stderr, "kernel_launch: occupancy query reports %d blocks per CU\n", per_cu); (void)hipGetLastError(); grid = -1; return; }
        grid = cus;
    }
    if (grid < 0) return;
    if (hipMemsetAsync((char*)d_ws + WS_CTL, 0, CTL_ZERO_BYTES, stream) != hipSuccess) return;
    Args a{};
    for (int i = 0; i < 23; ++i) a.in[i] = (const float*)d_in[i];
    a.out = (float*)d_out; a.ws = (unsigned char*)d_ws;
#if MK_SPLIT
    for (int p = 0; p < N_PHASES; ++p) { a.ph_lo = p; a.ph_hi = p + 1; hipLaunchKernelGGL(mk_fwd, dim3(grid), dim3(512), LDS_BYTES, stream, a); }
#else
    a.ph_lo = 0; a.ph_hi = N_PHASES;
    hipLaunchKernelGGL(mk_fwd, dim3(grid), dim3(512), LDS_BYTES, stream, a);
#endif
}
```

```cpp
#include <hip/hip_runtime.h>
#include <cstdio>
#include <cstdint>

#ifndef PMASK
#define PMASK 0xFFFF
#endif
#ifndef DUP
#define DUP 0
#endif
#ifndef MK_SPLIT
#define MK_SPLIT 0
#endif

constexpr int D = 2048, SEQ = 8192, CTX = 256, DEPTH = 4, GRID_W = 64;
constexpr int MROWS = CTX + SEQ;
constexpr int NCHUNK = MROWS / 128;
constexpr int RET_W = 1024, RET_H = 8, HD = 128;
constexpr int POOL_W = 512, SG_W = 512, DFF = 8192;
constexpr int N_IN = 4 * RET_W + POOL_W + 2 * SG_W + 3 * D;
constexpr int C_Q = 0, C_K = 1024, C_V = 2048, C_G = 3072, C_P = 4096, C_U = 4608, C_SV = 5120, C_GATE = 5632;
constexpr float EPS = 1e-6f;
constexpr float K_SCALE = 0.08838834764831845f;
constexpr float LOG2E = 1.4426950408889634f;

#define LAS __attribute__((address_space(3)))
#define GAS __attribute__((address_space(1)))
typedef unsigned short bf16;
typedef short bf16x8 __attribute__((ext_vector_type(8)));
typedef short bf16x4 __attribute__((ext_vector_type(4)));
typedef float f32x4 __attribute__((ext_vector_type(4)));
typedef float f32x2 __attribute__((ext_vector_type(2)));
typedef unsigned u32x4 __attribute__((ext_vector_type(4)));
typedef unsigned u32x2 __attribute__((ext_vector_type(2)));

__device__ __forceinline__ unsigned f2bf(float f) { unsigned u = __builtin_bit_cast(unsigned, f); return (u + 0x7fffu + ((u >> 16) & 1u)) >> 16; }
__device__ __forceinline__ unsigned pk2(float lo, float hi) { return f2bf(lo) | (f2bf(hi) << 16); }
__device__ __forceinline__ unsigned cvt_pk_bf16(float lo, float hi) { unsigned r; asm volatile("v_cvt_pk_bf16_f32 %0, %1, %2" : "=v"(r) : "v"(lo), "v"(hi)); return r; }
__device__ __forceinline__ float bflo(unsigned w) { return __uint_as_float(w << 16); }
__device__ __forceinline__ float bfhi(unsigned w) { return __uint_as_float(w & 0xffff0000u); }
__device__ __forceinline__ float silu_f(float x) { return x * __builtin_amdgcn_rcpf(1.f + __expf(-x)); }
__device__ __forceinline__ float gelu_tanh_f(float x) { const float u = 1.5957691216057308f * (x + 0.044715f * x * x * x); return x * __builtin_amdgcn_rcpf(1.f + __expf(-u)); }
__device__ __forceinline__ float log_sigmoid_f(float x) { return x >= 0.f ? -log1pf(expf(-x)) : x - log1pf(expf(x)); }
__device__ __forceinline__ float wave_sum(float v) {
#pragma unroll
    for (int o = 1; o < 64; o <<= 1) v += __shfl_xor(v, o);
    return v;
}
#define LDS_WAIT() asm volatile("s_waitcnt lgkmcnt(0)" ::: "memory")
#define VM_WAIT() asm volatile("s_waitcnt vmcnt(0)" ::: "memory")

namespace pg8 {
constexpr int BM = 256, BK = 64, HALF = 128, HTB = HALF * BK * 2  , STAGE_BYTES = 8 * HTB, NXCD = 8, WGM = 8;
__host__ __device__ __forceinline__ int lds_byte(int r, int c) { const int st = (r >> 4) * 2 + (c >> 5), rr = r & 15, cc = c & 31, ob = rr * 64 + cc * 2; return st * 1024 + (ob ^ (((ob >> 9) & 1) << 5)); }
__host__ __device__ __forceinline__ void stage_rc(int b, int& R, int& C) { const int st = b / 1024, sb = b % 1024, swz = sb ^ (((sb >> 9) & 1) << 5); R = (st >> 1) * 16 + swz / 64; C = (st & 1) * 32 + (swz % 64) / 2; }
__host__ __device__ __forceinline__ int perm32(int rho) { const int n = rho >> 4, i = rho & 15; return 8 * (i >> 2) + 4 * n + (i & 3); }

struct Unit { const char* A; const char* B; int nt, pm, pn, kind; };

struct TileOrder {
    int nM, nN, nwg, G, c;
    __device__ void init(int nM_, int nN_, int G_, int c_) { nM = nM_; nN = nN_; nwg = nM * nN; G = G_; c = c_; }
    __device__ bool tile(int i, int& pm, int& pn) const {
        const long L = (long)i * G + c; if (L >= nwg) return false;
        int wgid = (int)L; { const int q = nwg / NXCD, r = nwg % NXCD, xcd = wgid % NXCD, off = wgid / NXCD; wgid = (xcd < r ? xcd * (q + 1) : r * (q + 1) + (xcd - r) * q) + off; }
        const int nig = WGM * nN, gid = wgid / nig, fm = gid * WGM, gsz = (nM - fm) < WGM ? (nM - fm) : WGM;
        pm = fm + ((wgid % nig) % gsz); pn = (wgid % nig) / gsz; return true;
    }
};
struct GemmSched {
    TileOrder T; const char* A; const char* B; size_t a_tile, b_tile; int nt, pm0;
    __device__ __forceinline__ bool next(int i, Unit& u) const { int pm, pn; if (!T.tile(i, pm, pn)) return false; pm += pm0; u.A = A + (size_t)pm * a_tile; u.B = B + (size_t)pn * b_tile; u.nt = nt; u.pm = pm; u.pn = pn; u.kind = 0; return true; }
};
struct BranchSched {
    TileOrder T; const char* A; const char* B; size_t a_tile, b_tile; int pm0;
    __device__ __forceinline__ bool next(int i, Unit& u) const { int pm, pn; const int ti = i / 3, seg = i - 3 * ti; if (!T.tile(ti, pm, pn)) return false; pm += pm0;
        const int koff = seg == 0 ? 0 : (seg == 1 ? 1024 : 1536);
        u.A = A + (size_t)pm * a_tile + koff * 2; u.B = B + (size_t)pn * b_tile + koff * 2; u.nt = seg == 0 ? 16 : 8; u.pm = pm; u.pn = pn; u.kind = seg; return true; }
};

template <class Epi, class Sched>
__device__ __forceinline__ void gemm_phase(LAS unsigned char* lds, const int tid, const int lda, const int ldb, const Sched& S, const Epi& E) {
    const int wid = __builtin_amdgcn_readfirstlane(tid >> 6), lane = tid & 63, wr = wid >> 2, wc = wid & 3, fr = lane & 15, fq = lane >> 4;
    unsigned voffA[2], voffB[2];
#pragma unroll
    for (int i = 0; i < 2; ++i) { int R, C; stage_rc(tid * 16 + i * 8192, R, C); const int Rb = Epi::PERM ? (64 * (R >> 5) + perm32(R & 31)) : R;
        voffA[i] = (unsigned)(R * lda + C) * 2u; voffB[i] = (unsigned)(Rb * ldb + C) * 2u; }
    const size_t kstep = (size_t)(BK * 2);
    const size_t hstepA = (size_t)HALF * lda * 2, hstepB = (size_t)(Epi::PERM ? 32 : HALF) * ldb * 2;
    const unsigned ldsw = (unsigned)wid * 1024u;
    const int aoff = lds_byte(wr * 64 + fr, fq * 8), boff = lds_byte(wc * 32 + fr, fq * 8);
#define PG8_SA(b, h) (((b) * 2 + (h)) * HTB)
#define PG8_SB(b, h) ((4 + (b) * 2 + (h)) * HTB)
#define PG8_STAGE(bufoff, gbase, voff) do { _Pragma("unroll") for (int _i = 0; _i < 2; ++_i) \
        __builtin_amdgcn_global_load_lds((const unsigned*)((const char*)(gbase) + (voff)[_i]), (LAS unsigned*)(lds + (bufoff) + ldsw + _i * 8192), 16, 0, 0); } while (0)
#define PG8_LDA(dst, b, h) do { _Pragma("unroll") for (int m = 0; m < 4; ++m) _Pragma("unroll") for (int k = 0; k < 2; ++k) dst[m][k] = *(const LAS bf16x8*)(lds + PG8_SA(b, h) + aoff + m * 2048 + k * 1024); } while (0)
#define PG8_LDB(dst, b, h) do { _Pragma("unroll") for (int n = 0; n < 2; ++n) _Pragma("unroll") for (int k = 0; k < 2; ++k) dst[n][k] = *(const LAS bf16x8*)(lds + PG8_SB(b, h) + boff + n * 2048 + k * 1024); } while (0)
#define PG8_MMA(ai, bj, At, Bt) do { __builtin_amdgcn_s_setprio(1); _Pragma("unroll") for (int m = 0; m < 4; ++m) _Pragma("unroll") for (int n = 0; n < 2; ++n) _Pragma("unroll") for (int k = 0; k < 2; ++k) \
        acc[ai][bj][m][n] = __builtin_amdgcn_mfma_f32_16x16x32_bf16(Bt[n][k], At[m][k], acc[ai][bj][m][n], 0, 0, 0); __builtin_amdgcn_s_setprio(0); } while (0)
#define PG8_WAIT_V(n) asm volatile("s_waitcnt vmcnt(" #n ")" ::: "memory")
#define PG8_WAIT_L(n) asm volatile("s_waitcnt lgkmcnt(" #n ")" ::: "memory")
#define PG8_BAR __builtin_amdgcn_s_barrier()
#define PG8_SCHED __builtin_amdgcn_sched_barrier(0)
    Unit cur, nxt; int ui = 0;
    if (!S.next(0, cur)) return;
    f32x4 acc[2][2][4][2];
#pragma unroll
    for (int a = 0; a < 2; ++a)
#pragma unroll
        for (int b = 0; b < 2; ++b)
#pragma unroll
            for (int m = 0; m < 4; ++m)
#pragma unroll
                for (int n = 0; n < 2; ++n) acc[a][b][m][n] = (f32x4){0.f, 0.f, 0.f, 0.f};
    bf16x8 At[4][2], B0[2][2], B1[2][2];
    const char* cA = cur.A; const char* cB = cur.B;
    PG8_STAGE(PG8_SB(0, 0), cB, voffB); PG8_STAGE(PG8_SB(0, 1), cB + hstepB, voffB); PG8_STAGE(PG8_SA(0, 0), cA, voffA); PG8_STAGE(PG8_SA(0, 1), cA + hstepA, voffA);
    if (wr == 1) PG8_BAR;
    PG8_WAIT_V(2); PG8_BAR;
    PG8_STAGE(PG8_SB(1, 0), cB + kstep, voffB); PG8_STAGE(PG8_SA(1, 0), cA + kstep, voffA); PG8_STAGE(PG8_SB(1, 1), cB + hstepB + kstep, voffB);
    PG8_WAIT_V(6); PG8_BAR;
    for (;;) {
        const bool has_next = S.next(ui + 1, nxt);
        const char* nA = has_next ? nxt.A : cA; const char* nB = has_next ? nxt.B : cB;
        const int nt = cur.nt;
        for (int t = 0; t < nt; t += 2) {
            const bool last = (t == nt - 2);
            const char* a1 = cA + (size_t)(t + 1) * kstep;
            const char* a2 = last ? nA : cA + (size_t)(t + 2) * kstep; const char* b2 = last ? nB : cB + (size_t)(t + 2) * kstep;
            const char* a3 = a2 + kstep; const char* b3 = b2 + kstep;
            PG8_LDB(B0, 0, 0); PG8_LDB(B1, 0, 1); PG8_SCHED; PG8_LDA(At, 0, 0); PG8_STAGE(PG8_SA(1, 1), a1 + hstepA, voffA);
            PG8_WAIT_V(8); PG8_WAIT_L(0); PG8_BAR; PG8_MMA(0, 0, At, B0); PG8_MMA(0, 1, At, B1); PG8_BAR; PG8_SCHED;
            PG8_LDA(At, 0, 1); PG8_STAGE(PG8_SB(0, 0), b2, voffB); PG8_STAGE(PG8_SB(0, 1), b2 + hstepB, voffB); PG8_STAGE(PG8_SA(0, 0), a2, voffA);
            PG8_WAIT_V(8); PG8_WAIT_L(0); PG8_BAR; PG8_MMA(1, 0, At, B0); PG8_MMA(1, 1, At, B1); PG8_BAR; PG8_SCHED;
            PG8_LDB(B0, 1, 0); PG8_LDB(B1, 1, 1); PG8_SCHED; PG8_LDA(At, 1, 0); PG8_STAGE(PG8_SA(0, 1), a2 + hstepA, voffA);
            PG8_WAIT_V(8); PG8_WAIT_L(0); PG8_BAR; PG8_MMA(0, 0, At, B0); PG8_MMA(0, 1, At, B1); PG8_BAR; PG8_SCHED;
            PG8_LDA(At, 1, 1); PG8_STAGE(PG8_SB(1, 0), b3, voffB); PG8_STAGE(PG8_SB(1, 1), b3 + hstepB, voffB); PG8_STAGE(PG8_SA(1, 0), a3, voffA);
            PG8_WAIT_V(8); PG8_WAIT_L(0); PG8_BAR; PG8_MMA(1, 0, At, B0); PG8_MMA(1, 1, At, B1); PG8_BAR; PG8_SCHED;
        }
        if (wr == 0) PG8_BAR;
        E(acc, cur, wr, wc, fr, fq);
#if defined(EPI2)
        if (Epi::PROBE2) E(acc, cur, wr, wc, fr, fq);
#endif
        if (!has_next) break;
        if (!(Epi::KEEP && E.keep(cur))) {
#pragma unroll
            for (int a = 0; a < 2; ++a)
#pragma unroll
                for (int b = 0; b < 2; ++b)
#pragma unroll
                    for (int m = 0; m < 4; ++m)
#pragma unroll
                        for (int n = 0; n < 2; ++n) acc[a][b][m][n] = (f32x4){0.f, 0.f, 0.f, 0.f};
        }
        cur = nxt; cA = nA; cB = nB; ++ui;
        if (wr == 1) PG8_BAR;
    }
    PG8_WAIT_V(0);
    PG8_BAR;
#undef PG8_SA
#undef PG8_SB
#undef PG8_STAGE
#undef PG8_LDA
#undef PG8_LDB
#undef PG8_MMA
#undef PG8_WAIT_V
#undef PG8_WAIT_L
#undef PG8_BAR
#undef PG8_SCHED
}
}

constexpr size_t KiB = 1024, MiB = 1u << 20;
constexpr size_t WS_CTL = 0, CTL_ZERO_BYTES = 128 * KiB;
constexpr size_t WS_BAR = 64 * KiB;
constexpr size_t WS_MOD = 256 * KiB;
constexpr size_t WS_ROPE = 1 * MiB;
constexpr size_t WS_PWT = WS_ROPE + 64 * KiB;
constexpr size_t WS_SGW = WS_PWT + 512 * KiB;
constexpr size_t WS_WIN = 4 * MiB;
constexpr size_t SZ_WIN = (size_t)N_IN * D * 2;
constexpr size_t WS_WCAT = WS_WIN + DEPTH * SZ_WIN;
constexpr size_t SZ_WSQ = (size_t)D * D * 2;
constexpr size_t WS_WOUT = WS_WCAT + DEPTH * SZ_WSQ;
constexpr size_t WS_W1 = WS_WOUT + DEPTH * SZ_WSQ;
constexpr size_t SZ_WFF = (size_t)DFF * D * 2;
constexpr size_t WS_W2 = WS_W1 + DEPTH * SZ_WFF;
constexpr size_t WS_X = WS_W2 + DEPTH * SZ_WFF;
constexpr size_t WS_H = WS_X + (size_t)MROWS * D * 4;
constexpr size_t WS_ZB = WS_H + (size_t)MROWS * D * 2;
constexpr size_t WS_KVT = WS_ZB + (size_t)MROWS * N_IN * 2;
constexpr size_t WS_ST = WS_KVT + (size_t)NCHUNK * 16 * 16384 * 4;
constexpr size_t WS_MIX = WS_ST + (size_t)NCHUNK * 16 * 16384 * 2;
constexpr size_t WS_Y = WS_MIX + (size_t)MROWS * D * 2;
constexpr size_t WS_A1 = WS_Y + (size_t)MROWS * D * 2;
constexpr size_t WS_MODP = WS_A1 + (size_t)MROWS * DFF * 2;
constexpr size_t WS_SLAB = WS_MODP + (size_t)16 * DEPTH * 2 * 6 * D * 4;
constexpr size_t WS_XCH = WS_SLAB + (size_t)4 * CTX * D * 4;
constexpr size_t WS_END = WS_XCH + (size_t)MROWS * 8 * 4;
constexpr size_t WS_CNT = 0;

constexpr int SCR_BYTES = 147456;
constexpr int MISC_OFF = SCR_BYTES;
constexpr int LDS_BYTES = SCR_BYTES + 256;
constexpr int TP = 272;
constexpr int TILE_B = 128 * TP;

#define XB_TMO      128
#define XB_XCNT(j)  (256  + 64 * (j))
#define XB_XSUB(j)  (1280 + 64 * (j))
#define XB_XGEN(j)  (2304 + 64 * (j))
#define XB_TOP      3328
#define XB_TOPGEN   3392
#define XCD_BAR_WORDS 3456
#define XB_SPIN_CAP (1u << 18)
__device__ __forceinline__ unsigned xb_ld(unsigned* p)              { return __hip_atomic_load(p, __ATOMIC_RELAXED, __HIP_MEMORY_SCOPE_AGENT); }
__device__ __forceinline__ unsigned xb_add(unsigned* p, unsigned v) { return __hip_atomic_fetch_add(p, v, __ATOMIC_RELAXED, __HIP_MEMORY_SCOPE_AGENT); }
__device__ __forceinline__ unsigned xb_xcc_id() { return (unsigned)__builtin_amdgcn_s_getreg((3 << 11) | 20) & 0xFu; }
#define XB_SPIN(cond, bar) do { unsigned _sp = 0; while (cond) { __builtin_amdgcn_s_sleep(1); \
    if ((++_sp & 255u) == 0u) { if (xb_ld(&(bar)[XB_TMO])) break; if (_sp > XB_SPIN_CAP) { atomicAdd(&(bar)[XB_TMO], 1u); break; } } } } while (0)
struct XcdBarrier { unsigned* bar; unsigned x; volatile LAS unsigned* st; };
__device__ __forceinline__ XcdBarrier xcd_barrier_post(unsigned* bar, volatile LAS unsigned* st) {
    XcdBarrier b; b.bar = bar; b.x = xb_xcc_id(); b.st = st;
    if (threadIdx.x == 0) (void)xb_add(&bar[XB_XCNT(b.x)], 1u);
    return b;
}
__device__ __forceinline__ void xcd_barrier_complete(unsigned* bar, unsigned x, unsigned& nloc, unsigned& nx) {
    const unsigned G = gridDim.x * gridDim.y * gridDim.z;
    unsigned sum, cnt, mine, sp = 0u;
    for (;;) {
        sum = 0u; cnt = 0u; mine = 0u;
#pragma unroll
        for (unsigned j = 0; j < 16; ++j) { const unsigned c = xb_ld(&bar[XB_XCNT(j)]); sum += c; cnt += (c > 0u) ? 1u : 0u; mine = (j == x) ? c : mine; }
        if (sum == G) break;
        __builtin_amdgcn_s_sleep(1);
        if ((++sp & 255u) == 0u) { if (xb_ld(&bar[XB_TMO])) break; if (sp > XB_SPIN_CAP) { atomicAdd(&bar[XB_TMO], 1u); break; } }
    }
    nloc = mine > 0u ? mine : 1u; nx = cnt > 0u ? cnt : 1u;
}
__device__ __forceinline__ void xcd_barrier(const XcdBarrier& b) {
    asm volatile("s_waitcnt vmcnt(0)" ::: "memory");
    __syncthreads();
    if (threadIdx.x == 0) {
        unsigned* bar = b.bar;
        __builtin_amdgcn_s_waitcnt(0);
        unsigned nloc = b.st[0], nx = b.st[1];
        if (nloc == 0u) { xcd_barrier_complete(bar, b.x, nloc, nx); b.st[0] = nloc; b.st[1] = nx; }
        const unsigned old = xb_add(&bar[XB_XSUB(b.x)], 1u);
        const unsigned gen = old / nloc;
        if (old + 1u == (gen + 1u) * nloc) {
            __builtin_amdgcn_fence(__ATOMIC_RELEASE, "agent");
            asm volatile("s_waitcnt vmcnt(0)" ::: "memory");
            const unsigned og = xb_add(&bar[XB_TOP], 1u);
            const unsigned tg = og / nx;
            if (og + 1u == (tg + 1u) * nx) xb_add(&bar[XB_TOPGEN], 1u);
            else XB_SPIN(xb_ld(&bar[XB_TOPGEN]) == tg, bar);
            __builtin_amdgcn_fence(__ATOMIC_ACQUIRE, "agent");
            xb_add(&bar[XB_XGEN(b.x)], 1u);
            asm volatile("s_waitcnt vmcnt(0)" ::: "memory");
        } else {
            XB_SPIN(xb_ld(&bar[XB_XGEN(b.x)]) == gen, bar);
            __builtin_amdgcn_fence(__ATOMIC_ACQUIRE, "agent");
            asm volatile("s_waitcnt vmcnt(0)" ::: "memory");
        }
    }
    __syncthreads();
}

struct Args { const float* in[23]; float* out; unsigned char* ws; int ph_lo, ph_hi; };
typedef const __attribute__((address_space(4))) Args* KArgs;
struct Frame {
    LAS unsigned char* lds;
    int tid, lane, wave, G, bid;
    unsigned char* ws;
    const float* const __attribute__((address_space(4)))* in;
};
__device__ __forceinline__ void make_frame(Frame& F, LAS unsigned char* lds) {
    int t = threadIdx.x; asm volatile("" : "+v"(t));
    KArgs ka = (KArgs)__builtin_amdgcn_kernarg_segment_ptr(); asm volatile("" : "+s"(ka));
    F.lds = lds; F.tid = t; F.lane = t & 63; F.wave = __builtin_amdgcn_readfirstlane(t >> 6); { int g_ = gridDim.x, b_ = blockIdx.x; asm volatile("" : "+s"(g_), "+s"(b_)); F.G = g_; F.bid = b_; }
    F.ws = ka->ws; F.in = ka->in;
}
enum { I_X = 0, I_C, I_CTX, I_CCTX, I_WADA, I_BADA, I_N1G, I_WIN, I_RLOG, I_RNG, I_PW, I_PS, I_SGNG, I_SGW, I_SGB, I_WBR, I_WBP, I_WBS, I_WOUT, I_N2G, I_W1, I_W2, I_FNG };

using pg8::Unit; using pg8::BM; using pg8::HALF;
#if defined(EPI2)
#define P2(x) static constexpr bool PROBE2 = (EPI2 == x);
#else
#define P2(x)
#endif
struct EpiInProj {           P2(1)
    static constexpr bool PERM = true, KEEP = false;
    bf16* ZB; const float* rope;
    __device__ __forceinline__ bool keep(const Unit&) const { return false; }
    __device__ __forceinline__ void operator()(f32x4 (&acc)[2][2][4][2], const Unit& u, int wr, int wc, int fr, int fq) const {
        const int pn = u.pn, row0 = u.pm * BM + wr * 64 + fr;
        if (pn < 8) {
            const int half = wc & 1; const float ks = pn >= 4 ? K_SCALE : 1.f; const bool latent = u.pm > 0;
            f32x4 csn[4];
            auto ldcs = [&](int step, f32x4 (&c4)[4]) { const int row = row0 + (step >> 2) * HALF + (step & 3) * 16;
#pragma unroll
                for (int q = 0; q < 4; ++q) c4[q] = (f32x4){1.f, 0.f, 1.f, 0.f};
                if (latent) { const int tok = row - CTX; const int pos = half ? (tok & (GRID_W - 1)) : (tok / GRID_W); const float* rp = rope + (size_t)(pos * 32 + 8 * fq) * 2;
#pragma unroll
                    for (int q = 0; q < 4; ++q) c4[q] = *(const f32x4*)(rp + 4 * q); } };
            ldcs(0, csn);
#pragma unroll
            for (int ai = 0; ai < 2; ++ai)
#pragma unroll
                for (int m = 0; m < 4; ++m) {
                    const int row = row0 + ai * HALF + m * 16;
                    f32x4 cs[4];
#pragma unroll
                    for (int q = 0; q < 4; ++q) cs[q] = csn[q];
                    if (ai * 4 + m < 7) ldcs(ai * 4 + m + 1, csn);
                    float o1[8], o2[8];
#pragma unroll
                    for (int n = 0; n < 2; ++n) { const f32x4 t1 = acc[ai][0][m][n] * ks, t2 = acc[ai][1][m][n] * ks;
#pragma unroll
                        for (int j = 0; j < 4; ++j) { const int e = 4 * n + j; const float c = cs[e >> 1][2 * (e & 1)], sn = cs[e >> 1][2 * (e & 1) + 1];
                            o1[e] = t1[j] * c - t2[j] * sn; o2[e] = t1[j] * sn + t2[j] * c; } }
                    bf16* dst = ZB + (size_t)row * N_IN + pn * BM + 64 * wc + 8 * fq;
                    u32x4 w1, w2; w1.x = cvt_pk_bf16(o1[0], o1[1]); w1.y = cvt_pk_bf16(o1[2], o1[3]); w1.z = cvt_pk_bf16(o1[4], o1[5]); w1.w = cvt_pk_bf16(o1[6], o1[7]);
                    w2.x = cvt_pk_bf16(o2[0], o2[1]); w2.y = cvt_pk_bf16(o2[2], o2[3]); w2.z = cvt_pk_bf16(o2[4], o2[5]); w2.w = cvt_pk_bf16(o2[6], o2[7]);
                    *(u32x4*)dst = w1; *(u32x4*)(dst + 32) = w2;
                }
            return;
        }
        bf16* tile = ZB + (size_t)row0 * N_IN + pn * BM + wc * 64 + 8 * fq;
        if (pn >= 22) store_gate_tile(acc, (unsigned char*)ZB + (size_t)row0 * (N_IN * 2) + 2 * C_GATE + (pn * BM - C_GATE) + wc * 64 + 8 * fq);
        else if (pn < 12 || (pn >= 16 && pn < 18)) store_tile<0>(acc, tile);
        else if (pn < 16) store_tile<1>(acc, tile);
        else store_tile<2>(acc, tile);
    }
    __device__ __forceinline__ void store_gate_tile(f32x4 (&acc)[2][2][4][2], unsigned char* tile) const {
#pragma unroll
        for (int ai = 0; ai < 2; ++ai)
#pragma unroll
            for (int m = 0; m < 4; ++m) {
                unsigned char* rowp = tile + (size_t)(ai * HALF + m * 16) * (N_IN * 2);
#pragma unroll
                for (int bj = 0; bj < 2; ++bj) {
                    unsigned q[8];
#pragma unroll
                    for (int j = 0; j < 8; ++j) { const float z = j < 4 ? acc[ai][bj][m][0][j] : acc[ai][bj][m][1][j - 4];
                        const float g = __builtin_amdgcn_rcpf(1.f + __builtin_amdgcn_exp2f(z * -LOG2E));
                        q[j] = (unsigned)__builtin_amdgcn_fmed3f(g * 255.f + 0.5f, 1.f, 255.f); }
                    u32x2 w; w.x = q[0] | (q[1] << 8) | (q[2] << 16) | (q[3] << 24); w.y = q[4] | (q[5] << 8) | (q[6] << 16) | (q[7] << 24);
                    *(u32x2*)(rowp + bj * 32) = w;
                }
            }
    }
    template <int MODE>
    __device__ __forceinline__ void store_tile(f32x4 (&acc)[2][2][4][2], bf16* tile) const {
#pragma unroll
        for (int ai = 0; ai < 2; ++ai)
#pragma unroll
            for (int m = 0; m < 4; ++m) {
                bf16* rowp = tile + (size_t)(ai * HALF + m * 16) * N_IN;
#pragma unroll
                for (int bj = 0; bj < 2; ++bj) {
                    float v[8];
#pragma unroll
                    for (int j = 0; j < 4; ++j) { v[j] = acc[ai][bj][m][0][j]; v[4 + j] = acc[ai][bj][m][1][j]; }
#pragma unroll
                    for (int j = 0; j < 8; ++j) {
                        if (MODE == 1) v[j] = silu_f(v[j]);
                        else if (MODE == 2) v[j] = gelu_tanh_f(v[j]);
                        else if (MODE == 3) v[j] = 1.f + __expf(-fminf(fmaxf(v[j], -30.f), 30.f));
                    }
                    u32x4 w; w.x = cvt_pk_bf16(v[0], v[1]); w.y = cvt_pk_bf16(v[2], v[3]); w.z = cvt_pk_bf16(v[4], v[5]); w.w = cvt_pk_bf16(v[6], v[7]);
                    *(u32x4*)(rowp + bj * 32) = w;
                }
            }
    }
};
struct EpiBranch { static constexpr bool PRETOUCH = false;          P2(0)
    static constexpr bool PERM = true, KEEP = true;
    const bf16* ZB; bf16* Y;
    __device__ __forceinline__ bool keep(const Unit& u) const { return u.kind < 2; }
    __device__ __forceinline__ void operator()(f32x4 (&acc)[2][2][4][2], const Unit& u, int wr, int wc, int fr, int fq) const {
        const int kind = u.kind, rowu = u.pm * BM + wr * 64, colu = u.pn * BM + wc * 64;
        const unsigned char* gb = (const unsigned char*)ZB + (size_t)rowu * (N_IN * 2) + 2 * C_GATE + colu + kind * D;
        const int dstep = kind < 2 ? D : 0;
        const unsigned glo = (unsigned)(fr * (N_IN * 2) + 8 * fq);
        const bool fin = kind == 2;
#pragma unroll
        for (int ai = 0; ai < 2; ++ai) {
            u32x2 nm[4][2], dn[4][2];
#pragma unroll
            for (int m = 0; m < 4; ++m)
#pragma unroll
                for (int bj = 0; bj < 2; ++bj) { const unsigned char* p = gb + (size_t)(ai * HALF + m * 16) * (N_IN * 2) + bj * 32;
                    nm[m][bj] = *(const u32x2*)(p + glo); dn[m][bj] = *(const u32x2*)(p + dstep + glo); }
#pragma unroll
            for (int m = 0; m < 4; ++m)
#pragma unroll
                for (int bj = 0; bj < 2; ++bj) {
                    float sc[8];
#pragma unroll
                    for (int q = 0; q < 8; ++q) { const float n = (float)((nm[m][bj][q >> 2] >> (8 * (q & 3))) & 255u), r = __builtin_amdgcn_rcpf((float)((dn[m][bj][q >> 2] >> (8 * (q & 3))) & 255u));
                        sc[q] = n * (fin ? (1.f / 255.f) : r); }
#pragma unroll
                    for (int j = 0; j < 4; ++j) { acc[ai][bj][m][0][j] *= sc[j]; acc[ai][bj][m][1][j] *= sc[4 + j]; }
                }
        }
        if (fin) {
            bf16* yb = Y + (size_t)rowu * D + colu; const unsigned ylo = (unsigned)(fr * (D * 2) + 16 * fq);
#pragma unroll
            for (int ai = 0; ai < 2; ++ai)
#pragma unroll
                for (int m = 0; m < 4; ++m)
#pragma unroll
                    for (int bj = 0; bj < 2; ++bj) { const f32x4 a = acc[ai][bj][m][0], b = acc[ai][bj][m][1]; u32x4 w; w.x = cvt_pk_bf16(a[0], a[1]); w.y = cvt_pk_bf16(a[2], a[3]); w.z = cvt_pk_bf16(b[0], b[1]); w.w = cvt_pk_bf16(b[2], b[3]);
                        *(u32x4*)((unsigned char*)(yb + (size_t)(ai * HALF + m * 16) * D + bj * 32) + ylo) = w; }
        }
    }
};
struct EpiResid {            P2(0)
    static constexpr bool PERM = true, KEEP = false;
    bf16* X; const float* modl; int gi; float dry;
    __device__ __forceinline__ bool keep(const Unit&) const { return false; }
    __device__ __forceinline__ void operator()(f32x4 (&acc)[2][2][4][2], const Unit& u, int wr, int wc, int fr, int fq) const {
        const int row0 = u.pm * BM + wr * 64 + fr, col0 = u.pn * BM + wc * 64 + 8 * fq;
        const float* gate = modl + (size_t)(u.pm > 0 ? 1 : 0) * 6 * D + gi * D + col0;
        f32x4 gv[2][2];
#pragma unroll
        for (int bj = 0; bj < 2; ++bj)
#pragma unroll
            for (int n = 0; n < 2; ++n) gv[bj][n] = *(const f32x4*)(gate + bj * 32 + n * 4) * dry;
#pragma unroll
        for (int ai = 0; ai < 2; ++ai) {
            u32x4 xa[4][2];
#pragma unroll
            for (int m = 0; m < 4; ++m)
#pragma unroll
                for (int bj = 0; bj < 2; ++bj) xa[m][bj] = *(const u32x4*)(X + (size_t)(row0 + ai * HALF + m * 16) * D + col0 + bj * 32);
#pragma unroll
            for (int m = 0; m < 4; ++m) { bf16* rowp = X + (size_t)(row0 + ai * HALF + m * 16) * D + col0;
#pragma unroll
                for (int bj = 0; bj < 2; ++bj) { const f32x4 a = acc[ai][bj][m][0] * gv[bj][0], b = acc[ai][bj][m][1] * gv[bj][1]; const u32x4 x = xa[m][bj]; u32x4 w;
                    w.x = cvt_pk_bf16(bflo(x.x) + a[0], bfhi(x.x) + a[1]); w.y = cvt_pk_bf16(bflo(x.y) + a[2], bfhi(x.y) + a[3]);
                    w.z = cvt_pk_bf16(bflo(x.z) + b[0], bfhi(x.z) + b[1]); w.w = cvt_pk_bf16(bflo(x.w) + b[2], bfhi(x.w) + b[3]);
                    *(u32x4*)(rowp + bj * 32) = w; }
            }
        }
    }
};
template <bool FINAL>
struct EpiResidNorm {
    static constexpr bool PERM = true, KEEP = false;
    bf16* X; const float* modl; int gi; const float* ng; float* out; unsigned* xch; unsigned* cnt; LAS unsigned char* tab; unsigned want; bf16* H; const float* sc; const float* sh;
    __device__ __forceinline__ bool keep(const Unit&) const { return false; }
    __device__ __forceinline__ void operator()(f32x4 (&acc)[2][2][4][2], const Unit& u, int wr, int wc, int fr, int fq) const {
        const int lane = fq * 16 + fr, wid = wr * 4 + wc;
        const int row0 = u.pm * BM + wr * 64 + fr, col0 = u.pn * BM + wc * 64 + 8 * fq;
        LAS float* P = (LAS float*)tab; LAS float* S = (LAS float*)(tab + 4096);
        {
            const float* gate = modl + (size_t)6 * D + gi * D + col0;
            f32x4 gv[2][2];
#pragma unroll
            for (int bj = 0; bj < 2; ++bj)
#pragma unroll
                for (int n = 0; n < 2; ++n) gv[bj][n] = *(const f32x4*)(gate + bj * 32 + n * 4);
#pragma unroll
            for (int ai = 0; ai < 2; ++ai) {
                u32x4 xa[4][2];
#pragma unroll
                for (int m = 0; m < 4; ++m)
#pragma unroll
                    for (int bj = 0; bj < 2; ++bj) xa[m][bj] = *(const u32x4*)(X + (size_t)(row0 + ai * HALF + m * 16) * D + col0 + bj * 32);
#pragma unroll
                for (int m = 0; m < 4; ++m) { float ss = 0.f;
#pragma unroll
                    for (int bj = 0; bj < 2; ++bj) { const f32x4 a = acc[ai][bj][m][0] * gv[bj][0], b = acc[ai][bj][m][1] * gv[bj][1]; const u32x4 x = xa[m][bj]; u32x4 w;
                        w.x = cvt_pk_bf16(bflo(x.x) + a[0], bfhi(x.x) + a[1]); w.y = cvt_pk_bf16(bflo(x.y) + a[2], bfhi(x.y) + a[3]);
                        w.z = cvt_pk_bf16(bflo(x.z) + b[0], bfhi(x.z) + b[1]); w.w = cvt_pk_bf16(bflo(x.w) + b[2], bfhi(x.w) + b[3]);
                        if (!FINAL) *(u32x4*)(X + (size_t)(row0 + ai * HALF + m * 16) * D + col0 + bj * 32) = w;
                        const f32x4 v0 = (f32x4){bflo(w.x), bfhi(w.x), bflo(w.y), bfhi(w.y)}, v1 = (f32x4){bflo(w.z), bfhi(w.z), bflo(w.w), bfhi(w.w)};
                        acc[ai][bj][m][0] = v0; acc[ai][bj][m][1] = v1;
                        ss += ((v0[0] * v0[0] + v0[1] * v0[1]) + (v0[2] * v0[2] + v0[3] * v0[3])) + ((v1[0] * v1[0] + v1[1] * v1[1]) + (v1[2] * v1[2] + v1[3] * v1[3])); }
                    ss += __shfl_xor(ss, 16); ss += __shfl_xor(ss, 32);
                    if (fq == 0) P[(ai * HALF + wr * 64 + m * 16 + fr) * 4 + wc] = ss; }
            }
        }
        asm volatile("s_waitcnt lgkmcnt(0)" ::: "memory"); __builtin_amdgcn_s_barrier(); asm volatile("" ::: "memory");
        const int prow = wid * 32 + (lane & 31);
        if (lane < 32) { const float t = (P[prow * 4 + 0] + P[prow * 4 + 1]) + (P[prow * 4 + 2] + P[prow * 4 + 3]);
            __hip_atomic_store(xch + (size_t)(u.pm * BM + prow) * 8 + u.pn, __float_as_uint(t), __ATOMIC_RELAXED, __HIP_MEMORY_SCOPE_AGENT); }
        asm volatile("s_waitcnt vmcnt(0)" ::: "memory");
        if (lane == 0) __hip_atomic_fetch_add(cnt + 64 * u.pm, 1u, __ATOMIC_RELAXED, __HIP_MEMORY_SCOPE_AGENT);
        if (wid == 0) { unsigned sp = 0;
            while ((unsigned)__builtin_amdgcn_readfirstlane(__hip_atomic_load(cnt + 64 * u.pm, __ATOMIC_RELAXED, __HIP_MEMORY_SCOPE_AGENT)) < want && ++sp < (1u << 20)) __builtin_amdgcn_s_sleep(2);
            __builtin_amdgcn_fence(__ATOMIC_ACQUIRE, "agent"); }
        asm volatile("s_waitcnt vmcnt(0) lgkmcnt(0)" ::: "memory"); __builtin_amdgcn_s_barrier(); asm volatile("" ::: "memory");
        if (lane < 32) { const unsigned* sl = xch + (size_t)(u.pm * BM + prow) * 8; float tot = 0.f;
#pragma unroll
            for (int t = 0; t < 8; ++t) tot += __uint_as_float(__hip_atomic_load(sl + t, __ATOMIC_RELAXED, __HIP_MEMORY_SCOPE_AGENT));
            S[prow] = rsqrtf(tot * (1.f / D) + EPS); }
        asm volatile("s_waitcnt vmcnt(0) lgkmcnt(0)" ::: "memory"); __builtin_amdgcn_s_barrier(); asm volatile("" ::: "memory");
        f32x4 gg[2][2], hh[2][2];
#pragma unroll
        for (int bj = 0; bj < 2; ++bj)
#pragma unroll
            for (int n = 0; n < 2; ++n) { gg[bj][n] = *(const f32x4*)(ng + col0 + bj * 32 + n * 4);
                if (!FINAL) { gg[bj][n] = gg[bj][n] * (*(const f32x4*)(sc + col0 + bj * 32 + n * 4) + 1.f); hh[bj][n] = *(const f32x4*)(sh + col0 + bj * 32 + n * 4); } }
#pragma unroll
        for (int ai = 0; ai < 2; ++ai)
#pragma unroll
            for (int m = 0; m < 4; ++m) { const float r = S[ai * HALF + wr * 64 + m * 16 + fr]; const size_t ro = (size_t)(row0 + ai * HALF + m * 16);
#pragma unroll
                for (int bj = 0; bj < 2; ++bj) {
                    if (FINAL) { float* op = out + (ro - CTX) * D + col0 + bj * 32; *(f32x4*)op = acc[ai][bj][m][0] * r * gg[bj][0]; *(f32x4*)(op + 4) = acc[ai][bj][m][1] * r * gg[bj][1]; }
                    else { const f32x4 a = acc[ai][bj][m][0] * r * gg[bj][0] + hh[bj][0], b = acc[ai][bj][m][1] * r * gg[bj][1] + hh[bj][1]; u32x4 w;
                        w.x = cvt_pk_bf16(a[0], a[1]); w.y = cvt_pk_bf16(a[2], a[3]); w.z = cvt_pk_bf16(b[0], b[1]); w.w = cvt_pk_bf16(b[2], b[3]);
                        *(u32x4*)(H + ro * D + col0 + bj * 32) = w; } } }
    }
};
struct EpiRelu2 {            P2(2)
    static constexpr bool PERM = true, KEEP = false;
    bf16* O;
    __device__ __forceinline__ bool keep(const Unit&) const { return false; }
    __device__ __forceinline__ void operator()(f32x4 (&acc)[2][2][4][2], const Unit& u, int wr, int wc, int fr, int fq) const {
        const int row0 = u.pm * BM + wr * 64 + fr, col0 = u.pn * BM + wc * 64 + 8 * fq;
#pragma unroll
        for (int ai = 0; ai < 2; ++ai)
#pragma unroll
            for (int m = 0; m < 4; ++m) { bf16* rowp = O + (size_t)(row0 + ai * HALF + m * 16) * DFF + col0;
#pragma unroll
                for (int bj = 0; bj < 2; ++bj) { f32x4 a = acc[ai][bj][m][0], b = acc[ai][bj][m][1];
#pragma unroll
                    for (int j = 0; j < 4; ++j) { const float x = fmaxf(a[j], 0.f), y = fmaxf(b[j], 0.f); a[j] = x * x; b[j] = y * y; }
                    u32x4 w; w.x = cvt_pk_bf16(a[0], a[1]); w.y = cvt_pk_bf16(a[2], a[3]); w.z = cvt_pk_bf16(b[0], b[1]); w.w = cvt_pk_bf16(b[2], b[3]);
                    *(u32x4*)(rowp + bj * 32) = w; } }
    }
};

__device__ __forceinline__ int rope_src_col(int nv) {
    if (nv >= 2048) return nv;
    const int v = nv & 127, wc = v >> 5, fq = (v >> 3) & 3, n = (v >> 2) & 1, j = v & 3;
    return (nv & ~127) + 64 * (wc >> 1) + 16 * (wc & 1) + 4 * fq + j + 32 * n;
}
__device__ __forceinline__ void p0_transpose_item(const float* W, int N, bf16* WT, int ld, int koff, bool ropeperm, LAS float* scr, int item, int lane) {
    const int nblk = N / 32, kb = item / nblk, nb = item % nblk, k0 = 64 * kb, n0 = 32 * nb;
    const int nsrc = ropeperm ? rope_src_col(n0 + (lane & 31)) : n0 + (lane & 31);
#pragma unroll 8
    for (int i = 0; i < 32; ++i) { const int kk = 2 * i + (lane >> 5); scr[kk * 33 + (lane & 31)] = W[(size_t)(k0 + kk) * N + nsrc]; }
    LDS_WAIT(); asm volatile("" ::: "memory");
    const int c = lane & 7;
#pragma unroll
    for (int j = 0; j < 4; ++j) { const int n = (lane >> 3) + 8 * j; const LAS float* s = scr + (8 * c) * 33 + n;
        u32x4 o; o.x = pk2(s[0 * 33], s[1 * 33]); o.y = pk2(s[2 * 33], s[3 * 33]); o.z = pk2(s[4 * 33], s[5 * 33]); o.w = pk2(s[6 * 33], s[7 * 33]);
        *(u32x4*)(WT + (size_t)(n0 + n) * ld + koff + k0 + 8 * c) = o; }
    LDS_WAIT(); asm volatile("" ::: "memory");
}
__device__ __forceinline__ void p0_prologue(Frame& F) {
    const float* const __attribute__((address_space(4)))* in = F.in;
    const int gw = F.bid * 8 + F.wave, NGW = F.G * 8, lane = F.lane;
    const int gt = F.bid * 512 + F.tid, NGT = F.G * 512;
    {
        float* MOD = (float*)(F.ws + WS_MODP);
        constexpr int NJB = 6 * D / 256, NKQ = 16, KS = D / NKQ;
        for (int it = gw; it < DEPTH * NJB * NKQ; it += NGW) {
            const int l = it / (NJB * NKQ), r = it % (NJB * NKQ), jb = r / NKQ, kq = r % NKQ;
            const float* W = in[I_WADA] + ((size_t)l * D + kq * KS) * 6 * D + jb * 256 + lane * 4;
            f32x4 a0 = (f32x4){0.f, 0.f, 0.f, 0.f}, a1 = a0;
#pragma unroll 16
            for (int k = 0; k < KS; ++k) { const f32x4 w = __builtin_nontemporal_load((const f32x4*)(W + (size_t)k * 6 * D)); const float s0 = silu_f(in[I_CCTX][kq * KS + k]), s1 = silu_f(in[I_C][kq * KS + k]); a0 += w * s0; a1 += w * s1; }
            if (kq == 0) { const f32x4 b = *(const f32x4*)(in[I_BADA] + (size_t)l * 6 * D + jb * 256 + lane * 4); a0 += b; a1 += b; }
            float* o0 = MOD + (size_t)kq * (DEPTH * 2 * 6 * D) + ((size_t)l * 2 + 0) * 6 * D + jb * 256 + lane * 4;
            *(f32x4*)o0 = a0; *(f32x4*)(o0 + 6 * D) = a1;
        }
    }
    {
        LAS float* scr = (LAS float*)(F.lds + F.wave * 16640);
        constexpr int I_IN = (D / 64) * (N_IN / 64), I_BR = (RET_W / 64) * (D / 64), I_BP = (POOL_W / 64) * (D / 64), I_SQ = (D / 64) * (D / 64), I_F1 = (D / 64) * (DFF / 64), I_F2 = (DFF / 64) * (D / 64);
        constexpr int PER_L = I_IN + I_BR + 2 * I_BP + I_SQ + I_F1 + I_F2, TOTAL = DEPTH * PER_L;
        static_assert(8 * 16640 <= SCR_BYTES, "transposer LDS");
        unsigned char* ws = F.ws;
        auto decode = [&](int it, const float*& src, bf16*& dst, int& N, int& ld) {
            const int l = it / PER_L; int r = it % PER_L; const float* W; bf16* WT; int koff = 0, kb, nb;
            if (r < I_IN) { W = in[I_WIN] + (size_t)l * D * N_IN; N = N_IN; WT = (bf16*)(ws + WS_WIN + l * SZ_WIN); ld = D; kb = r / (N_IN / 64); nb = r % (N_IN / 64); }
            else if ((r -= I_IN) < I_BR) { W = in[I_WBR] + (size_t)l * RET_W * D; N = D; WT = (bf16*)(ws + WS_WCAT + l * SZ_WSQ); ld = D; kb = r / (D / 64); nb = r % (D / 64); }
            else if ((r -= I_BR) < I_BP) { W = in[I_WBP] + (size_t)l * POOL_W * D; N = D; WT = (bf16*)(ws + WS_WCAT + l * SZ_WSQ); ld = D; koff = RET_W; kb = r / (D / 64); nb = r % (D / 64); }
            else if ((r -= I_BP) < I_BP) { W = in[I_WBS] + (size_t)l * SG_W * D; N = D; WT = (bf16*)(ws + WS_WCAT + l * SZ_WSQ); ld = D; koff = RET_W + POOL_W; kb = r / (D / 64); nb = r % (D / 64); }
            else if ((r -= I_BP) < I_SQ) { W = in[I_WOUT] + (size_t)l * D * D; N = D; WT = (bf16*)(ws + WS_WOUT + l * SZ_WSQ); ld = D; kb = r / (D / 64); nb = r % (D / 64); }
            else if ((r -= I_SQ) < I_F1) { W = in[I_W1] + (size_t)l * D * DFF; N = DFF; WT = (bf16*)(ws + WS_W1 + l * SZ_WFF); ld = D; kb = r / (DFF / 64); nb = r % (DFF / 64); }
            else { r -= I_F1; W = in[I_W2] + (size_t)l * DFF * D; N = D; WT = (bf16*)(ws + WS_W2 + l * SZ_WFF); ld = DFF; kb = r / (D / 64); nb = r % (D / 64); }
            const int k0 = 64 * kb, n0 = 64 * nb;
            src = W + (size_t)k0 * N + n0;
            dst = WT + (size_t)n0 * ld + koff + k0;
        };
#define P0_LOAD(buf, srcu, Nu) do { const unsigned loff_ = (unsigned)(((lane >> 5) * (Nu) + 2 * (lane & 31)) * 4); \
            _Pragma("unroll") for (int i = 0; i < 32; ++i) buf[i] = __builtin_nontemporal_load((const f32x2*)((const char*)((srcu) + (size_t)(2 * i) * (Nu)) + loff_)); } while (0)
        f32x2 bufA[32], bufB[32];
        const float* sA; bf16* dA; int NA, ldA; const float* sB; bf16* dB; int NB, ldB;
        auto process = [&](f32x2 (&buf)[32], bf16* dst, int ld) {
#pragma unroll
            for (int i = 0; i < 32; ++i) { LAS float* q = scr + (2 * i + (lane >> 5)) * 65 + 2 * (lane & 31); q[0] = buf[i][0]; q[1] = buf[i][1]; }
            LDS_WAIT(); asm volatile("" ::: "memory");
            const int c = lane & 7;
#pragma unroll
            for (int j = 0; j < 8; ++j) { const int n = (lane >> 3) + 8 * j; const LAS float* p = scr + (8 * c) * 65 + n;
                u32x4 o; o.x = pk2(p[0 * 65], p[1 * 65]); o.y = pk2(p[2 * 65], p[3 * 65]); o.z = pk2(p[4 * 65], p[5 * 65]); o.w = pk2(p[6 * 65], p[7 * 65]);
                *(u32x4*)(dst + (size_t)n * ld + 8 * c) = o; }
            LDS_WAIT(); asm volatile("" ::: "memory");
        };
        int it = gw;
        if (it < TOTAL) {
            decode(it, sA, dA, NA, ldA);
            P0_LOAD(bufA, sA, NA);
            for (;;) {
                const int i1 = it + NGW;
                decode(i1 < TOTAL ? i1 : it, sB, dB, NB, ldB);
                P0_LOAD(bufB, sB, NB);
                process(bufA, dA, ldA);
                if (i1 >= TOTAL) break;
                const int i2 = i1 + NGW;
                decode(i2 < TOTAL ? i2 : i1, sA, dA, NA, ldA);
                P0_LOAD(bufA, sA, NA);
                process(bufB, dB, ldB);
                if (i2 >= TOTAL) break;
                it = i2;
            }
        }
#undef P0_LOAD
    }
    {
        bf16* PWT = (bf16*)(F.ws + WS_PWT); bf16* SGW = (bf16*)(F.ws + WS_SGW); float* ROPE = (float*)(F.ws + WS_ROPE);
        for (int i = gt; i < DEPTH * 4 * 128 * 128; i += NGT) {
            const int lg = i >> 14, d = (i >> 7) & 127, c = i & 127;
            PWT[i] = (bf16)f2bf(in[I_PW][(size_t)lg * 16384 + c * 128 + d]);
            SGW[i] = (bf16)f2bf(in[I_SGW][i]);
        }
        for (int i = gt; i < 128 * 32; i += NGT) { const int pos = i >> 5, f = i & 31; const float inv = powf(10000.f, -(float)f / 32.f); const float ang = (float)pos * inv; ROPE[2 * i] = cosf(ang); ROPE[2 * i + 1] = sinf(ang); }
    }
}

__device__ __forceinline__ void mod_reduce_phase(Frame& F) {
    const float* P = (const float*)(F.ws + WS_MODP); float* MOD = (float*)(F.ws + WS_MOD);
    for (int i = F.bid * 512 + F.tid; i < DEPTH * 2 * 6 * D; i += F.G * 512) { float s = 0.f;
#pragma unroll
        for (int k = 0; k < 16; ++k) s += P[(size_t)k * (DEPTH * 2 * 6 * D) + i];
        MOD[i] = s; }
}
__device__ __forceinline__ void norm_phase(Frame& F, const float* g, const float* modl, int si, bool first, const float* slab_gate = nullptr) {
    bf16* X = (bf16*)(F.ws + WS_X); bf16* H = (bf16*)(F.ws + WS_H);
    const int gw = F.bid * 8 + F.wave, NGW = F.G * 8, lane = F.lane;
    if (slab_gate) {
        LAS float* red = (LAS float*)F.lds;
        for (int row = F.bid; row < CTX; row += F.G) {
            const int c = 256 * F.wave + 4 * lane;
            const float* SL = (const float*)(F.ws + WS_SLAB) + (size_t)row * D + c;
            f32x4 sm = *(const f32x4*)SL;
#pragma unroll
            for (int k = 1; k < 4; ++k) sm += *(const f32x4*)(SL + (size_t)k * CTX * D);
            const u32x2 xo = *(const u32x2*)(X + (size_t)row * D + c); const f32x4 gt = *(const f32x4*)(slab_gate + c);
            u32x2 xn; xn.x = cvt_pk_bf16(bflo(xo.x) + gt[0] * sm[0], bfhi(xo.x) + gt[1] * sm[1]); xn.y = cvt_pk_bf16(bflo(xo.y) + gt[2] * sm[2], bfhi(xo.y) + gt[3] * sm[3]);
            *(u32x2*)(X + (size_t)row * D + c) = xn;
            const float v0 = bflo(xn.x), v1 = bfhi(xn.x), v2 = bflo(xn.y), v3 = bfhi(xn.y);
            const float ps = wave_sum((v0 * v0 + v1 * v1) + (v2 * v2 + v3 * v3));
            __syncthreads();
            if (lane == 0) red[F.wave] = ps;
            __syncthreads();
            float tot = 0.f;
#pragma unroll
            for (int k = 0; k < 8; ++k) tot += red[k];
            const float r = rsqrtf(tot * (1.f / D) + EPS);
            const f32x4 gg = *(const f32x4*)(g + c), sc = *(const f32x4*)(modl + (si + 1) * D + c), sh = *(const f32x4*)(modl + si * D + c);
            u32x2 w; w.x = cvt_pk_bf16(v0 * r * gg[0] * (sc[0] + 1.f) + sh[0], v1 * r * gg[1] * (sc[1] + 1.f) + sh[1]); w.y = cvt_pk_bf16(v2 * r * gg[2] * (sc[2] + 1.f) + sh[2], v3 * r * gg[3] * (sc[3] + 1.f) + sh[3]);
            *(u32x2*)(H + (size_t)row * D + c) = w;
        }
    }
    if (!first) {
        int row = slab_gate ? CTX + gw : gw;
        u32x4 cur[4], nxt[4];
        if (row < MROWS) {
#pragma unroll
            for (int j = 0; j < 4; ++j) cur[j] = *(const u32x4*)(X + (size_t)row * D + j * 512 + lane * 8);
        }
        while (row < MROWS) {
            const int nrow = row + NGW;
            if (nrow < MROWS) {
#pragma unroll
                for (int j = 0; j < 4; ++j) nxt[j] = *(const u32x4*)(X + (size_t)nrow * D + j * 512 + lane * 8);
            }
            float v[32]; float s = 0.f;
#pragma unroll
            for (int j = 0; j < 4; ++j)
#pragma unroll
                for (int e = 0; e < 4; ++e) { v[8 * j + 2 * e] = bflo(cur[j][e]); v[8 * j + 2 * e + 1] = bfhi(cur[j][e]); }
#pragma unroll
            for (int e = 0; e < 32; ++e) s += v[e] * v[e];
            const float r = rsqrtf(wave_sum(s) * (1.f / D) + EPS);
            const float* m = modl + (size_t)(row < CTX ? 0 : 1) * 6 * D;
#pragma unroll
            for (int j = 0; j < 4; ++j) { const int c = j * 512 + lane * 8; float o[8];
#pragma unroll
                for (int h = 0; h < 2; ++h) { const f32x4 gg = *(const f32x4*)(g + c + 4 * h), sc = *(const f32x4*)(m + (si + 1) * D + c + 4 * h), sh = *(const f32x4*)(m + si * D + c + 4 * h);
#pragma unroll
                    for (int e = 0; e < 4; ++e) o[4 * h + e] = v[8 * j + 4 * h + e] * r * gg[e] * (sc[e] + 1.f) + sh[e]; }
                u32x4 w; w.x = cvt_pk_bf16(o[0], o[1]); w.y = cvt_pk_bf16(o[2], o[3]); w.z = cvt_pk_bf16(o[4], o[5]); w.w = cvt_pk_bf16(o[6], o[7]);
                *(u32x4*)(H + (size_t)row * D + c) = w; }
#pragma unroll
            for (int j = 0; j < 4; ++j) cur[j] = nxt[j];
            row = nrow;
        }
        return;
    }
    for (int row = slab_gate ? CTX + gw : gw; row < MROWS; row += NGW) {
        float v[32]; float s = 0.f;
        if (first) {
            const float* src = row < CTX ? F.in[I_CTX] + (size_t)row * D : F.in[I_X] + (size_t)(row - CTX) * D;
#pragma unroll
            for (int j = 0; j < 4; ++j) { const f32x4 a = *(const f32x4*)(src + j * 512 + lane * 8), b = *(const f32x4*)(src + j * 512 + lane * 8 + 4);
#pragma unroll
                for (int e = 0; e < 4; ++e) { v[8 * j + e] = a[e]; v[8 * j + 4 + e] = b[e]; }
                u32x4 w; w.x = cvt_pk_bf16(a[0], a[1]); w.y = cvt_pk_bf16(a[2], a[3]); w.z = cvt_pk_bf16(b[0], b[1]); w.w = cvt_pk_bf16(b[2], b[3]);
                *(u32x4*)(X + (size_t)row * D + j * 512 + lane * 8) = w; }
        } else {
#pragma unroll
            for (int j = 0; j < 4; ++j) { const u32x4 x = *(const u32x4*)(X + (size_t)row * D + j * 512 + lane * 8);
#pragma unroll
                for (int e = 0; e < 4; ++e) { v[8 * j + 2 * e] = bflo(x[e]); v[8 * j + 2 * e + 1] = bfhi(x[e]); } }
        }
#pragma unroll
        for (int e = 0; e < 32; ++e) s += v[e] * v[e];
        const float r = rsqrtf(wave_sum(s) * (1.f / D) + EPS);
        const float* m = modl + (size_t)(row < CTX ? 0 : 1) * 6 * D;
#pragma unroll
        for (int j = 0; j < 4; ++j) { const int c = j * 512 + lane * 8; float o[8];
#pragma unroll
            for (int h = 0; h < 2; ++h) { const f32x4 gg = *(const f32x4*)(g + c + 4 * h), sc = *(const f32x4*)(m + (si + 1) * D + c + 4 * h), sh = *(const f32x4*)(m + si * D + c + 4 * h);
#pragma unroll
                for (int e = 0; e < 4; ++e) o[4 * h + e] = v[8 * j + 4 * h + e] * r * gg[e] * (sc[e] + 1.f) + sh[e]; }
            u32x4 w; w.x = cvt_pk_bf16(o[0], o[1]); w.y = cvt_pk_bf16(o[2], o[3]); w.z = cvt_pk_bf16(o[4], o[5]); w.w = cvt_pk_bf16(o[6], o[7]);
            *(u32x4*)(H + (size_t)row * D + c) = w; }
    }
}
#ifndef FUSE_FINAL
#define FUSE_FINAL 1
#endif
__device__ __forceinline__ void final_norm_phase(Frame& F, float* out) {
    if (FUSE_FINAL) return;
    const bf16* X = (const bf16*)(F.ws + WS_X); const float* g = F.in[I_FNG];
    const int gw = F.bid * 8 + F.wave, NGW = F.G * 8, lane = F.lane;
    u32x4 cur[4], nxt[4];
    if (gw < SEQ) {
#pragma unroll
        for (int j = 0; j < 4; ++j) cur[j] = *(const u32x4*)(X + (size_t)(gw + CTX) * D + j * 512 + lane * 8);
    }
    for (int row = gw; row < SEQ; row += NGW) {
        if (row + NGW < SEQ) {
#pragma unroll
            for (int j = 0; j < 4; ++j) nxt[j] = *(const u32x4*)(X + (size_t)(row + NGW + CTX) * D + j * 512 + lane * 8);
        }
        float v[32]; float s = 0.f;
#pragma unroll
        for (int j = 0; j < 4; ++j) { const u32x4 x = cur[j];
#pragma unroll
            for (int e = 0; e < 4; ++e) { v[8 * j + 2 * e] = bflo(x[e]); v[8 * j + 2 * e + 1] = bfhi(x[e]); } }
#pragma unroll
        for (int e = 0; e < 32; ++e) s += v[e] * v[e];
        const float r = rsqrtf(wave_sum(s) * (1.f / D) + EPS);
#pragma unroll
        for (int j = 0; j < 4; ++j) { const int c = j * 512 + lane * 8;
#pragma unroll
            for (int h = 0; h < 2; ++h) { const f32x4 gg = *(const f32x4*)(g + c + 4 * h); f32x4 o;
#pragma unroll
                for (int e = 0; e < 4; ++e) o[e] = v[8 * j + 4 * h + e] * r * gg[e];
                *(f32x4*)(out + (size_t)row * D + c + 4 * h) = o; } }
#pragma unroll
        for (int j = 0; j < 4; ++j) cur[j] = nxt[j];
    }
}

#define MFMA16(a, b, c) __builtin_amdgcn_mfma_f32_16x16x32_bf16((a), (b), (c), 0, 0, 0)
template <bool TWO>
__device__ __forceinline__ void fill_transposed(LAS unsigned char* T0, LAS unsigned char* T1, const bf16* src, size_t ld, int tid, float sc0, float sc1, bool scaled) {
    const int s = tid & 127, dq = tid >> 7;
    const bf16* rp = src + (size_t)s * ld + 32 * dq;
    u32x4 v[4];
#pragma unroll
    for (int kk = 0; kk < 4; ++kk) v[kk] = *(const u32x4*)(rp + 8 * kk);
#pragma unroll
    for (int kk = 0; kk < 4; ++kk)
#pragma unroll
        for (int q = 0; q < 4; ++q) {
            const int d = 32 * dq + 8 * kk + 2 * q; const unsigned w = v[kk][q];
            if (scaled) { const float lo = bflo(w), hi = bfhi(w);
                *(LAS bf16*)(T0 + d * TP + s * 2) = (bf16)f2bf(lo * sc0); *(LAS bf16*)(T0 + (d + 1) * TP + s * 2) = (bf16)f2bf(hi * sc0);
                if (TWO) { *(LAS bf16*)(T1 + d * TP + s * 2) = (bf16)f2bf(lo * sc1); *(LAS bf16*)(T1 + (d + 1) * TP + s * 2) = (bf16)f2bf(hi * sc1); } }
            else { *(LAS bf16*)(T0 + d * TP + s * 2) = (bf16)(w & 0xffffu); *(LAS bf16*)(T0 + (d + 1) * TP + s * 2) = (bf16)(w >> 16); }
        }
}
__device__ __forceinline__ void fill_rows(LAS unsigned char* T, const bf16* src, size_t ld, int tid) {
    const int r = tid >> 4, sg = tid & 15;
    const bf16* rp = src + (size_t)r * ld + sg * 8;
    u32x4 v[4];
#pragma unroll
    for (int q = 0; q < 4; ++q) v[q] = *(const u32x4*)(rp + (size_t)(32 * q) * ld);
#pragma unroll
    for (int q = 0; q < 4; ++q) *(LAS u32x4*)(T + (r + 32 * q) * TP + sg * 16) = v[q];
}

typedef short s16x4 __attribute__((ext_vector_type(4)));
__device__ __forceinline__ bf16x8 tr_frag(const LAS unsigned char* T, int rowa, int rowb, int col0, int lane) {
    const int i = lane & 15;
    const LAS unsigned char* pa = T + (rowa + (i >> 2)) * TP + (col0 + 4 * (i & 3)) * 2;
    const LAS unsigned char* pb = T + (rowb + (i >> 2)) * TP + (col0 + 4 * (i & 3)) * 2;
    const s16x4 lo = __builtin_amdgcn_ds_read_tr16_b64_v4i16((LAS s16x4*)pa), hi = __builtin_amdgcn_ds_read_tr16_b64_v4i16((LAS s16x4*)pb);
    return (bf16x8){lo[0], lo[1], lo[2], lo[3], hi[0], hi[1], hi[2], hi[3]};
}
__device__ __forceinline__ void kv_item(Frame& F, int l, int c, int h) {
    LAS unsigned char* Kt = F.lds; LAS unsigned char* Vt = F.lds + TILE_B;
    const bf16* ZB = (const bf16*)(F.ws + WS_ZB) + (size_t)c * 128 * N_IN;
    const float* lg = F.in[I_RLOG] + (size_t)l * 2 * RET_H;
    const float l2f = log_sigmoid_f(lg[h]) * LOG2E, l2b = log_sigmoid_f(lg[RET_H + h]) * LOG2E;
    fill_rows(Kt, ZB + C_K + h * HD, N_IN, F.tid);
    fill_rows(Vt, ZB + C_V + h * HD, N_IN, F.tid);
    __syncthreads();
    const int w = F.wave, fr = F.lane & 15, fq = F.lane >> 4;
    bf16x8 vf[4], vb[4];
    float gpf[8], gpb[8];
    { const float gf = exp2f(l2f), gb = exp2f(l2b); gpf[0] = 1.f; gpb[0] = 1.f;
#pragma unroll
      for (int k = 1; k < 8; ++k) { gpf[k] = gpf[k - 1] * gf; gpb[k] = gpb[k - 1] * gb; } }
#pragma unroll
    for (int t = 0; t < 4; ++t) {
        const bf16x8 raw = tr_frag(Vt, 32 * t + 8 * fq, 32 * t + 8 * fq + 4, 16 * w, F.lane);
        const u32x4 rw = __builtin_bit_cast(u32x4, raw); u32x4 pf, pb;
        const int sg0 = 32 * t + 8 * fq;
        const float wf7 = exp2f(l2f * (float)(120 - sg0)), wb0 = exp2f(l2b * (float)sg0);
#pragma unroll
        for (int q = 0; q < 4; ++q) { const float lo = bflo(rw[q]), hi = bfhi(rw[q]);
            pf[q] = cvt_pk_bf16(lo * (wf7 * gpf[7 - 2 * q]), hi * (wf7 * gpf[6 - 2 * q]));
            pb[q] = cvt_pk_bf16(lo * (wb0 * gpb[2 * q]), hi * (wb0 * gpb[2 * q + 1])); }
        vf[t] = __builtin_bit_cast(bf16x8, pf); vb[t] = __builtin_bit_cast(bf16x8, pb);
    }
    bf16* KVT = (bf16*)(F.ws + WS_KVT) + (((size_t)c * RET_H + h) * 2) * 16384 + (size_t)(16 * w + fr) * 128 + 4 * fq;
#pragma unroll
    for (int db = 0; db < 8; ++db) {
        f32x4 af = (f32x4){0.f, 0.f, 0.f, 0.f}, ab = af;
#pragma unroll
        for (int t = 0; t < 4; ++t) {
            const bf16x8 kf = tr_frag(Kt, 32 * t + 8 * fq, 32 * t + 8 * fq + 4, 16 * db, F.lane);
            af = MFMA16(kf, vf[t], af); ab = MFMA16(kf, vb[t], ab);
        }
        u32x2 of, ob; of.x = pk2(af[0], af[1]); of.y = pk2(af[2], af[3]); ob.x = pk2(ab[0], ab[1]); ob.y = pk2(ab[2], ab[3]);
        *(u32x2*)(KVT + 16 * db) = of; *(u32x2*)(KVT + 16384 + 16 * db) = ob;
    }
    __syncthreads();
}
__device__ __forceinline__ void pool_item(Frame& F, int l, int c, int g) {
    LAS unsigned char* Pin = F.lds; LAS unsigned char* PWT = F.lds + 144 * TP; LAS unsigned char* Yl = PWT + TILE_B;
    const bf16* ZB = (const bf16*)(F.ws + WS_ZB);
    const int row0 = c * 128, tid = F.tid;
    for (int p = tid; p < 144 * 16; p += 512) { const int rr = p >> 4, sg = p & 15, grow = row0 - 8 + rr;
        if (grow >= 0 && grow < MROWS) *(LAS u32x4*)(Pin + rr * TP + sg * 16) = *(const u32x4*)(ZB + (size_t)grow * N_IN + C_P + g * 128 + sg * 8); }
    fill_rows(PWT, (const bf16*)(F.ws + WS_PWT) + (size_t)(l * 4 + g) * 16384, 128, tid);
    __syncthreads();
    {
        const int t = tid >> 2, cq = tid & 3, grow = row0 + t;
        int seg0, seglen, pos;
        if (grow < CTX) { seg0 = 0; seglen = CTX; pos = grow; } else { const int tok = grow - CTX; seg0 = CTX + (tok / GRID_W) * GRID_W; seglen = GRID_W; pos = tok % GRID_W; }
        const int w = 2 << g; int lo = pos - w / 2; if (lo < 0) lo = 0; int hi = pos + w / 2 - 1; if (hi > seglen - 1) hi = seglen - 1;
        const float inv = 1.f / (float)(hi - lo + 1);
        float sum[32];
#pragma unroll
        for (int j = 0; j < 32; ++j) sum[j] = 0.f;
        for (int p = lo; p <= hi; ++p) { const LAS unsigned char* rp = Pin + (seg0 + p - (row0 - 8)) * TP + cq * 64;
#pragma unroll
            for (int q = 0; q < 4; ++q) { const u32x4 v = *(const LAS u32x4*)(rp + q * 16);
#pragma unroll
                for (int e = 0; e < 4; ++e) { sum[q * 8 + 2 * e] += bflo(v[e]); sum[q * 8 + 2 * e + 1] += bfhi(v[e]); } } }
        const LAS unsigned char* sp = Pin + (t + 8) * TP + cq * 64;
#pragma unroll
        for (int q = 0; q < 4; ++q) { const u32x4 v = *(const LAS u32x4*)(sp + q * 16); u32x4 o;
#pragma unroll
            for (int e = 0; e < 4; ++e) o[e] = cvt_pk_bf16(sum[q * 8 + 2 * e] * inv - bflo(v[e]), sum[q * 8 + 2 * e + 1] * inv - bfhi(v[e]));
            *(LAS u32x4*)(Yl + t * TP + cq * 64 + q * 16) = o; }
    }
    __syncthreads();
    const int w = F.wave, fr = F.lane & 15, fq = F.lane >> 4;
    bf16x8 yb[4];
#pragma unroll
    for (int t = 0; t < 4; ++t) yb[t] = *(const LAS bf16x8*)(Yl + (16 * w + fr) * TP + (32 * t + 8 * fq) * 2);
    bf16* MIX = (bf16*)(F.ws + WS_MIX) + (size_t)(row0 + 16 * w + fr) * D + RET_W + g * 128 + 4 * fq;
    const float* ps = F.in[I_PS] + (size_t)l * POOL_W + g * 128 + 4 * fq;
    f32x4 scv[8];
#pragma unroll
    for (int db = 0; db < 8; ++db) scv[db] = *(const f32x4*)(ps + 16 * db);
#pragma unroll
    for (int db = 0; db < 8; ++db) {
        f32x4 a = (f32x4){0.f, 0.f, 0.f, 0.f};
#pragma unroll
        for (int t = 0; t < 4; ++t) a = MFMA16(*(const LAS bf16x8*)(PWT + (16 * db + fr) * TP + (32 * t + 8 * fq) * 2), yb[t], a);
        a = a * scv[db];
        u32x2 o; o.x = cvt_pk_bf16(a[0], a[1]); o.y = cvt_pk_bf16(a[2], a[3]);
        *(u32x2*)(MIX + 16 * db) = o;
    }
    __syncthreads();
}
__device__ __forceinline__ void sg_item(Frame& F, int l, int c, int g) {
    LAS unsigned char* VN = F.lds;
    const bf16* ZB = (const bf16*)(F.ws + WS_ZB) + (size_t)c * 128 * N_IN;
    const int tid = F.tid;
    {
        const int w0 = F.wave * 16, lane = F.lane;
        u32x4 rv[16];
#pragma unroll
        for (int i = 0; i < 16; ++i) rv[i] = *(const u32x4*)(ZB + (size_t)(w0 + i) * N_IN + C_SV + 8 * lane);
        const float* ng = F.in[I_SGNG] + (size_t)l * SG_W + 8 * lane;
        const f32x4 n0 = *(const f32x4*)ng, n1 = *(const f32x4*)(ng + 4);
        float ss[16];
#pragma unroll
        for (int i = 0; i < 16; ++i) { const u32x4 v = rv[i]; ss[i] = 0.f;
#pragma unroll
            for (int e = 0; e < 4; ++e) { const float a = bflo(v[e]), b = bfhi(v[e]); ss[i] += a * a + b * b; } }
#pragma unroll
        for (int o = 1; o < 64; o <<= 1)
#pragma unroll
            for (int i = 0; i < 16; ++i) ss[i] += __shfl_xor(ss[i], o);
        if ((lane >> 4) == g) {
#pragma unroll
            for (int i = 0; i < 16; ++i) { const u32x4 v = rv[i]; const float r = rsqrtf(ss[i] * (1.f / SG_W) + EPS); u32x4 o;
                o.x = cvt_pk_bf16(bflo(v.x) * r * n0[0], bfhi(v.x) * r * n0[1]); o.y = cvt_pk_bf16(bflo(v.y) * r * n0[2], bfhi(v.y) * r * n0[3]);
                o.z = cvt_pk_bf16(bflo(v.z) * r * n1[0], bfhi(v.z) * r * n1[1]); o.w = cvt_pk_bf16(bflo(v.w) * r * n1[2], bfhi(v.w) * r * n1[3]);
                *(LAS u32x4*)(VN + (w0 + i) * TP + (lane & 15) * 16) = o; }
        }
    }
    __syncthreads();
    const int w = F.wave, fr = F.lane & 15, fq = F.lane >> 4;
    const bf16* SGW = (const bf16*)(F.ws + WS_SGW) + ((size_t)(l * 4 + g) * 128 + 16 * w + fr) * 128;
    bf16x8 wf[4];
#pragma unroll
    for (int t = 0; t < 4; ++t) wf[t] = *(const bf16x8*)(SGW + 32 * t + 8 * fq);
    const float bias = F.in[I_SGB][(size_t)(l * 4 + g) * 128 + 16 * w + fr];
    const bf16* U = ZB + (size_t)(16 * w + fr) * N_IN + C_U + g * 128 + 4 * fq;
    u32x2 uvv[8];
#pragma unroll
    for (int cb = 0; cb < 8; ++cb) uvv[cb] = *(const u32x2*)(U + 16 * cb);
    bf16* MIX = (bf16*)(F.ws + WS_MIX) + (size_t)(c * 128 + 16 * w + fr) * D + RET_W + POOL_W + g * 128 + 4 * fq;
#pragma unroll
    for (int cb = 0; cb < 8; ++cb) {
        f32x4 a = (f32x4){0.f, 0.f, 0.f, 0.f};
#pragma unroll
        for (int t = 0; t < 4; ++t) a = MFMA16(tr_frag(VN, 32 * t + 8 * fq, 32 * t + 8 * fq + 4, 16 * cb, F.lane), wf[t], a);
        const u32x2 uv = uvv[cb];
        u32x2 o; o.x = cvt_pk_bf16((a[0] + bias) * bflo(uv.x), (a[1] + bias) * bfhi(uv.x)); o.y = cvt_pk_bf16((a[2] + bias) * bflo(uv.y), (a[3] + bias) * bfhi(uv.y));
        *(u32x2*)(MIX + 16 * cb) = o;
    }
    __syncthreads();
}
__device__ __forceinline__ void scan_phase(Frame& F, int l, int nskip) {
    const bf16* KVT = (const bf16*)(F.ws + WS_KVT); bf16* ST = (bf16*)(F.ws + WS_ST);
    const float* lg = F.in[I_RLOG] + (size_t)l * 2 * RET_H;
    if (F.bid < nskip) return;
    const int nw = F.G - nskip, per = (65536 + nw - 1) / nw, p = (F.bid - nskip) * per + F.tid;
    if (F.tid < per && p < 65536) {
        const int hd = p >> 12, h = hd >> 1, dir = hd & 1;
        const float g128 = expf(128.f * log_sigmoid_f(lg[dir * RET_H + h]));
        const size_t e0 = (size_t)p * 4;
        u32x2 kvw[NCHUNK];
#pragma unroll
        for (int c = 0; c < NCHUNK; ++c) kvw[c] = *(const u32x2*)(KVT + (size_t)c * 262144 + e0);
        f32x4 S = (f32x4){0.f, 0.f, 0.f, 0.f};
        if (dir == 0) {
#pragma unroll
            for (int c = 0; c < NCHUNK; ++c) { u32x2 o; o.x = cvt_pk_bf16(S[0], S[1]); o.y = cvt_pk_bf16(S[2], S[3]); *(u32x2*)(ST + (size_t)c * 262144 + e0) = o;
                S = S * g128 + (f32x4){bflo(kvw[c].x), bfhi(kvw[c].x), bflo(kvw[c].y), bfhi(kvw[c].y)}; }
        } else {
#pragma unroll
            for (int i = 0; i < NCHUNK; ++i) { const int c = i < 2 ? 1 - i : NCHUNK + 1 - i; u32x2 o; o.x = cvt_pk_bf16(S[0], S[1]); o.y = cvt_pk_bf16(S[2], S[3]); *(u32x2*)(ST + (size_t)c * 262144 + e0) = o;
                S = S * g128 + (f32x4){bflo(kvw[c].x), bfhi(kvw[c].x), bflo(kvw[c].y), bfhi(kvw[c].y)}; }
        }
    }
}
__device__ __forceinline__ void fill_rows_f32(LAS unsigned char* T, const float* src, int tid) {
    const int r = tid >> 2, sg = tid & 3;
#pragma unroll
    for (int q = 0; q < 4; ++q) { unsigned z = 0u; asm volatile("" : "+v"(z));
        u32x4 w = (u32x4){z, z, z, z};
        if (src) { const f32x4 a = *(const f32x4*)(src + (size_t)r * 128 + sg * 32 + q * 8), b = *(const f32x4*)(src + (size_t)r * 128 + sg * 32 + q * 8 + 4);
            w.x = cvt_pk_bf16(a[0], a[1]); w.y = cvt_pk_bf16(a[2], a[3]); w.z = cvt_pk_bf16(b[0], b[1]); w.w = cvt_pk_bf16(b[2], b[3]); }
        *(LAS u32x4*)(T + r * TP + sg * 64 + q * 16) = w; }
}
__device__ __forceinline__ void ret_core(Frame& F, int l, int c, int h, float l2f, float l2b, const bf16x8 (&qf)[4], const u32x2 (&gvv)[8]) {
    LAS unsigned char* Kt = F.lds; LAS unsigned char* VT = F.lds + TILE_B; LAS unsigned char* SF = F.lds + 2 * TILE_B; LAS unsigned char* SB = F.lds + 3 * TILE_B;
    const int w = F.wave, fr = F.lane & 15, fq = F.lane >> 4;
    const int i = 16 * w + fr;
    bf16x8 pf[4];
#pragma unroll
    for (int tp = 0; tp < 4; ++tp) {
        unsigned pw[4];
#pragma unroll
        for (int bb = 0; bb < 2; ++bb) {
            const int b = 2 * tp + bb;
            f32x4 s = (f32x4){0.f, 0.f, 0.f, 0.f};
#pragma unroll
            for (int t = 0; t < 4; ++t) s = MFMA16(*(const LAS bf16x8*)(Kt + (16 * b + fr) * TP + (32 * t + 8 * fq) * 2), qf[t], s);
            float pv[4];
#pragma unroll
            for (int r = 0; r < 4; ++r) { const int j = 16 * b + 4 * fq + r; const int dd = i - j;
                const float dm = dd > 0 ? exp2f(l2f * (float)dd) : (dd < 0 ? exp2f(l2b * (float)(-dd)) : 2.f); pv[r] = s[r] * dm; }
            pw[2 * bb] = cvt_pk_bf16(pv[0], pv[1]); pw[2 * bb + 1] = cvt_pk_bf16(pv[2], pv[3]);
        }
        u32x4 pk; pk.x = pw[0]; pk.y = pw[1]; pk.z = pw[2]; pk.w = pw[3];
        pf[tp] = __builtin_bit_cast(bf16x8, pk);
    }
    const float af = exp2f(l2f * (float)(i + 1)), ab = exp2f(l2b * (float)(128 - i));
    f32x4 o[8]; float ss = 0.f;
#pragma unroll
    for (int eb = 0; eb < 8; ++eb) {
        f32x4 a0 = (f32x4){0.f, 0.f, 0.f, 0.f}, a1 = a0, a2 = a0;
#pragma unroll
        for (int t = 0; t < 4; ++t) {
            a0 = MFMA16(tr_frag(VT, 32 * t + 4 * fq, 32 * t + 16 + 4 * fq, 16 * eb, F.lane), pf[t], a0);
            a1 = MFMA16(*(const LAS bf16x8*)(SF + (16 * eb + fr) * TP + (32 * t + 8 * fq) * 2), qf[t], a1);
            a2 = MFMA16(*(const LAS bf16x8*)(SB + (16 * eb + fr) * TP + (32 * t + 8 * fq) * 2), qf[t], a2);
        }
        o[eb] = a0 + a1 * af + a2 * ab;
        ss += (o[eb][0] * o[eb][0] + o[eb][1] * o[eb][1]) + (o[eb][2] * o[eb][2] + o[eb][3] * o[eb][3]);
    }
    ss += __shfl_xor(ss, 16); ss += __shfl_xor(ss, 32);
    const float r = rsqrtf(ss * (1.f / HD) + EPS);
    bf16* MIX = (bf16*)(F.ws + WS_MIX) + (size_t)(c * 128 + i) * D + h * HD + 4 * fq;
    f32x4 n4v[8];
    { const float* ng = F.in[I_RNG] + (size_t)l * RET_W + h * HD + 4 * fq;
#pragma unroll
      for (int eb = 0; eb < 8; ++eb) n4v[eb] = *(const f32x4*)(ng + 16 * eb); }
#pragma unroll
    for (int eb = 0; eb < 8; ++eb) {
        const u32x2 gv = gvv[eb]; const f32x4 n4 = n4v[eb];
        const f32x4 v = o[eb] * r * n4;
        u32x2 ov; ov.x = cvt_pk_bf16(v[0] * bflo(gv.x), v[1] * bfhi(gv.x)); ov.y = cvt_pk_bf16(v[2] * bflo(gv.y), v[3] * bfhi(gv.y));
        *(u32x2*)(MIX + 16 * eb) = ov;
    }
    __syncthreads();
}


template <bool CTXSRC>
__device__ __forceinline__ void ret_item(Frame& F, int l, int c, int h) {
    LAS unsigned char* Kt = F.lds; LAS unsigned char* VT = F.lds + TILE_B; LAS unsigned char* SF = F.lds + 2 * TILE_B; LAS unsigned char* SB = F.lds + 3 * TILE_B;
    const bf16* ZB = (const bf16*)(F.ws + WS_ZB) + (size_t)c * 128 * N_IN;
    const bf16* ST = (const bf16*)(F.ws + WS_ST) + (((size_t)c * RET_H + h) * 2) * 16384;
    const float* lg = F.in[I_RLOG] + (size_t)l * 2 * RET_H;
    const float l2f = log_sigmoid_f(lg[h]) * LOG2E, l2b = log_sigmoid_f(lg[RET_H + h]) * LOG2E;
    const int tid = F.tid, w = F.wave, fr = F.lane & 15, fq = F.lane >> 4;
    fill_rows(Kt, ZB + C_K + h * HD, N_IN, tid);
    if (CTXSRC) {
        const bf16* KV = (const bf16*)(F.ws + WS_KVT) + (((size_t)(1 - c) * RET_H + h) * 2) * 16384;
        if (c == 1) fill_rows(SF, KV, 128, tid); else fill_rows_f32(SF, nullptr, tid);
        if (c == 0) fill_rows(SB, KV + 16384, 128, tid); else fill_rows_f32(SB, nullptr, tid);
    } else {
        fill_rows(SF, ST, 128, tid);
        fill_rows(SB, ST + 16384, 128, tid);
    }
    fill_rows(VT, ZB + C_V + h * HD, N_IN, tid);
    bf16x8 qf[4];
    { const bf16* qp = ZB + (size_t)(16 * w + fr) * N_IN + C_Q + h * HD + 8 * fq;
#pragma unroll
      for (int t = 0; t < 4; ++t) qf[t] = *(const bf16x8*)(qp + 32 * t); }
    const int i = 16 * w + fr;
    u32x2 gvv[8];
    { const bf16* G = ZB + (size_t)i * N_IN + C_G + h * HD + 4 * fq;
#pragma unroll
      for (int eb = 0; eb < 8; ++eb) gvv[eb] = *(const u32x2*)(G + 16 * eb); }
    __syncthreads();
    ret_core(F, l, c, h, l2f, l2b, qf, gvv);
}
__device__ __forceinline__ void ret_tiles_load(Frame& F, int c, int h, u32x4 (&pf)[8]) {
    const bf16* ZB = (const bf16*)(F.ws + WS_ZB) + (size_t)c * 128 * N_IN;
    int t = F.tid; asm volatile("" : "+v"(t));
    const int r = t >> 4, sg = t & 15;
#pragma unroll
    for (int q = 0; q < 4; ++q) { pf[q] = *(const u32x4*)(ZB + (size_t)(r + 32 * q) * N_IN + C_K + h * HD + sg * 8); pf[4 + q] = *(const u32x4*)(ZB + (size_t)(r + 32 * q) * N_IN + C_V + h * HD + sg * 8); }
}
__device__ __forceinline__ void ret_item_pipe(Frame& F, int l, int c, int h, u32x4 (&pf)[8], int nc, int nh, bool has_next) {
    LAS unsigned char* Kt = F.lds; LAS unsigned char* VT = F.lds + TILE_B; LAS unsigned char* SF = F.lds + 2 * TILE_B; LAS unsigned char* SB = F.lds + 3 * TILE_B;
    const bf16* ZB = (const bf16*)(F.ws + WS_ZB) + (size_t)c * 128 * N_IN;
    const bf16* ST = (const bf16*)(F.ws + WS_ST) + (((size_t)c * RET_H + h) * 2) * 16384;
    const float* lg = F.in[I_RLOG] + (size_t)l * 2 * RET_H;
    const float l2f = log_sigmoid_f(lg[h]) * LOG2E, l2b = log_sigmoid_f(lg[RET_H + h]) * LOG2E;
    const int w = F.wave, fr = F.lane & 15, fq = F.lane >> 4, r = F.tid >> 4, sg = F.tid & 15;
    fill_rows(SF, ST, 128, F.tid);
    fill_rows(SB, ST + 16384, 128, F.tid);
    bf16x8 qf[4];
    { const bf16* qp = ZB + (size_t)(16 * w + fr) * N_IN + C_Q + h * HD + 8 * fq;
#pragma unroll
      for (int t = 0; t < 4; ++t) qf[t] = *(const bf16x8*)(qp + 32 * t); }
    u32x2 gvv[8];
    { const bf16* G = ZB + (size_t)(16 * w + fr) * N_IN + C_G + h * HD + 4 * fq;
#pragma unroll
      for (int eb = 0; eb < 8; ++eb) gvv[eb] = *(const u32x2*)(G + 16 * eb); }
#pragma unroll
    for (int q = 0; q < 4; ++q) { const int o = (r + 32 * q) * TP + sg * 16; *(LAS u32x4*)(Kt + o) = pf[q]; *(LAS u32x4*)(VT + o) = pf[4 + q]; }
    __syncthreads();
    if (has_next) ret_tiles_load(F, nc, nh, pf);
    ret_core(F, l, c, h, l2f, l2b, qf, gvv);
}
template <int R, int C, int WR, int WC, int KC>
__device__ __forceinline__ void skinny_acc(Frame& F, f32x4 (&acc)[WR][WC], const bf16* A, int lda, const bf16* Bt, int ldb, int K) {
    constexpr int PITCH = KC * 2 + 16, SEGS = KC / 8, PIECES = (R + C) * SEGS, PPT = PIECES / 512, STAGE = (R + C) * PITCH, WGC = C / 16 / WC;
    static_assert(PIECES % 512 == 0 && (R / 16 / WR) * WGC == 8 && 2 * STAGE <= SCR_BYTES, "skinny geometry");
    const int tid = F.tid, fr = F.lane & 15, fq = F.lane >> 4, wgr = F.wave / WGC, wgc = F.wave % WGC;
    u32x4 rg0[PPT], rg1[PPT];
    const bf16* src[PPT]; int dst[PPT];
#pragma unroll
    for (int q = 0; q < PPT; ++q) { const int p = tid + 512 * q, row = p / SEGS, sg = p % SEGS;
        src[q] = row < R ? A + (size_t)row * lda + sg * 8 : Bt + (size_t)(row - R) * ldb + sg * 8; dst[q] = row * PITCH + sg * 16; }
#define SK_GLOAD(rg, k0) do { _Pragma("unroll") for (int q = 0; q < PPT; ++q) rg[q] = *(const u32x4*)(src[q] + (k0)); } while (0)
#define SK_LSTORE(rg, buf) do { _Pragma("unroll") for (int q = 0; q < PPT; ++q) *(LAS u32x4*)(F.lds + (buf) * STAGE + dst[q]) = rg[q]; } while (0)
#define SK_COMPUTE(buf) do { const LAS unsigned char* bA = F.lds + (buf) * STAGE; const LAS unsigned char* bB = bA + R * PITCH; \
        _Pragma("unroll") for (int t = 0; t < KC / 32; ++t) { bf16x8 af[WR], bfr[WC]; \
            _Pragma("unroll") for (int i = 0; i < WR; ++i) af[i] = *(const LAS bf16x8*)(bA + (16 * (wgr * WR + i) + fr) * PITCH + (32 * t + 8 * fq) * 2); \
            _Pragma("unroll") for (int j = 0; j < WC; ++j) bfr[j] = *(const LAS bf16x8*)(bB + (16 * (wgc * WC + j) + fr) * PITCH + (32 * t + 8 * fq) * 2); \
            _Pragma("unroll") for (int i = 0; i < WR; ++i) _Pragma("unroll") for (int j = 0; j < WC; ++j) acc[i][j] = MFMA16(bfr[j], af[i], acc[i][j]); } } while (0)
    const int nch = K / KC;
    __syncthreads();
    SK_GLOAD(rg0, 0); SK_GLOAD(rg1, KC);
    for (int ch = 0; ch < nch; ch += 2) {
        SK_LSTORE(rg0, 0); __syncthreads();
        if (ch + 2 < nch) SK_GLOAD(rg0, (ch + 2) * KC);
        SK_COMPUTE(0);
        SK_LSTORE(rg1, 1); __syncthreads();
        if (ch + 3 < nch) SK_GLOAD(rg1, (ch + 3) * KC);
        SK_COMPUTE(1);
    }
#undef SK_GLOAD
#undef SK_LSTORE
#undef SK_COMPUTE
}
template <int MODE>
__device__ __forceinline__ void ctx_n2048(Frame& F, int l, const bf16* A, const bf16* Bt, int gi, float dry) {
    if (F.G != 256) return;
    constexpr int AP = D * 2 + 16, PART = 32 * AP;
    static_assert(PART + 8 * 64 * 16 <= SCR_BYTES, "ctx_n2048 LDS");
    const int r0 = 32 * (F.bid >> 5), c0 = 64 * (F.bid & 31), fr = F.lane & 15, fq = F.lane >> 4, j = F.wave & 3, kh = F.wave >> 2, tid = F.tid;
    u32x4 av[16];
#pragma unroll
    for (int q = 0; q < 16; ++q) { const int p = tid + 512 * q; av[q] = *(const u32x4*)(A + (size_t)(r0 + (p >> 8)) * D + (p & 255) * 8); }
    const bf16* bp = Bt + (size_t)(c0 + 16 * j + fr) * D + 1024 * kh + 8 * fq;
    bf16x8 bfv[32];
#pragma unroll
    for (int t = 0; t < 16; ++t) bfv[t] = *(const bf16x8*)(bp + 32 * t);
    const int col = c0 + 16 * j + 4 * fq;
    unsigned g0[2], g1[2]; u32x2 xo[2]; f32x4 gt = (f32x4){0.f, 0.f, 0.f, 0.f};
#pragma unroll
    for (int i = 0; i < 2; ++i) { const int row = r0 + 16 * i + fr;
        if (MODE == 0) { const unsigned char* gp = (const unsigned char*)(F.ws + WS_ZB) + (size_t)row * (N_IN * 2) + 2 * C_GATE + col;
            g0[i] = *(const unsigned*)(gp + kh * D); g1[i] = *(const unsigned*)(gp + 2 * kh * D); }
        else xo[i] = *(const u32x2*)((const bf16*)(F.ws + WS_X) + (size_t)row * D + col); }
    if (MODE == 1) gt = *(const f32x4*)((const float*)(F.ws + WS_MOD) + ((size_t)l * 2 + 0) * 6 * D + gi * D + col) * dry;
    __syncthreads();
#pragma unroll
    for (int q = 0; q < 16; ++q) { const int p = tid + 512 * q; *(LAS u32x4*)(F.lds + (p >> 8) * AP + (p & 255) * 16) = av[q]; }
#pragma unroll
    for (int t = 16; t < 32; ++t) bfv[t] = *(const bf16x8*)(bp + 32 * t);
    __syncthreads();
    f32x4 acc[2][2];
#pragma unroll
    for (int s2 = 0; s2 < 2; ++s2)
#pragma unroll
        for (int i = 0; i < 2; ++i) acc[s2][i] = (f32x4){0.f, 0.f, 0.f, 0.f};
    const LAS unsigned char* ap = F.lds + fr * AP + (1024 * kh + 8 * fq) * 2;
#pragma unroll
    for (int t = 0; t < 32; ++t) { const int s2 = (MODE == 0 && t >= 16) ? 1 : 0;
        const bf16x8 a0 = *(const LAS bf16x8*)(ap + 64 * t), a1 = *(const LAS bf16x8*)(ap + 16 * AP + 64 * t);
        acc[s2][0] = MFMA16(bfv[t], a0, acc[s2][0]); acc[s2][1] = MFMA16(bfv[t], a1, acc[s2][1]); }
    f32x4 y[2];
#pragma unroll
    for (int i = 0; i < 2; ++i) {
        if (MODE == 0) {
#pragma unroll
            for (int e = 0; e < 4; ++e) y[i][e] = (acc[0][i][e] * (float)((g0[i] >> (8 * e)) & 255u) + acc[1][i][e] * (float)((g1[i] >> (8 * e)) & 255u)) * (1.f / 255.f);
        } else y[i] = acc[0][i];
    }
    LAS f32x4* part = (LAS f32x4*)(F.lds + PART);
    if (kh == 1) { part[(j * 2 + 0) * 64 + F.lane] = y[0]; part[(j * 2 + 1) * 64 + F.lane] = y[1]; }
    __syncthreads();
    if (kh == 0) {
#pragma unroll
        for (int i = 0; i < 2; ++i) { const int row = r0 + 16 * i + fr; const f32x4 v = y[i] + part[(j * 2 + i) * 64 + F.lane];
            if (MODE == 0) { u32x2 o; o.x = cvt_pk_bf16(v[0], v[1]); o.y = cvt_pk_bf16(v[2], v[3]); *(u32x2*)((bf16*)(F.ws + WS_Y) + (size_t)row * D + col) = o; }
            else { const f32x4 d = gt * v; u32x2 xn; xn.x = cvt_pk_bf16(bflo(xo[i].x) + d[0], bfhi(xo[i].x) + d[1]); xn.y = cvt_pk_bf16(bflo(xo[i].y) + d[2], bfhi(xo[i].y) + d[3]);
                *(u32x2*)((bf16*)(F.ws + WS_X) + (size_t)row * D + col) = xn; }
        }
    }
    __syncthreads();
}
__device__ __forceinline__ void ctx_up(Frame& F, const bf16* Bt) {
    if (F.G != 256) return;
    const int r0 = 64 * (F.bid >> 6), c0 = 128 * (F.bid & 63), fr = F.lane & 15, fq = F.lane >> 4, wgr = F.wave >> 2, wgc = F.wave & 3;
    f32x4 acc[2][2];
#pragma unroll
    for (int i = 0; i < 2; ++i)
#pragma unroll
        for (int j = 0; j < 2; ++j) acc[i][j] = (f32x4){0.f, 0.f, 0.f, 0.f};
    skinny_acc<64, 128, 2, 2, 128>(F, acc, (const bf16*)(F.ws + WS_H) + (size_t)r0 * D, D, Bt + (size_t)c0 * D, D, D);
#pragma unroll
    for (int i = 0; i < 2; ++i)
#pragma unroll
        for (int j = 0; j < 2; ++j) { const int row = r0 + 16 * (wgr * 2 + i) + fr, col = c0 + 16 * (wgc * 2 + j) + 4 * fq; f32x4 a = acc[i][j];
#pragma unroll
            for (int q = 0; q < 4; ++q) { const float x = fmaxf(a[q], 0.f); a[q] = x * x; }
            u32x2 o; o.x = cvt_pk_bf16(a[0], a[1]); o.y = cvt_pk_bf16(a[2], a[3]);
            *(u32x2*)((bf16*)(F.ws + WS_A1) + (size_t)row * DFF + col) = o; }
}

__device__ __forceinline__ void ctx_down_splitk(Frame& F, const bf16* Bt) {
    if (F.G != 256) return;
    const int ks = F.bid >> 6, r0 = 64 * ((F.bid >> 4) & 3), c0 = 128 * (F.bid & 15), fr = F.lane & 15, fq = F.lane >> 4, wgr = F.wave >> 2, wgc = F.wave & 3;
    f32x4 acc[2][2];
#pragma unroll
    for (int i = 0; i < 2; ++i)
#pragma unroll
        for (int j = 0; j < 2; ++j) acc[i][j] = (f32x4){0.f, 0.f, 0.f, 0.f};
    skinny_acc<64, 128, 2, 2, 128>(F, acc, (const bf16*)(F.ws + WS_A1) + (size_t)r0 * DFF + ks * 2048, DFF, Bt + (size_t)c0 * DFF + ks * 2048, DFF, 2048);
    float* SL = (float*)(F.ws + WS_SLAB) + (size_t)ks * CTX * D;
#pragma unroll
    for (int i = 0; i < 2; ++i)
#pragma unroll
        for (int j = 0; j < 2; ++j) { const int row = r0 + 16 * (wgr * 2 + i) + fr, col = c0 + 16 * (wgc * 2 + j) + 4 * fq; *(f32x4*)(SL + (size_t)row * D + col) = acc[i][j]; }
}

constexpr int PH_PER_LAYER = 10, PH_PRE = 3, N_PHASES = PH_PRE + DEPTH * PH_PER_LAYER;
__global__ void __launch_bounds__(512, 2) mk_fwd(Args args) {
    extern __shared__ __attribute__((aligned(16))) unsigned char lds_raw[];
    LAS unsigned char* const ldsb = (LAS unsigned char*)lds_raw;
    volatile LAS unsigned* MISC = (volatile LAS unsigned*)(ldsb + MISC_OFF);
    for (int u = threadIdx.x; u < 64; u += 512) MISC[u] = 0u;
    __syncthreads();
    unsigned* barw = (unsigned*)(args.ws + WS_BAR);
    XcdBarrier bar; bar.bar = barw; bar.x = 0; bar.st = MISC + 8;
    if (!MK_SPLIT) bar = xcd_barrier_post(barw, MISC + 8);
    const int lo = args.ph_lo, hi = args.ph_hi;
#define IN(k) (lo <= (k) && (k) < hi)
#define SEAM(k) do { if (IN((k) + 1)) xcd_barrier(bar); } while (0)
#define MODP(F) ((const float*)((F).ws + WS_MOD))

    if (IN(0) && (PMASK & 1)) { for (int rep = 0; rep < ((DUP >> 12) & 1) + 1; ++rep) { Frame F; make_frame(F, ldsb); p0_prologue(F); __syncthreads(); } SEAM(0); }
    if (IN(1) && (PMASK & 1)) { Frame F; make_frame(F, ldsb); mod_reduce_phase(F); SEAM(1); }
    if (IN(2) && (PMASK & 2)) { Frame F; make_frame(F, ldsb); norm_phase(F, F.in[I_N1G], MODP(F), 0, true); SEAM(2); }

    for (int l = 0; l < DEPTH; ++l) {
        const int pb = PH_PRE + l * PH_PER_LAYER;
        if (IN(pb + 0) && (PMASK & 4)) for (int rep = 0; rep < ((DUP >> 0) & 1) + 1; ++rep) {
            Frame F; make_frame(F, ldsb);
            pg8::GemmSched S; S.T.init(MROWS / 256, N_IN / 256, F.G, F.bid); S.A = (const char*)(F.ws + WS_H); S.B = (const char*)(F.ws + WS_WIN + l * SZ_WIN);
            S.a_tile = (size_t)256 * D * 2; S.b_tile = (size_t)256 * D * 2; S.nt = D / 64; S.pm0 = 0;
            EpiInProj E{(bf16*)(F.ws + WS_ZB), (const float*)(F.ws + WS_ROPE)};
            pg8::gemm_phase(F.lds, F.tid, D, D, S, E);
            SEAM(pb + 0);
        }
        if (IN(pb + 1) && (PMASK & 8)) for (int rep = 0; rep < ((DUP >> 1) & 1) + 1; ++rep) {
            Frame F; make_frame(F, ldsb);
            constexpr int N_KV = NCHUNK * RET_H, N_PG = (NCHUNK - 4) * 4;
            for (int it = F.bid; it < N_KV + 2 * N_PG; it += F.G) {
                if (it < N_KV) kv_item(F, l, it / RET_H, it % RET_H);
                else if (it < N_KV + N_PG) { const int r = it - N_KV + 16; pool_item(F, l, r >> 2, r & 3); }
                else { const int r = it - N_KV - N_PG + 16; sg_item(F, l, r >> 2, r & 3); }
            }
            SEAM(pb + 1);
        }
        if (IN(pb + 2) && (PMASK & 16)) for (int rep = 0; rep < ((DUP >> 2) & 1) + 1; ++rep) { Frame F; make_frame(F, ldsb);
            const bool ctx_live = l + 1 < DEPTH;
            const int nctx = ctx_live ? 2 * RET_H : 0, ndef = ctx_live ? 32 : 16;
            if (F.bid < nctx) ret_item<true>(F, l, F.bid >> 3, F.bid & 7);
            else if (F.bid < nctx + ndef) { const int j = F.bid - nctx, d = ctx_live ? j : (j < 8 ? 8 + j : 16 + j);
                if (d < 16) pool_item(F, l, d >> 2, d & 3); else sg_item(F, l, (d - 16) >> 2, d & 3); }
            scan_phase(F, l, nctx + ndef); SEAM(pb + 2); }
        if (IN(pb + 3) && (PMASK & 32)) for (int rep = 0; rep < ((DUP >> 3) & 1) + 1; ++rep) {
            Frame F; make_frame(F, ldsb);
            constexpr int N_RET = SEQ / 128 * RET_H;
            if (F.bid < N_RET) { u32x4 pf[8]; { const int itx = 2 * RET_H + F.bid; ret_tiles_load(F, itx / RET_H, itx % RET_H, pf); }
                for (int it = F.bid; it < N_RET; it += F.G) { const int itx = 2 * RET_H + it, nx = itx + F.G; ret_item_pipe(F, l, itx / RET_H, itx % RET_H, pf, nx / RET_H, nx % RET_H, it + F.G < N_RET); } }
            SEAM(pb + 3);
        }
        if (IN(pb + 4) && (PMASK & 64)) for (int rep = 0; rep < ((DUP >> 4) & 1) + 1; ++rep) {
            Frame F; make_frame(F, ldsb);
            pg8::BranchSched S; S.T.init(SEQ / 256, D / 256, F.G, F.bid); S.A = (const char*)(F.ws + WS_MIX); S.B = (const char*)(F.ws + WS_WCAT + l * SZ_WSQ);
            S.a_tile = (size_t)256 * D * 2; S.b_tile = (size_t)256 * D * 2; S.pm0 = 1;
            EpiBranch E{(const bf16*)(F.ws + WS_ZB), (bf16*)(F.ws + WS_Y)};
            pg8::gemm_phase(F.lds, F.tid, D, D, S, E);
            if (l + 1 < DEPTH) ctx_n2048<0>(F, l, (const bf16*)(F.ws + WS_MIX), (const bf16*)(F.ws + WS_WCAT + l * SZ_WSQ), 0, 1.f);
            SEAM(pb + 4);
        }
        if (IN(pb + 5) && (PMASK & 128)) for (int rep = 0; rep < ((DUP >> 5) & 1) + 1; ++rep) {
            Frame F; make_frame(F, ldsb);
            pg8::GemmSched S; S.T.init(SEQ / 256, D / 256, F.G, F.bid); S.A = (const char*)(F.ws + WS_Y); S.B = (const char*)(F.ws + WS_WOUT + l * SZ_WSQ);
            S.a_tile = (size_t)256 * D * 2; S.b_tile = (size_t)256 * D * 2; S.nt = D / 64; S.pm0 = 1;
            if (l + 1 < DEPTH || !FUSE_FINAL) {
                EpiResid E{(bf16*)(F.ws + WS_X), MODP(F) + (size_t)l * 2 * 6 * D, 2, rep ? 0.f : 1.f};
                pg8::gemm_phase(F.lds, F.tid, D, D, S, E);
                if (l + 1 < DEPTH) ctx_n2048<1>(F, l, (const bf16*)(F.ws + WS_Y), (const bf16*)(F.ws + WS_WOUT + l * SZ_WSQ), 2, rep ? 0.f : 1.f);
            } else {
                const float* ml = MODP(F) + (size_t)l * 2 * 6 * D;
                EpiResidNorm<false> E{(bf16*)(F.ws + WS_X), ml, 2, F.in[I_N2G] + (size_t)l * D, nullptr, (unsigned*)(F.ws + WS_XCH), (unsigned*)(F.ws + WS_CNT), F.lds + 131072, 64u, (bf16*)(F.ws + WS_H), ml + 6 * D + 4 * D, ml + 6 * D + 3 * D};
                pg8::gemm_phase(F.lds, F.tid, D, D, S, E);
            }
            SEAM(pb + 5);
        }
        if (IN(pb + 6) && (PMASK & 256) && (l + 1 < DEPTH || !FUSE_FINAL)) for (int rep = 0; rep < ((DUP >> 6) & 1) + 1; ++rep) { Frame F; make_frame(F, ldsb); norm_phase(F, F.in[I_N2G] + (size_t)l * D, MODP(F) + (size_t)l * 2 * 6 * D, 3, false); SEAM(pb + 6); }
        if (IN(pb + 7) && (PMASK & 512)) for (int rep = 0; rep < ((DUP >> 7) & 1) + 1; ++rep) {
            Frame F; make_frame(F, ldsb);
            pg8::GemmSched S; S.T.init(SEQ / 256, DFF / 256, F.G, F.bid); S.A = (const char*)(F.ws + WS_H); S.B = (const char*)(F.ws + WS_W1 + l * SZ_WFF);
            S.a_tile = (size_t)256 * D * 2; S.b_tile = (size_t)256 * D * 2; S.nt = D / 64; S.pm0 = 1;
            EpiRelu2 E{(bf16*)(F.ws + WS_A1)};
            pg8::gemm_phase(F.lds, F.tid, D, D, S, E);
            if (l + 1 < DEPTH) ctx_up(F, (const bf16*)(F.ws + WS_W1 + l * SZ_WFF));
            SEAM(pb + 7);
        }
        if (IN(pb + 8) && (PMASK & 1024)) for (int rep = 0; rep < ((DUP >> 8) & 1) + 1; ++rep) {
            Frame F; make_frame(F, ldsb);
            pg8::GemmSched S; S.T.init(SEQ / 256, D / 256, F.G, F.bid); S.A = (const char*)(F.ws + WS_A1); S.B = (const char*)(F.ws + WS_W2 + l * SZ_WFF);
            S.a_tile = (size_t)256 * DFF * 2; S.b_tile = (size_t)256 * DFF * 2; S.nt = DFF / 64; S.pm0 = 1;
            if (l + 1 < DEPTH) {
                EpiResid E{(bf16*)(F.ws + WS_X), MODP(F) + (size_t)l * 2 * 6 * D, 5, rep ? 0.f : 1.f};
                pg8::gemm_phase(F.lds, F.tid, DFF, DFF, S, E);
                ctx_down_splitk(F, (const bf16*)(F.ws + WS_W2 + l * SZ_WFF));
            } else {
                EpiResidNorm<true> E{(bf16*)(F.ws + WS_X), MODP(F) + (size_t)l * 2 * 6 * D, 5, F.in[I_FNG], ((KArgs)__builtin_amdgcn_kernarg_segment_ptr())->out, (unsigned*)(F.ws + WS_XCH), (unsigned*)(F.ws + WS_CNT), F.lds + 131072, 128u, nullptr, nullptr, nullptr};
                pg8::gemm_phase(F.lds, F.tid, DFF, DFF, S, E);
            }
            if (l + 1 < DEPTH || !FUSE_FINAL) SEAM(pb + 8);
        }
        if (IN(pb + 9) && (PMASK & 2048)) for (int rep = 0; rep < ((DUP >> 9) & 1) + 1; ++rep) {
            Frame F; make_frame(F, ldsb);
            if (l + 1 < DEPTH) { norm_phase(F, F.in[I_N1G] + (size_t)(l + 1) * D, MODP(F) + (size_t)(l + 1) * 2 * 6 * D, 0, false, MODP(F) + (size_t)l * 2 * 6 * D + 5 * D); SEAM(pb + 9); }
            else final_norm_phase(F, ((KArgs)__builtin_amdgcn_kernarg_segment_ptr())->out);
        }
    }
#undef IN
#undef SEAM
}

extern "C" void kernel_launch(void* const* d_in, const int* in_sizes, int n_in, void* d_out, int out_size, void* d_ws, size_t ws_size, hipStream_t stream) {
    static int grid = 0;
    if (grid == 0) {
        if (n_in != 23 || out_size != SEQ * D || ws_size < WS_END) { fprintf(stderr, "kernel_launch: unexpected problem (n_in %d, out %d, ws %zu < %zu)\n", n_in, out_size, ws_size, (size_t)WS_END); grid = -1; return; }
        int dev = 0, cus = 0, per_cu = 0;
        if (hipGetDevice(&dev) != hipSuccess || hipDeviceGetAttribute(&cus, hipDeviceAttributeMultiprocessorCount, dev) != hipSuccess) { grid = -1; return; }
        if (hipFuncSetAttribute((const void*)mk_fwd, hipFuncAttributeMaxDynamicSharedMemorySize, LDS_BYTES) != hipSuccess) { fprintf(stderr, "kernel_launch: hipFuncSetAttribute failed\n"); grid = -1; return; }
        if (hipOccupancyMaxActiveBlocksPerMultiprocessor(&per_cu, (const void*)mk_fwd, 512, LDS_BYTES) != hipSuccess || per_cu < 1) { fprintf(stderr, "kernel_launch: occupancy query reports %d blocks per CU\n", per_cu); (void)hipGetLastError(); grid = -1; return; }
        grid = cus;
    }
    if (grid < 0) return;
    if (hipMemsetAsync((char*)d_ws + WS_CTL, 0, CTL_ZERO_BYTES, stream) != hipSuccess) return;
    Args a{};
    for (int i = 0; i < 23; ++i) a.in[i] = (const float*)d_in[i];
    a.out = (float*)d_out; a.ws = (unsigned char*)d_ws;
#if MK_SPLIT
    for (int p = 0; p < N_PHASES; ++p) { a.ph_lo = p; a.ph_hi = p + 1; hipLaunchKernelGGL(mk_fwd, dim3(grid), dim3(512), LDS_BYTES, stream, a); }
#else
    a.ph_lo = 0; a.ph_hi = N_PHASES;
    hipLaunchKernelGGL(mk_fwd, dim3(grid), dim3(512), LDS_BYTES, stream, a);
#endif
}
```

```cpp
#include <hip/hip_runtime.h>
#include <cstdio>
#include <cstdint>

#ifndef PMASK
#define PMASK 0xFFFF
#endif
#ifndef DUP
#define DUP 0
#endif
#ifndef MK_SPLIT
#define MK_SPLIT 0
#endif

constexpr int D = 2048, SEQ = 8192, CTX = 256, DEPTH = 4, GRID_W = 64;
constexpr int MROWS = CTX + SEQ;
constexpr int NCHUNK = MROWS / 128;
constexpr int RET_W = 1024, RET_H = 8, HD = 128;
constexpr int POOL_W = 512, SG_W = 512, DFF = 8192;
constexpr int N_IN = 4 * RET_W + POOL_W + 2 * SG_W + 3 * D;
constexpr int C_Q = 0, C_K = 1024, C_V = 2048, C_G = 3072, C_P = 4096, C_U = 4608, C_SV = 5120, C_GATE = 5632;
constexpr float EPS = 1e-6f;
constexpr float K_SCALE = 0.08838834764831845f;
constexpr float LOG2E = 1.4426950408889634f;

#define LAS __attribute__((address_space(3)))
#define GAS __attribute__((address_space(1)))
typedef unsigned short bf16;
typedef short bf16x8 __attribute__((ext_vector_type(8)));
typedef short bf16x4 __attribute__((ext_vector_type(4)));
typedef float f32x4 __attribute__((ext_vector_type(4)));
typedef float f32x2 __attribute__((ext_vector_type(2)));
typedef unsigned u32x4 __attribute__((ext_vector_type(4)));
typedef unsigned u32x2 __attribute__((ext_vector_type(2)));

__device__ __forceinline__ unsigned f2bf(float f) { unsigned u = __builtin_bit_cast(unsigned, f); return (u + 0x7fffu + ((u >> 16) & 1u)) >> 16; }
__device__ __forceinline__ unsigned pk2(float lo, float hi) { return f2bf(lo) | (f2bf(hi) << 16); }
__device__ __forceinline__ unsigned cvt_pk_bf16(float lo, float hi) { unsigned r; asm volatile("v_cvt_pk_bf16_f32 %0, %1, %2" : "=v"(r) : "v"(lo), "v"(hi)); return r; }
__device__ __forceinline__ float bflo(unsigned w) { return __uint_as_float(w << 16); }
__device__ __forceinline__ float bfhi(unsigned w) { return __uint_as_float(w & 0xffff0000u); }
__device__ __forceinline__ float silu_f(float x) { return x * __builtin_amdgcn_rcpf(1.f + __expf(-x)); }
__device__ __forceinline__ float gelu_tanh_f(float x) { const float u = 1.5957691216057308f * (x + 0.044715f * x * x * x); return x * __builtin_amdgcn_rcpf(1.f + __expf(-u)); }
__device__ __forceinline__ float log_sigmoid_f(float x) { return x >= 0.f ? -log1pf(expf(-x)) : x - log1pf(expf(x)); }
__device__ __forceinline__ float wave_sum(float v) {
#pragma unroll
    for (int o = 1; o < 64; o <<= 1) v += __shfl_xor(v, o);
    return v;
}
#define LDS_WAIT() asm volatile("s_waitcnt lgkmcnt(0)" ::: "memory")
#define VM_WAIT() asm volatile("s_waitcnt vmcnt(0)" ::: "memory")

namespace pg8 {
constexpr int BM = 256, BK = 64, HALF = 128, HTB = HALF * BK * 2  , STAGE_BYTES = 8 * HTB, NXCD = 8, WGM = 8;
__host__ __device__ __forceinline__ int lds_byte(int r, int c) { const int st = (r >> 4) * 2 + (c >> 5), rr = r & 15, cc = c & 31, ob = rr * 64 + cc * 2; return st * 1024 + (ob ^ (((ob >> 9) & 1) << 5)); }
__host__ __device__ __forceinline__ void stage_rc(int b, int& R, int& C) { const int st = b / 1024, sb = b % 1024, swz = sb ^ (((sb >> 9) & 1) << 5); R = (st >> 1) * 16 + swz / 64; C = (st & 1) * 32 + (swz % 64) / 2; }
__host__ __device__ __forceinline__ int perm32(int rho) { const int n = rho >> 4, i = rho & 15; return 8 * (i >> 2) + 4 * n + (i & 3); }

struct Unit { const char* A; const char* B; int nt, pm, pn, kind; };

struct TileOrder {
    int nM, nN, nwg, G, c;
    __device__ void init(int nM_, int nN_, int G_, int c_) { nM = nM_; nN = nN_; nwg = nM * nN; G = G_; c = c_; }
    __device__ bool tile(int i, int& pm, int& pn) const {
        const long L = (long)i * G + c; if (L >= nwg) return false;
        int wgid = (int)L; { const int q = nwg / NXCD, r = nwg % NXCD, xcd = wgid % NXCD, off = wgid / NXCD; wgid = (xcd < r ? xcd * (q + 1) : r * (q + 1) + (xcd - r) * q) + off; }
        const int nig = WGM * nN, gid = wgid / nig, fm = gid * WGM, gsz = (nM - fm) < WGM ? (nM - fm) : WGM;
        pm = fm + ((wgid % nig) % gsz); pn = (wgid % nig) / gsz; return true;
    }
};
struct GemmSched {
    TileOrder T; const char* A; const char* B; size_t a_tile, b_tile; int nt, pm0;
    __device__ __forceinline__ bool next(int i, Unit& u) const { int pm, pn; if (!T.tile(i, pm, pn)) return false; pm += pm0; u.A = A + (size_t)pm * a_tile; u.B = B + (size_t)pn * b_tile; u.nt = nt; u.pm = pm; u.pn = pn; u.kind = 0; return true; }
};
struct BranchSched {
    TileOrder T; const char* A; const char* B; size_t a_tile, b_tile; int pm0;
    __device__ __forceinline__ bool next(int i, Unit& u) const { int pm, pn; const int ti = i / 3, seg = i - 3 * ti; if (!T.tile(ti, pm, pn)) return false; pm += pm0;
        const int koff = seg == 0 ? 0 : (seg == 1 ? 1024 : 1536);
        u.A = A + (size_t)pm * a_tile + koff * 2; u.B = B + (size_t)pn * b_tile + koff * 2; u.nt = seg == 0 ? 16 : 8; u.pm = pm; u.pn = pn; u.kind = seg; return true; }
};

template <class Epi, class Sched>
__device__ __forceinline__ void gemm_phase(LAS unsigned char* lds, const int tid, const int lda, const int ldb, const Sched& S, const Epi& E) {
    const int wid = __builtin_amdgcn_readfirstlane(tid >> 6), lane = tid & 63, wr = wid >> 2, wc = wid & 3, fr = lane & 15, fq = lane >> 4;
    unsigned voffA[2], voffB[2];
#pragma unroll
    for (int i = 0; i < 2; ++i) { int R, C; stage_rc(tid * 16 + i * 8192, R, C); const int Rb = Epi::PERM ? (64 * (R >> 5) + perm32(R & 31)) : R;
        voffA[i] = (unsigned)(R * lda + C) * 2u; voffB[i] = (unsigned)(Rb * ldb + C) * 2u; }
    const size_t kstep = (size_t)(BK * 2);
    const size_t hstepA = (size_t)HALF * lda * 2, hstepB = (size_t)(Epi::PERM ? 32 : HALF) * ldb * 2;
    const unsigned ldsw = (unsigned)wid * 1024u;
    const int aoff = lds_byte(wr * 64 + fr, fq * 8), boff = lds_byte(wc * 32 + fr, fq * 8);
#define PG8_SA(b, h) (((b) * 2 + (h)) * HTB)
#define PG8_SB(b, h) ((4 + (b) * 2 + (h)) * HTB)
#define PG8_STAGE(bufoff, gbase, voff) do { _Pragma("unroll") for (int _i = 0; _i < 2; ++_i) \
        __builtin_amdgcn_global_load_lds((const unsigned*)((const char*)(gbase) + (voff)[_i]), (LAS unsigned*)(lds + (bufoff) + ldsw + _i * 8192), 16, 0, 0); } while (0)
#define PG8_LDA(dst, b, h) do { _Pragma("unroll") for (int m = 0; m < 4; ++m) _Pragma("unroll") for (int k = 0; k < 2; ++k) dst[m][k] = *(const LAS bf16x8*)(lds + PG8_SA(b, h) + aoff + m * 2048 + k * 1024); } while (0)
#define PG8_LDB(dst, b, h) do { _Pragma("unroll") for (int n = 0; n < 2; ++n) _Pragma("unroll") for (int k = 0; k < 2; ++k) dst[n][k] = *(const LAS bf16x8*)(lds + PG8_SB(b, h) + boff + n * 2048 + k * 1024); } while (0)
#define PG8_MMA(ai, bj, At, Bt) do { __builtin_amdgcn_s_setprio(1); _Pragma("unroll") for (int m = 0; m < 4; ++m) _Pragma("unroll") for (int n = 0; n < 2; ++n) _Pragma("unroll") for (int k = 0; k < 2; ++k) \
        acc[ai][bj][m][n] = __builtin_amdgcn_mfma_f32_16x16x32_bf16(Bt[n][k], At[m][k], acc[ai][bj][m][n], 0, 0, 0); __builtin_amdgcn_s_setprio(0); } while (0)
#define PG8_WAIT_V(n) asm volatile("s_waitcnt vmcnt(" #n ")" ::: "memory")
#define PG8_WAIT_L(n) asm volatile("s_waitcnt lgkmcnt(" #n ")" ::: "memory")
#define PG8_BAR __builtin_amdgcn_s_barrier()
#define PG8_SCHED __builtin_amdgcn_sched_barrier(0)
    Unit cur, nxt; int ui = 0;
    if (!S.next(0, cur)) return;
    f32x4 acc[2][2][4][2];
#pragma unroll
    for (int a = 0; a < 2; ++a)
#pragma unroll
        for (int b = 0; b < 2; ++b)
#pragma unroll
            for (int m = 0; m < 4; ++m)
#pragma unroll
                for (int n = 0; n < 2; ++n) acc[a][b][m][n] = (f32x4){0.f, 0.f, 0.f, 0.f};
    bf16x8 At[4][2], B0[2][2], B1[2][2];
    const char* cA = cur.A; const char* cB = cur.B;
    PG8_STAGE(PG8_SB(0, 0), cB, voffB); PG8_STAGE(PG8_SB(0, 1), cB + hstepB, voffB); PG8_STAGE(PG8_SA(0, 0), cA, voffA); PG8_STAGE(PG8_SA(0, 1), cA + hstepA, voffA);
    if (wr == 1) PG8_BAR;
    PG8_WAIT_V(2); PG8_BAR;
    PG8_STAGE(PG8_SB(1, 0), cB + kstep, voffB); PG8_STAGE(PG8_SA(1, 0), cA + kstep, voffA); PG8_STAGE(PG8_SB(1, 1), cB + hstepB + kstep, voffB);
    PG8_WAIT_V(6); PG8_BAR;
    for (;;) {
        const bool has_next = S.next(ui + 1, nxt);
        const char* nA = has_next ? nxt.A : cA; const char* nB = has_next ? nxt.B : cB;
        const int nt = cur.nt;
        for (int t = 0; t < nt; t += 2) {
            const bool last = (t == nt - 2);
            const char* a1 = cA + (size_t)(t + 1) * kstep;
            const char* a2 = last ? nA : cA + (size_t)(t + 2) * kstep; const char* b2 = last ? nB : cB + (size_t)(t + 2) * kstep;
            const char* a3 = a2 + kstep; const char* b3 = b2 + kstep;
            PG8_LDB(B0, 0, 0); PG8_LDB(B1, 0, 1); PG8_SCHED; PG8_LDA(At, 0, 0); PG8_STAGE(PG8_SA(1, 1), a1 + hstepA, voffA);
            PG8_WAIT_V(8); PG8_WAIT_L(0); PG8_BAR; PG8_MMA(0, 0, At, B0); PG8_MMA(0, 1, At, B1); PG8_BAR; PG8_SCHED;
            PG8_LDA(At, 0, 1); PG8_STAGE(PG8_SB(0, 0), b2, voffB); PG8_STAGE(PG8_SB(0, 1), b2 + hstepB, voffB); PG8_STAGE(PG8_SA(0, 0), a2, voffA);
            PG8_WAIT_V(8); PG8_WAIT_L(0); PG8_BAR; PG8_MMA(1, 0, At, B0); PG8_MMA(1, 1, At, B1); PG8_BAR; PG8_SCHED;
            PG8_LDB(B0, 1, 0); PG8_LDB(B1, 1, 1); PG8_SCHED; PG8_LDA(At, 1, 0); PG8_STAGE(PG8_SA(0, 1), a2 + hstepA, voffA);
            PG8_WAIT_V(8); PG8_WAIT_L(0); PG8_BAR; PG8_MMA(0, 0, At, B0); PG8_MMA(0, 1, At, B1); PG8_BAR; PG8_SCHED;
            PG8_LDA(At, 1, 1); PG8_STAGE(PG8_SB(1, 0), b3, voffB); PG8_STAGE(PG8_SB(1, 1), b3 + hstepB, voffB); PG8_STAGE(PG8_SA(1, 0), a3, voffA);
            PG8_WAIT_V(8); PG8_WAIT_L(0); PG8_BAR; PG8_MMA(1, 0, At, B0); PG8_MMA(1, 1, At, B1); PG8_BAR; PG8_SCHED;
        }
        if (wr == 0) PG8_BAR;
        E(acc, cur, wr, wc, fr, fq);
#if defined(EPI2)
        if (Epi::PROBE2) E(acc, cur, wr, wc, fr, fq);
#endif
        if (!has_next) break;
        if (!(Epi::KEEP && E.keep(cur))) {
#pragma unroll
            for (int a = 0; a < 2; ++a)
#pragma unroll
                for (int b = 0; b < 2; ++b)
#pragma unroll
                    for (int m = 0; m < 4; ++m)
#pragma unroll
                        for (int n = 0; n < 2; ++n) acc[a][b][m][n] = (f32x4){0.f, 0.f, 0.f, 0.f};
        }
        cur = nxt; cA = nA; cB = nB; ++ui;
        if (wr == 1) PG8_BAR;
    }
    PG8_WAIT_V(0);
    PG8_BAR;
#undef PG8_SA
#undef PG8_SB
#undef PG8_STAGE
#undef PG8_LDA
#undef PG8_LDB
#undef PG8_MMA
#undef PG8_WAIT_V
#undef PG8_WAIT_L
#undef PG8_BAR
#undef PG8_SCHED
}
}

constexpr size_t KiB = 1024, MiB = 1u << 20;
constexpr size_t WS_CTL = 0, CTL_ZERO_BYTES = 128 * KiB;
constexpr size_t WS_BAR = 64 * KiB;
constexpr size_t WS_MOD = 256 * KiB;
constexpr size_t WS_ROPE = 1 * MiB;
constexpr size_t WS_PWT = WS_ROPE + 64 * KiB;
constexpr size_t WS_SGW = WS_PWT + 512 * KiB;
constexpr size_t WS_WIN = 4 * MiB;
constexpr size_t SZ_WIN = (size_t)N_IN * D * 2;
constexpr size_t WS_WCAT = WS_WIN + DEPTH * SZ_WIN;
constexpr size_t SZ_WSQ = (size_t)D * D * 2;
constexpr size_t WS_WOUT = WS_WCAT + DEPTH * SZ_WSQ;
constexpr size_t WS_W1 = WS_WOUT + DEPTH * SZ_WSQ;
constexpr size_t SZ_WFF = (size_t)DFF * D * 2;
constexpr size_t WS_W2 = WS_W1 + DEPTH * SZ_WFF;
constexpr size_t WS_X = WS_W2 + DEPTH * SZ_WFF;
constexpr size_t WS_H = WS_X + (size_t)MROWS * D * 4;
constexpr size_t WS_ZB = WS_H + (size_t)MROWS * D * 2;
constexpr size_t WS_KVT = WS_ZB + (size_t)MROWS * N_IN * 2;
constexpr size_t WS_ST = WS_KVT + (size_t)NCHUNK * 16 * 16384 * 4;
constexpr size_t WS_MIX = WS_ST + (size_t)NCHUNK * 16 * 16384 * 2;
constexpr size_t WS_Y = WS_MIX + (size_t)MROWS * D * 2;
constexpr size_t WS_A1 = WS_Y + (size_t)MROWS * D * 2;
constexpr size_t WS_MODP = WS_A1 + (size_t)MROWS * DFF * 2;
constexpr size_t WS_SLAB = WS_MODP + (size_t)16 * DEPTH * 2 * 6 * D * 4;
constexpr size_t WS_XCH = WS_SLAB + (size_t)4 * CTX * D * 4;
constexpr size_t WS_END = WS_XCH + (size_t)MROWS * 8 * 4;
constexpr size_t WS_CNT = 0;

constexpr int SCR_BYTES = 147456;
constexpr int MISC_OFF = SCR_BYTES;
constexpr int LDS_BYTES = SCR_BYTES + 256;
constexpr int TP = 272;
constexpr int TILE_B = 128 * TP;

#define XB_TMO      128
#define XB_XCNT(j)  (256  + 64 * (j))
#define XB_XSUB(j)  (1280 + 64 * (j))
#define XB_XGEN(j)  (2304 + 64 * (j))
#define XB_TOP      3328
#define XB_TOPGEN   3392
#define XCD_BAR_WORDS 3456
#define XB_SPIN_CAP (1u << 18)
__device__ __forceinline__ unsigned xb_ld(unsigned* p)              { return __hip_atomic_load(p, __ATOMIC_RELAXED, __HIP_MEMORY_SCOPE_AGENT); }
__device__ __forceinline__ unsigned xb_add(unsigned* p, unsigned v) { return __hip_atomic_fetch_add(p, v, __ATOMIC_RELAXED, __HIP_MEMORY_SCOPE_AGENT); }
__device__ __forceinline__ unsigned xb_xcc_id() { return (unsigned)__builtin_amdgcn_s_getreg((3 << 11) | 20) & 0xFu; }
#define XB_SPIN(cond, bar) do { unsigned _sp = 0; while (cond) { __builtin_amdgcn_s_sleep(1); \
    if ((++_sp & 255u) == 0u) { if (xb_ld(&(bar)[XB_TMO])) break; if (_sp > XB_SPIN_CAP) { atomicAdd(&(bar)[XB_TMO], 1u); break; } } } } while (0)
struct XcdBarrier { unsigned* bar; unsigned x; volatile LAS unsigned* st; };
__device__ __forceinline__ XcdBarrier xcd_barrier_post(unsigned* bar, volatile LAS unsigned* st) {
    XcdBarrier b; b.bar = bar; b.x = xb_xcc_id(); b.st = st;
    if (threadIdx.x == 0) (void)xb_add(&bar[XB_XCNT(b.x)], 1u);
    return b;
}
__device__ __forceinline__ void xcd_barrier_complete(unsigned* bar, unsigned x, unsigned& nloc, unsigned& nx) {
    const unsigned G = gridDim.x * gridDim.y * gridDim.z;
    unsigned sum, cnt, mine, sp = 0u;
    for (;;) {
        sum = 0u; cnt = 0u; mine = 0u;
#pragma unroll
        for (unsigned j = 0; j < 16; ++j) { const unsigned c = xb_ld(&bar[XB_XCNT(j)]); sum += c; cnt += (c > 0u) ? 1u : 0u; mine = (j == x) ? c : mine; }
        if (sum == G) break;
        __builtin_amdgcn_s_sleep(1);
        if ((++sp & 255u) == 0u) { if (xb_ld(&bar[XB_TMO])) break; if (sp > XB_SPIN_CAP) { atomicAdd(&bar[XB_TMO], 1u); break; } }
    }
    nloc = mine > 0u ? mine : 1u; nx = cnt > 0u ? cnt : 1u;
}
__device__ __forceinline__ void xcd_barrier(const XcdBarrier& b) {
    asm volatile("s_waitcnt vmcnt(0)" ::: "memory");
    __syncthreads();
    if (threadIdx.x == 0) {
        unsigned* bar = b.bar;
        __builtin_amdgcn_s_waitcnt(0);
        unsigned nloc = b.st[0], nx = b.st[1];
        if (nloc == 0u) { xcd_barrier_complete(bar, b.x, nloc, nx); b.st[0] = nloc; b.st[1] = nx; }
        const unsigned old = xb_add(&bar[XB_XSUB(b.x)], 1u);
        const unsigned gen = old / nloc;
        if (old + 1u == (gen + 1u) * nloc) {
            __builtin_amdgcn_fence(__ATOMIC_RELEASE, "agent");
            asm volatile("s_waitcnt vmcnt(0)" ::: "memory");
            const unsigned og = xb_add(&bar[XB_TOP], 1u);
            const unsigned tg = og / nx;
            if (og + 1u == (tg + 1u) * nx) xb_add(&bar[XB_TOPGEN], 1u);
            else XB_SPIN(xb_ld(&bar[XB_TOPGEN]) == tg, bar);
            __builtin_amdgcn_fence(__ATOMIC_ACQUIRE, "agent");
            xb_add(&bar[XB_XGEN(b.x)], 1u);
            asm volatile("s_waitcnt vmcnt(0)" ::: "memory");
        } else {
            XB_SPIN(xb_ld(&bar[XB_XGEN(b.x)]) == gen, bar);
            __builtin_amdgcn_fence(__ATOMIC_ACQUIRE, "agent");
            asm volatile("s_waitcnt vmcnt(0)" ::: "memory");
        }
    }
    __syncthreads();
}

struct Args { const float* in[23]; float* out; unsigned char* ws; int ph_lo, ph_hi; };
typedef const __attribute__((address_space(4))) Args* KArgs;
struct Frame {
    LAS unsigned char* lds;
    int tid, lane, wave, G, bid;
    unsigned char* ws;
    const float* const __attribute__((address_space(4)))* in;
};
__device__ __forceinline__ void make_frame(Frame& F, LAS unsigned char* lds) {
    int t = threadIdx.x; asm volatile("" : "+v"(t));
    KArgs ka = (KArgs)__builtin_amdgcn_kernarg_segment_ptr(); asm volatile("" : "+s"(ka));
    F.lds = lds; F.tid = t; F.lane = t & 63; F.wave = __builtin_amdgcn_readfirstlane(t >> 6); { int g_ = gridDim.x, b_ = blockIdx.x; asm volatile("" : "+s"(g_), "+s"(b_)); F.G = g_; F.bid = b_; }
    F.ws = ka->ws; F.in = ka->in;
}
enum { I_X = 0, I_C, I_CTX, I_CCTX, I_WADA, I_BADA, I_N1G, I_WIN, I_RLOG, I_RNG, I_PW, I_PS, I_SGNG, I_SGW, I_SGB, I_WBR, I_WBP, I_WBS, I_WOUT, I_N2G, I_W1, I_W2, I_FNG };

using pg8::Unit; using pg8::BM; using pg8::HALF;
#if defined(EPI2)
#define P2(x) static constexpr bool PROBE2 = (EPI2 == x);
#else
#define P2(x)
#endif
struct EpiInProj {           P2(1)
    static constexpr bool PERM = true, KEEP = false;
    bf16* ZB; const float* rope;
    __device__ __forceinline__ bool keep(const Unit&) const { return false; }
    __device__ __forceinline__ void operator()(f32x4 (&acc)[2][2][4][2], const Unit& u, int wr, int wc, int fr, int fq) const {
        const int pn = u.pn, row0 = u.pm * BM + wr * 64 + fr;
        if (pn < 8) {
            const int half = wc & 1; const float ks = pn >= 4 ? K_SCALE : 1.f; const bool latent = u.pm > 0;
            f32x4 csn[4];
            auto ldcs = [&](int step, f32x4 (&c4)[4]) { const int row = row0 + (step >> 2) * HALF + (step & 3) * 16;
#pragma unroll
                for (int q = 0; q < 4; ++q) c4[q] = (f32x4){1.f, 0.f, 1.f, 0.f};
                if (latent) { const int tok = row - CTX; const int pos = half ? (tok & (GRID_W - 1)) : (tok / GRID_W); const float* rp = rope + (size_t)(pos * 32 + 8 * fq) * 2;
#pragma unroll
                    for (int q = 0; q < 4; ++q) c4[q] = *(const f32x4*)(rp + 4 * q); } };
            ldcs(0, csn);
#pragma unroll
            for (int ai = 0; ai < 2; ++ai)
#pragma unroll
                for (int m = 0; m < 4; ++m) {
                    const int row = row0 + ai * HALF + m * 16;
                    f32x4 cs[4];
#pragma unroll
                    for (int q = 0; q < 4; ++q) cs[q] = csn[q];
                    if (ai * 4 + m < 7) ldcs(ai * 4 + m + 1, csn);
                    float o1[8], o2[8];
#pragma unroll
                    for (int n = 0; n < 2; ++n) { const f32x4 t1 = acc[ai][0][m][n] * ks, t2 = acc[ai][1][m][n] * ks;
#pragma unroll
                        for (int j = 0; j < 4; ++j) { const int e = 4 * n + j; const float c = cs[e >> 1][2 * (e & 1)], sn = cs[e >> 1][2 * (e & 1) + 1];
                            o1[e] = t1[j] * c - t2[j] * sn; o2[e] = t1[j] * sn + t2[j] * c; } }
                    bf16* dst = ZB + (size_t)row * N_IN + pn * BM + 64 * wc + 8 * fq;
                    u32x4 w1, w2; w1.x = cvt_pk_bf16(o1[0], o1[1]); w1.y = cvt_pk_bf16(o1[2], o1[3]); w1.z = cvt_pk_bf16(o1[4], o1[5]); w1.w = cvt_pk_bf16(o1[6], o1[7]);
                    w2.x = cvt_pk_bf16(o2[0], o2[1]); w2.y = cvt_pk_bf16(o2[2], o2[3]); w2.z = cvt_pk_bf16(o2[4], o2[5]); w2.w = cvt_pk_bf16(o2[6], o2[7]);
                    *(u32x4*)dst = w1; *(u32x4*)(dst + 32) = w2;
                }
            return;
        }
        bf16* tile = ZB + (size_t)row0 * N_IN + pn * BM + wc * 64 + 8 * fq;
        if (pn >= 22) store_gate_tile(acc, (unsigned char*)ZB + (size_t)row0 * (N_IN * 2) + 2 * C_GATE + (pn * BM - C_GATE) + wc * 64 + 8 * fq);
        else if (pn < 12 || (pn >= 16 && pn < 18)) store_tile<0>(acc, tile);
        else if (pn < 16) store_tile<1>(acc, tile);
        else store_tile<2>(acc, tile);
    }
    __device__ __forceinline__ void store_gate_tile(f32x4 (&acc)[2][2][4][2], unsigned char* tile) const {
#pragma unroll
        for (int ai = 0; ai < 2; ++ai)
#pragma unroll
            for (int m = 0; m < 4; ++m) {
                unsigned char* rowp = tile + (size_t)(ai * HALF + m * 16) * (N_IN * 2);
#pragma unroll
                for (int bj = 0; bj < 2; ++bj) {
                    unsigned q[8];
#pragma unroll
                    for (int j = 0; j < 8; ++j) { const float z = j < 4 ? acc[ai][bj][m][0][j] : acc[ai][bj][m][1][j - 4];
                        const float g = __builtin_amdgcn_rcpf(1.f + __builtin_amdgcn_exp2f(z * -LOG2E));
                        q[j] = (unsigned)__builtin_amdgcn_fmed3f(g * 255.f + 0.5f, 1.f, 255.f); }
                    u32x2 w; w.x = q[0] | (q[1] << 8) | (q[2] << 16) | (q[3] << 24); w.y = q[4] | (q[5] << 8) | (q[6] << 16) | (q[7] << 24);
                    *(u32x2*)(rowp + bj * 32) = w;
                }
            }
    }
    template <int MODE>
    __device__ __forceinline__ void store_tile(f32x4 (&acc)[2][2][4][2], bf16* tile) const {
#pragma unroll
        for (int ai = 0; ai < 2; ++ai)
#pragma unroll
            for (int m = 0; m < 4; ++m) {
                bf16* rowp = tile + (size_t)(ai * HALF + m * 16) * N_IN;
#pragma unroll
                for (int bj = 0; bj < 2; ++bj) {
                    float v[8];
#pragma unroll
                    for (int j = 0; j < 4; ++j) { v[j] = acc[ai][bj][m][0][j]; v[4 + j] = acc[ai][bj][m][1][j]; }
#pragma unroll
                    for (int j = 0; j < 8; ++j) {
                        if (MODE == 1) v[j] = silu_f(v[j]);
                        else if (MODE == 2) v[j] = gelu_tanh_f(v[j]);
                        else if (MODE == 3) v[j] = 1.f + __expf(-fminf(fmaxf(v[j], -30.f), 30.f));
                    }
                    u32x4 w; w.x = cvt_pk_bf16(v[0], v[1]); w.y = cvt_pk_bf16(v[2], v[3]); w.z = cvt_pk_bf16(v[4], v[5]); w.w = cvt_pk_bf16(v[6], v[7]);
                    *(u32x4*)(rowp + bj * 32) = w;
                }
            }
    }
};
struct EpiBranch { static constexpr bool PRETOUCH = false;          P2(0)
    static constexpr bool PERM = true, KEEP = true;
    const bf16* ZB; bf16* Y;
    __device__ __forceinline__ bool keep(const Unit& u) const { return u.kind < 2; }
    __device__ __forceinline__ void operator()(f32x4 (&acc)[2][2][4][2], const Unit& u, int wr, int wc, int fr, int fq) const {
        const int kind = u.kind, rowu = u.pm * BM + wr * 64, colu = u.pn * BM + wc * 64;
        const unsigned char* gb = (const unsigned char*)ZB + (size_t)rowu * (N_IN * 2) + 2 * C_GATE + colu + kind * D;
        const int dstep = kind < 2 ? D : 0;
        const unsigned glo = (unsigned)(fr * (N_IN * 2) + 8 * fq);
        const bool fin = kind == 2;
#pragma unroll
        for (int ai = 0; ai < 2; ++ai) {
            u32x2 nm[4][2], dn[4][2];
#pragma unroll
            for (int m = 0; m < 4; ++m)
#pragma unroll
                for (int bj = 0; bj < 2; ++bj) { const unsigned char* p = gb + (size_t)(ai * HALF + m * 16) * (N_IN * 2) + bj * 32;
                    nm[m][bj] = *(const u32x2*)(p + glo); dn[m][bj] = *(const u32x2*)(p + dstep + glo); }
#pragma unroll
            for (int m = 0; m < 4; ++m)
#pragma unroll
                for (int bj = 0; bj < 2; ++bj) {
                    float sc[8];
#pragma unroll
                    for (int q = 0; q < 8; ++q) { const float n = (float)((nm[m][bj][q >> 2] >> (8 * (q & 3))) & 255u), r = __builtin_amdgcn_rcpf((float)((dn[m][bj][q >> 2] >> (8 * (q & 3))) & 255u));
                        sc[q] = n * (fin ? (1.f / 255.f) : r); }
#pragma unroll
                    for (int j = 0; j < 4; ++j) { acc[ai][bj][m][0][j] *= sc[j]; acc[ai][bj][m][1][j] *= sc[4 + j]; }
                }
        }
        if (fin) {
            bf16* yb = Y + (size_t)rowu * D + colu; const unsigned ylo = (unsigned)(fr * (D * 2) + 16 * fq);
#pragma unroll
            for (int ai = 0; ai < 2; ++ai)
#pragma unroll
                for (int m = 0; m < 4; ++m)
#pragma unroll
                    for (int bj = 0; bj < 2; ++bj) { const f32x4 a = acc[ai][bj][m][0], b = acc[ai][bj][m][1]; u32x4 w; w.x = cvt_pk_bf16(a[0], a[1]); w.y = cvt_pk_bf16(a[2], a[3]); w.z = cvt_pk_bf16(b[0], b[1]); w.w = cvt_pk_bf16(b[2], b[3]);
                        *(u32x4*)((unsigned char*)(yb + (size_t)(ai * HALF + m * 16) * D + bj * 32) + ylo) = w; }
        }
    }
};
struct EpiResid {            P2(0)
    static constexpr bool PERM = true, KEEP = false;
    bf16* X; const float* modl; int gi; float dry;
    __device__ __forceinline__ bool keep(const Unit&) const { return false; }
    __device__ __forceinline__ void operator()(f32x4 (&acc)[2][2][4][2], const Unit& u, int wr, int wc, int fr, int fq) const {
        const int row0 = u.pm * BM + wr * 64 + fr, col0 = u.pn * BM + wc * 64 + 8 * fq;
        const float* gate = modl + (size_t)(u.pm > 0 ? 1 : 0) * 6 * D + gi * D + col0;
        f32x4 gv[2][2];
#pragma unroll
        for (int bj = 0; bj < 2; ++bj)
#pragma unroll
            for (int n = 0; n < 2; ++n) gv[bj][n] = *(const f32x4*)(gate + bj * 32 + n * 4) * dry;
#pragma unroll
        for (int ai = 0; ai < 2; ++ai) {
            u32x4 xa[4][2];
#pragma unroll
            for (int m = 0; m < 4; ++m)
#pragma unroll
                for (int bj = 0; bj < 2; ++bj) xa[m][bj] = *(const u32x4*)(X + (size_t)(row0 + ai * HALF + m * 16) * D + col0 + bj * 32);
#pragma unroll
            for (int m = 0; m < 4; ++m) { bf16* rowp = X + (size_t)(row0 + ai * HALF + m * 16) * D + col0;
#pragma unroll
                for (int bj = 0; bj < 2; ++bj) { const f32x4 a = acc[ai][bj][m][0] * gv[bj][0], b = acc[ai][bj][m][1] * gv[bj][1]; const u32x4 x = xa[m][bj]; u32x4 w;
                    w.x = cvt_pk_bf16(bflo(x.x) + a[0], bfhi(x.x) + a[1]); w.y = cvt_pk_bf16(bflo(x.y) + a[2], bfhi(x.y) + a[3]);
                    w.z = cvt_pk_bf16(bflo(x.z) + b[0], bfhi(x.z) + b[1]); w.w = cvt_pk_bf16(bflo(x.w) + b[2], bfhi(x.w) + b[3]);
                    *(u32x4*)(rowp + bj * 32) = w; }
            }
        }
    }
};
template <bool FINAL>
struct EpiResidNorm {
    static constexpr bool PERM = true, KEEP = false;
    bf16* X; const float* modl; int gi; const float* ng; float* out; unsigned* xch; unsigned* cnt; LAS unsigned char* tab; unsigned want; bf16* H; const float* sc; const float* sh;
    __device__ __forceinline__ bool keep(const Unit&) const { return false; }
    __device__ __forceinline__ void operator()(f32x4 (&acc)[2][2][4][2], const Unit& u, int wr, int wc, int fr, int fq) const {
        const int lane = fq * 16 + fr, wid = wr * 4 + wc;
        const int row0 = u.pm * BM + wr * 64 + fr, col0 = u.pn * BM + wc * 64 + 8 * fq;
        LAS float* P = (LAS float*)tab; LAS float* S = (LAS float*)(tab + 4096);
        {
            const float* gate = modl + (size_t)6 * D + gi * D + col0;
            f32x4 gv[2][2];
#pragma unroll
            for (int bj = 0; bj < 2; ++bj)
#pragma unroll
                for (int n = 0; n < 2; ++n) gv[bj][n] = *(const f32x4*)(gate + bj * 32 + n * 4);
#pragma unroll
            for (int ai = 0; ai < 2; ++ai) {
                u32x4 xa[4][2];
#pragma unroll
                for (int m = 0; m < 4; ++m)
#pragma unroll
                    for (int bj = 0; bj < 2; ++bj) xa[m][bj] = *(const u32x4*)(X + (size_t)(row0 + ai * HALF + m * 16) * D + col0 + bj * 32);
#pragma unroll
                for (int m = 0; m < 4; ++m) { float ss = 0.f;
#pragma unroll
                    for (int bj = 0; bj < 2; ++bj) { const f32x4 a = acc[ai][bj][m][0] * gv[bj][0], b = acc[ai][bj][m][1] * gv[bj][1]; const u32x4 x = xa[m][bj]; u32x4 w;
                        w.x = cvt_pk_bf16(bflo(x.x) + a[0], bfhi(x.x) + a[1]); w.y = cvt_pk_bf16(bflo(x.y) + a[2], bfhi(x.y) + a[3]);
                        w.z = cvt_pk_bf16(bflo(x.z) + b[0], bfhi(x.z) + b[1]); w.w = cvt_pk_bf16(bflo(x.w) + b[2], bfhi(x.w) + b[3]);
                        if (!FINAL) *(u32x4*)(X + (size_t)(row0 + ai * HALF + m * 16) * D + col0 + bj * 32) = w;
                        const f32x4 v0 = (f32x4){bflo(w.x), bfhi(w.x), bflo(w.y), bfhi(w.y)}, v1 = (f32x4){bflo(w.z), bfhi(w.z), bflo(w.w), bfhi(w.w)};
                        acc[ai][bj][m][0] = v0; acc[ai][bj][m][1] = v1;
                        ss += ((v0[0] * v0[0] + v0[1] * v0[1]) + (v0[2] * v0[2] + v0[3] * v0[3])) + ((v1[0] * v1[0] + v1[1] * v1[1]) + (v1[2] * v1[2] + v1[3] * v1[3])); }
                    ss += __shfl_xor(ss, 16); ss += __shfl_xor(ss, 32);
                    if (fq == 0) P[(ai * HALF + wr * 64 + m * 16 + fr) * 4 + wc] = ss; }
            }
        }
        asm volatile("s_waitcnt lgkmcnt(0)" ::: "memory"); __builtin_amdgcn_s_barrier(); asm volatile("" ::: "memory");
        const int prow = wid * 32 + (lane & 31);
        if (lane < 32) { const float t = (P[prow * 4 + 0] + P[prow * 4 + 1]) + (P[prow * 4 + 2] + P[prow * 4 + 3]);
            __hip_atomic_store(xch + (size_t)(u.pm * BM + prow) * 8 + u.pn, __float_as_uint(t), __ATOMIC_RELAXED, __HIP_MEMORY_SCOPE_AGENT); }
        asm volatile("s_waitcnt vmcnt(0)" ::: "memory");
        if (lane == 0) __hip_atomic_fetch_add(cnt + 64 * u.pm, 1u, __ATOMIC_RELAXED, __HIP_MEMORY_SCOPE_AGENT);
        if (wid == 0) { unsigned sp = 0;
            while ((unsigned)__builtin_amdgcn_readfirstlane(__hip_atomic_load(cnt + 64 * u.pm, __ATOMIC_RELAXED, __HIP_MEMORY_SCOPE_AGENT)) < want && ++sp < (1u << 20)) __builtin_amdgcn_s_sleep(2);
            __builtin_amdgcn_fence(__ATOMIC_ACQUIRE, "agent"); }
        asm volatile("s_waitcnt vmcnt(0) lgkmcnt(0)" ::: "memory"); __builtin_amdgcn_s_barrier(); asm volatile("" ::: "memory");
        if (lane < 32) { const unsigned* sl = xch + (size_t)(u.pm * BM + prow) * 8; float tot = 0.f;
#pragma unroll
            for (int t = 0; t < 8; ++t) tot += __uint_as_float(__hip_atomic_load(sl + t, __ATOMIC_RELAXED, __HIP_MEMORY_SCOPE_AGENT));
            S[prow] = rsqrtf(tot * (1.f / D) + EPS); }
        asm volatile("s_waitcnt vmcnt(0) lgkmcnt(0)" ::: "memory"); __builtin_amdgcn_s_barrier(); asm volatile("" ::: "memory");
        f32x4 gg[2][2], hh[2][2];
#pragma unroll
        for (int bj = 0; bj < 2; ++bj)
#pragma unroll
            for (int n = 0; n < 2; ++n) { gg[bj][n] = *(const f32x4*)(ng + col0 + bj * 32 + n * 4);
                if (!FINAL) { gg[bj][n] = gg[bj][n] * (*(const f32x4*)(sc + col0 + bj * 32 + n * 4) + 1.f); hh[bj][n] = *(const f32x4*)(sh + col0 + bj * 32 + n * 4); } }
#pragma unroll
        for (int ai = 0; ai < 2; ++ai)
#pragma unroll
            for (int m = 0; m < 4; ++m) { const float r = S[ai * HALF + wr * 64 + m * 16 + fr]; const size_t ro = (size_t)(row0 + ai * HALF + m * 16);
#pragma unroll
                for (int bj = 0; bj < 2; ++bj) {
                    if (FINAL) { float* op = out + (ro - CTX) * D + col0 + bj * 32; *(f32x4*)op = acc[ai][bj][m][0] * r * gg[bj][0]; *(f32x4*)(op + 4) = acc[ai][bj][m][1] * r * gg[bj][1]; }
                    else { const f32x4 a = acc[ai][bj][m][0] * r * gg[bj][0] + hh[bj][0], b = acc[ai][bj][m][1] * r * gg[bj][1] + hh[bj][1]; u32x4 w;
                        w.x = cvt_pk_bf16(a[0], a[1]); w.y = cvt_pk_bf16(a[2], a[3]); w.z = cvt_pk_bf16(b[0], b[1]); w.w = cvt_pk_bf16(b[2], b[3]);
                        *(u32x4*)(H + ro * D + col0 + bj * 32) = w; } } }
    }
};
struct EpiRelu2 {            P2(2)
    static constexpr bool PERM = true, KEEP = false;
    bf16* O;
    __device__ __forceinline__ bool keep(const Unit&) const { return false; }
    __device__ __forceinline__ void operator()(f32x4 (&acc)[2][2][4][2], const Unit& u, int wr, int wc, int fr, int fq) const {
        const int row0 = u.pm * BM + wr * 64 + fr, col0 = u.pn * BM + wc * 64 + 8 * fq;
#pragma unroll
        for (int ai = 0; ai < 2; ++ai)
#pragma unroll
            for (int m = 0; m < 4; ++m) { bf16* rowp = O + (size_t)(row0 + ai * HALF + m * 16) * DFF + col0;
#pragma unroll
                for (int bj = 0; bj < 2; ++bj) { f32x4 a = acc[ai][bj][m][0], b = acc[ai][bj][m][1];
#pragma unroll
                    for (int j = 0; j < 4; ++j) { const float x = fmaxf(a[j], 0.f), y = fmaxf(b[j], 0.f); a[j] = x * x; b[j] = y * y; }
                    u32x4 w; w.x = cvt_pk_bf16(a[0], a[1]); w.y = cvt_pk_bf16(a[2], a[3]); w.z = cvt_pk_bf16(b[0], b[1]); w.w = cvt_pk_bf16(b[2], b[3]);
                    *(u32x4*)(rowp + bj * 32) = w; } }
    }
};

__device__ __forceinline__ int rope_src_col(int nv) {
    if (nv >= 2048) return nv;
    const int v = nv & 127, wc = v >> 5, fq = (v >> 3) & 3, n = (v >> 2) & 1, j = v & 3;
    return (nv & ~127) + 64 * (wc >> 1) + 16 * (wc & 1) + 4 * fq + j + 32 * n;
}
__device__ __forceinline__ void p0_transpose_item(const float* W, int N, bf16* WT, int ld, int koff, bool ropeperm, LAS float* scr, int item, int lane) {
    const int nblk = N / 32, kb = item / nblk, nb = item % nblk, k0 = 64 * kb, n0 = 32 * nb;
    const int nsrc = ropeperm ? rope_src_col(n0 + (lane & 31)) : n0 + (lane & 31);
#pragma unroll 8
    for (int i = 0; i < 32; ++i) { const int kk = 2 * i + (lane >> 5); scr[kk * 33 + (lane & 31)] = W[(size_t)(k0 + kk) * N + nsrc]; }
    LDS_WAIT(); asm volatile("" ::: "memory");
    const int c = lane & 7;
#pragma unroll
    for (int j = 0; j < 4; ++j) { const int n = (lane >> 3) + 8 * j; const LAS float* s = scr + (8 * c) * 33 + n;
        u32x4 o; o.x = pk2(s[0 * 33], s[1 * 33]); o.y = pk2(s[2 * 33], s[3 * 33]); o.z = pk2(s[4 * 33], s[5 * 33]); o.w = pk2(s[6 * 33], s[7 * 33]);
        *(u32x4*)(WT + (size_t)(n0 + n) * ld + koff + k0 + 8 * c) = o; }
    LDS_WAIT(); asm volatile("" ::: "memory");
}
__device__ __forceinline__ void p0_prologue(Frame& F) {
    const float* const __attribute__((address_space(4)))* in = F.in;
    const int gw = F.bid * 8 + F.wave, NGW = F.G * 8, lane = F.lane;
    const int gt = F.bid * 512 + F.tid, NGT = F.G * 512;
    {
        float* MOD = (float*)(F.ws + WS_MODP);
        constexpr int NJB = 6 * D / 256, NKQ = 16, KS = D / NKQ;
        for (int it = gw; it < DEPTH * NJB * NKQ; it += NGW) {
            const int l = it / (NJB * NKQ), r = it % (NJB * NKQ), kq = r / NJB, jb = r % NJB;
            const float* W = in[I_WADA] + ((size_t)l * D + kq * KS) * 6 * D + jb * 256 + lane * 4;
            f32x4 a0 = (f32x4){0.f, 0.f, 0.f, 0.f}, a1 = a0;
#pragma unroll 16
            for (int k = 0; k < KS; ++k) { const f32x4 w = __builtin_nontemporal_load((const f32x4*)(W + (size_t)k * 6 * D)); const float s0 = silu_f(in[I_CCTX][kq * KS + k]), s1 = silu_f(in[I_C][kq * KS + k]); a0 += w * s0; a1 += w * s1; }
            if (kq == 0) { const f32x4 b = *(const f32x4*)(in[I_BADA] + (size_t)l * 6 * D + jb * 256 + lane * 4); a0 += b; a1 += b; }
            float* o0 = MOD + (size_t)kq * (DEPTH * 2 * 6 * D) + ((size_t)l * 2 + 0) * 6 * D + jb * 256 + lane * 4;
            *(f32x4*)o0 = a0; *(f32x4*)(o0 + 6 * D) = a1;
        }
    }
    {
        LAS float* scr = (LAS float*)(F.lds + F.wave * 16640);
        constexpr int I_IN = (D / 64) * (N_IN / 64), I_BR = (RET_W / 64) * (D / 64), I_BP = (POOL_W / 64) * (D / 64), I_SQ = (D / 64) * (D / 64), I_F1 = (D / 64) * (DFF / 64), I_F2 = (DFF / 64) * (D / 64);
        constexpr int PER_L = I_IN + I_BR + 2 * I_BP + I_SQ + I_F1 + I_F2, TOTAL = DEPTH * PER_L;
        static_assert(8 * 16640 <= SCR_BYTES, "transposer LDS");
        unsigned char* ws = F.ws;
        auto decode = [&](int it, const float*& src, bf16*& dst, int& N, int& ld) {
            const int l = it / PER_L; int r = it % PER_L; const float* W; bf16* WT; int koff = 0, kb, nb;
            if (r < I_IN) { W = in[I_WIN] + (size_t)l * D * N_IN; N = N_IN; WT = (bf16*)(ws + WS_WIN + l * SZ_WIN); ld = D; kb = r / (N_IN / 64); nb = r % (N_IN / 64); }
            else if ((r -= I_IN) < I_BR) { W = in[I_WBR] + (size_t)l * RET_W * D; N = D; WT = (bf16*)(ws + WS_WCAT + l * SZ_WSQ); ld = D; kb = r / (D / 64); nb = r % (D / 64); }
            else if ((r -= I_BR) < I_BP) { W = in[I_WBP] + (size_t)l * POOL_W * D; N = D; WT = (bf16*)(ws + WS_WCAT + l * SZ_WSQ); ld = D; koff = RET_W; kb = r / (D / 64); nb = r % (D / 64); }
            else if ((r -= I_BP) < I_BP) { W = in[I_WBS] + (size_t)l * SG_W * D; N = D; WT = (bf16*)(ws + WS_WCAT + l * SZ_WSQ); ld = D; koff = RET_W + POOL_W; kb = r / (D / 64); nb = r % (D / 64); }
            else if ((r -= I_BP) < I_SQ) { W = in[I_WOUT] + (size_t)l * D * D; N = D; WT = (bf16*)(ws + WS_WOUT + l * SZ_WSQ); ld = D; kb = r / (D / 64); nb = r % (D / 64); }
            else if ((r -= I_SQ) < I_F1) { W = in[I_W1] + (size_t)l * D * DFF; N = DFF; WT = (bf16*)(ws + WS_W1 + l * SZ_WFF); ld = D; kb = r / (DFF / 64); nb = r % (DFF / 64); }
            else { r -= I_F1; W = in[I_W2] + (size_t)l * DFF * D; N = D; WT = (bf16*)(ws + WS_W2 + l * SZ_WFF); ld = DFF; kb = r / (D / 64); nb = r % (D / 64); }
            const int k0 = 64 * kb, n0 = 64 * nb;
            src = W + (size_t)k0 * N + n0;
            dst = WT + (size_t)n0 * ld + koff + k0;
        };
#define P0_LOAD(buf, srcu, Nu) do { const unsigned loff_ = (unsigned)(((lane >> 5) * (Nu) + 2 * (lane & 31)) * 4); \
            _Pragma("unroll") for (int i = 0; i < 32; ++i) buf[i] = __builtin_nontemporal_load((const f32x2*)((const char*)((srcu) + (size_t)(2 * i) * (Nu)) + loff_)); } while (0)
        f32x2 bufA[32], bufB[32];
        const float* sA; bf16* dA; int NA, ldA; const float* sB; bf16* dB; int NB, ldB;
        auto process = [&](f32x2 (&buf)[32], bf16* dst, int ld) {
#pragma unroll
            for (int i = 0; i < 32; ++i) { LAS float* q = scr + (2 * i + (lane >> 5)) * 65 + 2 * (lane & 31); q[0] = buf[i][0]; q[1] = buf[i][1]; }
            LDS_WAIT(); asm volatile("" ::: "memory");
            const int c = lane & 7;
#pragma unroll
            for (int j = 0; j < 8; ++j) { const int n = (lane >> 3) + 8 * j; const LAS float* p = scr + (8 * c) * 65 + n;
                u32x4 o; o.x = pk2(p[0 * 65], p[1 * 65]); o.y = pk2(p[2 * 65], p[3 * 65]); o.z = pk2(p[4 * 65], p[5 * 65]); o.w = pk2(p[6 * 65], p[7 * 65]);
                *(u32x4*)(dst + (size_t)n * ld + 8 * c) = o; }
            LDS_WAIT(); asm volatile("" ::: "memory");
        };
        int it = gw;
        if (it < TOTAL) {
            decode(it, sA, dA, NA, ldA);
            P0_LOAD(bufA, sA, NA);
            for (;;) {
                const int i1 = it + NGW;
                decode(i1 < TOTAL ? i1 : it, sB, dB, NB, ldB);
                P0_LOAD(bufB, sB, NB);
                process(bufA, dA, ldA);
                if (i1 >= TOTAL) break;
                const int i2 = i1 + NGW;
                decode(i2 < TOTAL ? i2 : i1, sA, dA, NA, ldA);
                P0_LOAD(bufA, sA, NA);
                process(bufB, dB, ldB);
                if (i2 >= TOTAL) break;
                it = i2;
            }
        }
#undef P0_LOAD
    }
    {
        bf16* PWT = (bf16*)(F.ws + WS_PWT); bf16* SGW = (bf16*)(F.ws + WS_SGW); float* ROPE = (float*)(F.ws + WS_ROPE);
        for (int i = gt; i < DEPTH * 4 * 128 * 128; i += NGT) {
            const int lg = i >> 14, d = (i >> 7) & 127, c = i & 127;
            PWT[i] = (bf16)f2bf(in[I_PW][(size_t)lg * 16384 + c * 128 + d]);
            SGW[i] = (bf16)f2bf(in[I_SGW][i]);
        }
        for (int i = gt; i < 128 * 32; i += NGT) { const int pos = i >> 5, f = i & 31; const float inv = powf(10000.f, -(float)f / 32.f); const float ang = (float)pos * inv; ROPE[2 * i] = cosf(ang); ROPE[2 * i + 1] = sinf(ang); }
    }
}

__device__ __forceinline__ void mod_reduce_phase(Frame& F) {
    const float* P = (const float*)(F.ws + WS_MODP); float* MOD = (float*)(F.ws + WS_MOD);
    for (int i = F.bid * 512 + F.tid; i < DEPTH * 2 * 6 * D; i += F.G * 512) { float s = 0.f;
#pragma unroll
        for (int k = 0; k < 16; ++k) s += P[(size_t)k * (DEPTH * 2 * 6 * D) + i];
        MOD[i] = s; }
}
__device__ __forceinline__ void norm_phase(Frame& F, const float* g, const float* modl, int si, bool first, const float* slab_gate = nullptr) {
    bf16* X = (bf16*)(F.ws + WS_X); bf16* H = (bf16*)(F.ws + WS_H);
    const int gw = F.bid * 8 + F.wave, NGW = F.G * 8, lane = F.lane;
    if (slab_gate) {
        LAS float* red = (LAS float*)F.lds;
        for (int row = F.bid; row < CTX; row += F.G) {
            const int c = 256 * F.wave + 4 * lane;
            const float* SL = (const float*)(F.ws + WS_SLAB) + (size_t)row * D + c;
            f32x4 sm = *(const f32x4*)SL;
#pragma unroll
            for (int k = 1; k < 4; ++k) sm += *(const f32x4*)(SL + (size_t)k * CTX * D);
            const u32x2 xo = *(const u32x2*)(X + (size_t)row * D + c); const f32x4 gt = *(const f32x4*)(slab_gate + c);
            u32x2 xn; xn.x = cvt_pk_bf16(bflo(xo.x) + gt[0] * sm[0], bfhi(xo.x) + gt[1] * sm[1]); xn.y = cvt_pk_bf16(bflo(xo.y) + gt[2] * sm[2], bfhi(xo.y) + gt[3] * sm[3]);
            *(u32x2*)(X + (size_t)row * D + c) = xn;
            const float v0 = bflo(xn.x), v1 = bfhi(xn.x), v2 = bflo(xn.y), v3 = bfhi(xn.y);
            const float ps = wave_sum((v0 * v0 + v1 * v1) + (v2 * v2 + v3 * v3));
            __syncthreads();
            if (lane == 0) red[F.wave] = ps;
            __syncthreads();
            float tot = 0.f;
#pragma unroll
            for (int k = 0; k < 8; ++k) tot += red[k];
            const float r = rsqrtf(tot * (1.f / D) + EPS);
            const f32x4 gg = *(const f32x4*)(g + c), sc = *(const f32x4*)(modl + (si + 1) * D + c), sh = *(const f32x4*)(modl + si * D + c);
            u32x2 w; w.x = cvt_pk_bf16(v0 * r * gg[0] * (sc[0] + 1.f) + sh[0], v1 * r * gg[1] * (sc[1] + 1.f) + sh[1]); w.y = cvt_pk_bf16(v2 * r * gg[2] * (sc[2] + 1.f) + sh[2], v3 * r * gg[3] * (sc[3] + 1.f) + sh[3]);
            *(u32x2*)(H + (size_t)row * D + c) = w;
        }
    }
    if (!first) {
        int row = slab_gate ? CTX + gw : gw;
        u32x4 cur[4], nxt[4];
        if (row < MROWS) {
#pragma unroll
            for (int j = 0; j < 4; ++j) cur[j] = *(const u32x4*)(X + (size_t)row * D + j * 512 + lane * 8);
        }
        while (row < MROWS) {
            const int nrow = row + NGW;
            if (nrow < MROWS) {
#pragma unroll
                for (int j = 0; j < 4; ++j) nxt[j] = *(const u32x4*)(X + (size_t)nrow * D + j * 512 + lane * 8);
            }
            float v[32]; float s = 0.f;
#pragma unroll
            for (int j = 0; j < 4; ++j)
#pragma unroll
                for (int e = 0; e < 4; ++e) { v[8 * j + 2 * e] = bflo(cur[j][e]); v[8 * j + 2 * e + 1] = bfhi(cur[j][e]); }
#pragma unroll
            for (int e = 0; e < 32; ++e) s += v[e] * v[e];
            const float r = rsqrtf(wave_sum(s) * (1.f / D) + EPS);
            const float* m = modl + (size_t)(row < CTX ? 0 : 1) * 6 * D;
#pragma unroll
            for (int j = 0; j < 4; ++j) { const int c = j * 512 + lane * 8; float o[8];
#pragma unroll
                for (int h = 0; h < 2; ++h) { const f32x4 gg = *(const f32x4*)(g + c + 4 * h), sc = *(const f32x4*)(m + (si + 1) * D + c + 4 * h), sh = *(const f32x4*)(m + si * D + c + 4 * h);
#pragma unroll
                    for (int e = 0; e < 4; ++e) o[4 * h + e] = v[8 * j + 4 * h + e] * r * gg[e] * (sc[e] + 1.f) + sh[e]; }
                u32x4 w; w.x = cvt_pk_bf16(o[0], o[1]); w.y = cvt_pk_bf16(o[2], o[3]); w.z = cvt_pk_bf16(o[4], o[5]); w.w = cvt_pk_bf16(o[6], o[7]);
                *(u32x4*)(H + (size_t)row * D + c) = w; }
#pragma unroll
            for (int j = 0; j < 4; ++j) cur[j] = nxt[j];
            row = nrow;
        }
        return;
    }
    for (int row = slab_gate ? CTX + gw : gw; row < MROWS; row += NGW) {
        float v[32]; float s = 0.f;
        if (first) {
            const float* src = row < CTX ? F.in[I_CTX] + (size_t)row * D : F.in[I_X] + (size_t)(row - CTX) * D;
#pragma unroll
            for (int j = 0; j < 4; ++j) { const f32x4 a = *(const f32x4*)(src + j * 512 + lane * 8), b = *(const f32x4*)(src + j * 512 + lane * 8 + 4);
#pragma unroll
                for (int e = 0; e < 4; ++e) { v[8 * j + e] = a[e]; v[8 * j + 4 + e] = b[e]; }
                u32x4 w; w.x = cvt_pk_bf16(a[0], a[1]); w.y = cvt_pk_bf16(a[2], a[3]); w.z = cvt_pk_bf16(b[0], b[1]); w.w = cvt_pk_bf16(b[2], b[3]);
                *(u32x4*)(X + (size_t)row * D + j * 512 + lane * 8) = w; }
        } else {
#pragma unroll
            for (int j = 0; j < 4; ++j) { const u32x4 x = *(const u32x4*)(X + (size_t)row * D + j * 512 + lane * 8);
#pragma unroll
                for (int e = 0; e < 4; ++e) { v[8 * j + 2 * e] = bflo(x[e]); v[8 * j + 2 * e + 1] = bfhi(x[e]); } }
        }
#pragma unroll
        for (int e = 0; e < 32; ++e) s += v[e] * v[e];
        const float r = rsqrtf(wave_sum(s) * (1.f / D) + EPS);
        const float* m = modl + (size_t)(row < CTX ? 0 : 1) * 6 * D;
#pragma unroll
        for (int j = 0; j < 4; ++j) { const int c = j * 512 + lane * 8; float o[8];
#pragma unroll
            for (int h = 0; h < 2; ++h) { const f32x4 gg = *(const f32x4*)(g + c + 4 * h), sc = *(const f32x4*)(m + (si + 1) * D + c + 4 * h), sh = *(const f32x4*)(m + si * D + c + 4 * h);
#pragma unroll
                for (int e = 0; e < 4; ++e) o[4 * h + e] = v[8 * j + 4 * h + e] * r * gg[e] * (sc[e] + 1.f) + sh[e]; }
            u32x4 w; w.x = cvt_pk_bf16(o[0], o[1]); w.y = cvt_pk_bf16(o[2], o[3]); w.z = cvt_pk_bf16(o[4], o[5]); w.w = cvt_pk_bf16(o[6], o[7]);
            *(u32x4*)(H + (size_t)row * D + c) = w; }
    }
}
#ifndef FUSE_FINAL
#define FUSE_FINAL 1
#endif
__device__ __forceinline__ void final_norm_phase(Frame& F, float* out) {
    if (FUSE_FINAL) return;
    const bf16* X = (const bf16*)(F.ws + WS_X); const float* g = F.in[I_FNG];
    const int gw = F.bid * 8 + F.wave, NGW = F.G * 8, lane = F.lane;
    u32x4 cur[4], nxt[4];
    if (gw < SEQ) {
#pragma unroll
        for (int j = 0; j < 4; ++j) cur[j] = *(const u32x4*)(X + (size_t)(gw + CTX) * D + j * 512 + lane * 8);
    }
    for (int row = gw; row < SEQ; row += NGW) {
        if (row + NGW < SEQ) {
#pragma unroll
            for (int j = 0; j < 4; ++j) nxt[j] = *(const u32x4*)(X + (size_t)(row + NGW + CTX) * D + j * 512 + lane * 8);
        }
        float v[32]; float s = 0.f;
#pragma unroll
        for (int j = 0; j < 4; ++j) { const u32x4 x = cur[j];
#pragma unroll
            for (int e = 0; e < 4; ++e) { v[8 * j + 2 * e] = bflo(x[e]); v[8 * j + 2 * e + 1] = bfhi(x[e]); } }
#pragma unroll
        for (int e = 0; e < 32; ++e) s += v[e] * v[e];
        const float r = rsqrtf(wave_sum(s) * (1.f / D) + EPS);
#pragma unroll
        for (int j = 0; j < 4; ++j) { const int c = j * 512 + lane * 8;
#pragma unroll
            for (int h = 0; h < 2; ++h) { const f32x4 gg = *(const f32x4*)(g + c + 4 * h); f32x4 o;
#pragma unroll
                for (int e = 0; e < 4; ++e) o[e] = v[8 * j + 4 * h + e] * r * gg[e];
                *(f32x4*)(out + (size_t)row * D + c + 4 * h) = o; } }
#pragma unroll
        for (int j = 0; j < 4; ++j) cur[j] = nxt[j];
    }
}

#define MFMA16(a, b, c) __builtin_amdgcn_mfma_f32_16x16x32_bf16((a), (b), (c), 0, 0, 0)
template <bool TWO>
__device__ __forceinline__ void fill_transposed(LAS unsigned char* T0, LAS unsigned char* T1, const bf16* src, size_t ld, int tid, float sc0, float sc1, bool scaled) {
    const int s = tid & 127, dq = tid >> 7;
    const bf16* rp = src + (size_t)s * ld + 32 * dq;
    u32x4 v[4];
#pragma unroll
    for (int kk = 0; kk < 4; ++kk) v[kk] = *(const u32x4*)(rp + 8 * kk);
#pragma unroll
    for (int kk = 0; kk < 4; ++kk)
#pragma unroll
        for (int q = 0; q < 4; ++q) {
            const int d = 32 * dq + 8 * kk + 2 * q; const unsigned w = v[kk][q];
            if (scaled) { const float lo = bflo(w), hi = bfhi(w);
                *(LAS bf16*)(T0 + d * TP + s * 2) = (bf16)f2bf(lo * sc0); *(LAS bf16*)(T0 + (d + 1) * TP + s * 2) = (bf16)f2bf(hi * sc0);
                if (TWO) { *(LAS bf16*)(T1 + d * TP + s * 2) = (bf16)f2bf(lo * sc1); *(LAS bf16*)(T1 + (d + 1) * TP + s * 2) = (bf16)f2bf(hi * sc1); } }
            else { *(LAS bf16*)(T0 + d * TP + s * 2) = (bf16)(w & 0xffffu); *(LAS bf16*)(T0 + (d + 1) * TP + s * 2) = (bf16)(w >> 16); }
        }
}
__device__ __forceinline__ void fill_rows(LAS unsigned char* T, const bf16* src, size_t ld, int tid) {
    const int r = tid >> 4, sg = tid & 15;
    const bf16* rp = src + (size_t)r * ld + sg * 8;
    u32x4 v[4];
#pragma unroll
    for (int q = 0; q < 4; ++q) v[q] = *(const u32x4*)(rp + (size_t)(32 * q) * ld);
#pragma unroll
    for (int q = 0; q < 4; ++q) *(LAS u32x4*)(T + (r + 32 * q) * TP + sg * 16) = v[q];
}

typedef short s16x4 __attribute__((ext_vector_type(4)));
__device__ __forceinline__ bf16x8 tr_frag(const LAS unsigned char* T, int rowa, int rowb, int col0, int lane) {
    const int i = lane & 15;
    const LAS unsigned char* pa = T + (rowa + (i >> 2)) * TP + (col0 + 4 * (i & 3)) * 2;
    const LAS unsigned char* pb = T + (rowb + (i >> 2)) * TP + (col0 + 4 * (i & 3)) * 2;
    const s16x4 lo = __builtin_amdgcn_ds_read_tr16_b64_v4i16((LAS s16x4*)pa), hi = __builtin_amdgcn_ds_read_tr16_b64_v4i16((LAS s16x4*)pb);
    return (bf16x8){lo[0], lo[1], lo[2], lo[3], hi[0], hi[1], hi[2], hi[3]};
}
__device__ __forceinline__ void kv_item(Frame& F, int l, int c, int h) {
    LAS unsigned char* Kt = F.lds; LAS unsigned char* Vt = F.lds + TILE_B;
    const bf16* ZB = (const bf16*)(F.ws + WS_ZB) + (size_t)c * 128 * N_IN;
    const float* lg = F.in[I_RLOG] + (size_t)l * 2 * RET_H;
    const float l2f = log_sigmoid_f(lg[h]) * LOG2E, l2b = log_sigmoid_f(lg[RET_H + h]) * LOG2E;
    fill_rows(Kt, ZB + C_K + h * HD, N_IN, F.tid);
    fill_rows(Vt, ZB + C_V + h * HD, N_IN, F.tid);
    __syncthreads();
    const int w = F.wave, fr = F.lane & 15, fq = F.lane >> 4;
    bf16x8 vf[4], vb[4];
    float gpf[8], gpb[8];
    { const float gf = exp2f(l2f), gb = exp2f(l2b); gpf[0] = 1.f; gpb[0] = 1.f;
#pragma unroll
      for (int k = 1; k < 8; ++k) { gpf[k] = gpf[k - 1] * gf; gpb[k] = gpb[k - 1] * gb; } }
#pragma unroll
    for (int t = 0; t < 4; ++t) {
        const bf16x8 raw = tr_frag(Vt, 32 * t + 8 * fq, 32 * t + 8 * fq + 4, 16 * w, F.lane);
        const u32x4 rw = __builtin_bit_cast(u32x4, raw); u32x4 pf, pb;
        const int sg0 = 32 * t + 8 * fq;
        const float wf7 = exp2f(l2f * (float)(120 - sg0)), wb0 = exp2f(l2b * (float)sg0);
#pragma unroll
        for (int q = 0; q < 4; ++q) { const float lo = bflo(rw[q]), hi = bfhi(rw[q]);
            pf[q] = cvt_pk_bf16(lo * (wf7 * gpf[7 - 2 * q]), hi * (wf7 * gpf[6 - 2 * q]));
            pb[q] = cvt_pk_bf16(lo * (wb0 * gpb[2 * q]), hi * (wb0 * gpb[2 * q + 1])); }
        vf[t] = __builtin_bit_cast(bf16x8, pf); vb[t] = __builtin_bit_cast(bf16x8, pb);
    }
    bf16* KVT = (bf16*)(F.ws + WS_KVT) + (((size_t)c * RET_H + h) * 2) * 16384 + (size_t)(16 * w + fr) * 128 + 4 * fq;
#pragma unroll
    for (int db = 0; db < 8; ++db) {
        f32x4 af = (f32x4){0.f, 0.f, 0.f, 0.f}, ab = af;
#pragma unroll
        for (int t = 0; t < 4; ++t) {
            const bf16x8 kf = tr_frag(Kt, 32 * t + 8 * fq, 32 * t + 8 * fq + 4, 16 * db, F.lane);
            af = MFMA16(kf, vf[t], af); ab = MFMA16(kf, vb[t], ab);
        }
        u32x2 of, ob; of.x = pk2(af[0], af[1]); of.y = pk2(af[2], af[3]); ob.x = pk2(ab[0], ab[1]); ob.y = pk2(ab[2], ab[3]);
        *(u32x2*)(KVT + 16 * db) = of; *(u32x2*)(KVT + 16384 + 16 * db) = ob;
    }
    __syncthreads();
}
__device__ __forceinline__ void pool_item(Frame& F, int l, int c, int g) {
    LAS unsigned char* Pin = F.lds; LAS unsigned char* PWT = F.lds + 144 * TP; LAS unsigned char* Yl = PWT + TILE_B;
    const bf16* ZB = (const bf16*)(F.ws + WS_ZB);
    const int row0 = c * 128, tid = F.tid;
    for (int p = tid; p < 144 * 16; p += 512) { const int rr = p >> 4, sg = p & 15, grow = row0 - 8 + rr;
        if (grow >= 0 && grow < MROWS) *(LAS u32x4*)(Pin + rr * TP + sg * 16) = *(const u32x4*)(ZB + (size_t)grow * N_IN + C_P + g * 128 + sg * 8); }
    fill_rows(PWT, (const bf16*)(F.ws + WS_PWT) + (size_t)(l * 4 + g) * 16384, 128, tid);
    __syncthreads();
    {
        const int t = tid >> 2, cq = tid & 3, grow = row0 + t;
        int seg0, seglen, pos;
        if (grow < CTX) { seg0 = 0; seglen = CTX; pos = grow; } else { const int tok = grow - CTX; seg0 = CTX + (tok / GRID_W) * GRID_W; seglen = GRID_W; pos = tok % GRID_W; }
        const int w = 2 << g; int lo = pos - w / 2; if (lo < 0) lo = 0; int hi = pos + w / 2 - 1; if (hi > seglen - 1) hi = seglen - 1;
        const float inv = 1.f / (float)(hi - lo + 1);
        float sum[32];
#pragma unroll
        for (int j = 0; j < 32; ++j) sum[j] = 0.f;
        for (int p = lo; p <= hi; ++p) { const LAS unsigned char* rp = Pin + (seg0 + p - (row0 - 8)) * TP + cq * 64;
#pragma unroll
            for (int q = 0; q < 4; ++q) { const u32x4 v = *(const LAS u32x4*)(rp + q * 16);
#pragma unroll
                for (int e = 0; e < 4; ++e) { sum[q * 8 + 2 * e] += bflo(v[e]); sum[q * 8 + 2 * e + 1] += bfhi(v[e]); } } }
        const LAS unsigned char* sp = Pin + (t + 8) * TP + cq * 64;
#pragma unroll
        for (int q = 0; q < 4; ++q) { const u32x4 v = *(const LAS u32x4*)(sp + q * 16); u32x4 o;
#pragma unroll
            for (int e = 0; e < 4; ++e) o[e] = cvt_pk_bf16(sum[q * 8 + 2 * e] * inv - bflo(v[e]), sum[q * 8 + 2 * e + 1] * inv - bfhi(v[e]));
            *(LAS u32x4*)(Yl + t * TP + cq * 64 + q * 16) = o; }
    }
    __syncthreads();
    const int w = F.wave, fr = F.lane & 15, fq = F.lane >> 4;
    bf16x8 yb[4];
#pragma unroll
    for (int t = 0; t < 4; ++t) yb[t] = *(const LAS bf16x8*)(Yl + (16 * w + fr) * TP + (32 * t + 8 * fq) * 2);
    bf16* MIX = (bf16*)(F.ws + WS_MIX) + (size_t)(row0 + 16 * w + fr) * D + RET_W + g * 128 + 4 * fq;
    const float* ps = F.in[I_PS] + (size_t)l * POOL_W + g * 128 + 4 * fq;
    f32x4 scv[8];
#pragma unroll
    for (int db = 0; db < 8; ++db) scv[db] = *(const f32x4*)(ps + 16 * db);
#pragma unroll
    for (int db = 0; db < 8; ++db) {
        f32x4 a = (f32x4){0.f, 0.f, 0.f, 0.f};
#pragma unroll
        for (int t = 0; t < 4; ++t) a = MFMA16(*(const LAS bf16x8*)(PWT + (16 * db + fr) * TP + (32 * t + 8 * fq) * 2), yb[t], a);
        a = a * scv[db];
        u32x2 o; o.x = cvt_pk_bf16(a[0], a[1]); o.y = cvt_pk_bf16(a[2], a[3]);
        *(u32x2*)(MIX + 16 * db) = o;
    }
    __syncthreads();
}
__device__ __forceinline__ void sg_item(Frame& F, int l, int c, int g) {
    LAS unsigned char* VN = F.lds;
    const bf16* ZB = (const bf16*)(F.ws + WS_ZB) + (size_t)c * 128 * N_IN;
    const int tid = F.tid;
    {
        const int w0 = F.wave * 16, lane = F.lane;
        u32x4 rv[16];
#pragma unroll
        for (int i = 0; i < 16; ++i) rv[i] = *(const u32x4*)(ZB + (size_t)(w0 + i) * N_IN + C_SV + 8 * lane);
        const float* ng = F.in[I_SGNG] + (size_t)l * SG_W + 8 * lane;
        const f32x4 n0 = *(const f32x4*)ng, n1 = *(const f32x4*)(ng + 4);
        float ss[16];
#pragma unroll
        for (int i = 0; i < 16; ++i) { const u32x4 v = rv[i]; ss[i] = 0.f;
#pragma unroll
            for (int e = 0; e < 4; ++e) { const float a = bflo(v[e]), b = bfhi(v[e]); ss[i] += a * a + b * b; } }
#pragma unroll
        for (int o = 1; o < 64; o <<= 1)
#pragma unroll
            for (int i = 0; i < 16; ++i) ss[i] += __shfl_xor(ss[i], o);
        if ((lane >> 4) == g) {
#pragma unroll
            for (int i = 0; i < 16; ++i) { const u32x4 v = rv[i]; const float r = rsqrtf(ss[i] * (1.f / SG_W) + EPS); u32x4 o;
                o.x = cvt_pk_bf16(bflo(v.x) * r * n0[0], bfhi(v.x) * r * n0[1]); o.y = cvt_pk_bf16(bflo(v.y) * r * n0[2], bfhi(v.y) * r * n0[3]);
                o.z = cvt_pk_bf16(bflo(v.z) * r * n1[0], bfhi(v.z) * r * n1[1]); o.w = cvt_pk_bf16(bflo(v.w) * r * n1[2], bfhi(v.w) * r * n1[3]);
                *(LAS u32x4*)(VN + (w0 + i) * TP + (lane & 15) * 16) = o; }
        }
    }
    __syncthreads();
    const int w = F.wave, fr = F.lane & 15, fq = F.lane >> 4;
    const bf16* SGW = (const bf16*)(F.ws + WS_SGW) + ((size_t)(l * 4 + g) * 128 + 16 * w + fr) * 128;
    bf16x8 wf[4];
#pragma unroll
    for (int t = 0; t < 4; ++t) wf[t] = *(const bf16x8*)(SGW + 32 * t + 8 * fq);
    const float bias = F.in[I_SGB][(size_t)(l * 4 + g) * 128 + 16 * w + fr];
    const bf16* U = ZB + (size_t)(16 * w + fr) * N_IN + C_U + g * 128 + 4 * fq;
    u32x2 uvv[8];
#pragma unroll
    for (int cb = 0; cb < 8; ++cb) uvv[cb] = *(const u32x2*)(U + 16 * cb);
    bf16* MIX = (bf16*)(F.ws + WS_MIX) + (size_t)(c * 128 + 16 * w + fr) * D + RET_W + POOL_W + g * 128 + 4 * fq;
#pragma unroll
    for (int cb = 0; cb < 8; ++cb) {
        f32x4 a = (f32x4){0.f, 0.f, 0.f, 0.f};
#pragma unroll
        for (int t = 0; t < 4; ++t) a = MFMA16(tr_frag(VN, 32 * t + 8 * fq, 32 * t + 8 * fq + 4, 16 * cb, F.lane), wf[t], a);
        const u32x2 uv = uvv[cb];
        u32x2 o; o.x = cvt_pk_bf16((a[0] + bias) * bflo(uv.x), (a[1] + bias) * bfhi(uv.x)); o.y = cvt_pk_bf16((a[2] + bias) * bflo(uv.y), (a[3] + bias) * bfhi(uv.y));
        *(u32x2*)(MIX + 16 * cb) = o;
    }
    __syncthreads();
}
__device__ __forceinline__ void scan_phase(Frame& F, int l, int nskip) {
    const bf16* KVT = (const bf16*)(F.ws + WS_KVT); bf16* ST = (bf16*)(F.ws + WS_ST);
    const float* lg = F.in[I_RLOG] + (size_t)l * 2 * RET_H;
    if (F.bid < nskip) return;
    const int nw = F.G - nskip, per = (65536 + nw - 1) / nw, p = (F.bid - nskip) * per + F.tid;
    if (F.tid < per && p < 65536) {
        const int hd = p >> 12, h = hd >> 1, dir = hd & 1;
        const float g128 = expf(128.f * log_sigmoid_f(lg[dir * RET_H + h]));
        const size_t e0 = (size_t)p * 4;
        u32x2 kvw[NCHUNK];
#pragma unroll
        for (int c = 0; c < NCHUNK; ++c) kvw[c] = *(const u32x2*)(KVT + (size_t)c * 262144 + e0);
        f32x4 S = (f32x4){0.f, 0.f, 0.f, 0.f};
        if (dir == 0) {
#pragma unroll
            for (int c = 0; c < NCHUNK; ++c) { u32x2 o; o.x = cvt_pk_bf16(S[0], S[1]); o.y = cvt_pk_bf16(S[2], S[3]); *(u32x2*)(ST + (size_t)c * 262144 + e0) = o;
                S = S * g128 + (f32x4){bflo(kvw[c].x), bfhi(kvw[c].x), bflo(kvw[c].y), bfhi(kvw[c].y)}; }
        } else {
#pragma unroll
            for (int i = 0; i < NCHUNK; ++i) { const int c = i < 2 ? 1 - i : NCHUNK + 1 - i; u32x2 o; o.x = cvt_pk_bf16(S[0], S[1]); o.y = cvt_pk_bf16(S[2], S[3]); *(u32x2*)(ST + (size_t)c * 262144 + e0) = o;
                S = S * g128 + (f32x4){bflo(kvw[c].x), bfhi(kvw[c].x), bflo(kvw[c].y), bfhi(kvw[c].y)}; }
        }
    }
}
__device__ __forceinline__ void fill_rows_f32(LAS unsigned char* T, const float* src, int tid) {
    const int r = tid >> 2, sg = tid & 3;
#pragma unroll
    for (int q = 0; q < 4; ++q) { unsigned z = 0u; asm volatile("" : "+v"(z));
        u32x4 w = (u32x4){z, z, z, z};
        if (src) { const f32x4 a = *(const f32x4*)(src + (size_t)r * 128 + sg * 32 + q * 8), b = *(const f32x4*)(src + (size_t)r * 128 + sg * 32 + q * 8 + 4);
            w.x = cvt_pk_bf16(a[0], a[1]); w.y = cvt_pk_bf16(a[2], a[3]); w.z = cvt_pk_bf16(b[0], b[1]); w.w = cvt_pk_bf16(b[2], b[3]); }
        *(LAS u32x4*)(T + r * TP + sg * 64 + q * 16) = w; }
}
__device__ __forceinline__ void ret_core(Frame& F, int l, int c, int h, float l2f, float l2b, const bf16x8 (&qf)[4], const u32x2 (&gvv)[8]) {
    LAS unsigned char* Kt = F.lds; LAS unsigned char* VT = F.lds + TILE_B; LAS unsigned char* SF = F.lds + 2 * TILE_B; LAS unsigned char* SB = F.lds + 3 * TILE_B;
    const int w = F.wave, fr = F.lane & 15, fq = F.lane >> 4;
    const int i = 16 * w + fr;
    bf16x8 pf[4];
#pragma unroll
    for (int tp = 0; tp < 4; ++tp) {
        unsigned pw[4];
#pragma unroll
        for (int bb = 0; bb < 2; ++bb) {
            const int b = 2 * tp + bb;
            f32x4 s = (f32x4){0.f, 0.f, 0.f, 0.f};
#pragma unroll
            for (int t = 0; t < 4; ++t) s = MFMA16(*(const LAS bf16x8*)(Kt + (16 * b + fr) * TP + (32 * t + 8 * fq) * 2), qf[t], s);
            float pv[4];
#pragma unroll
            for (int r = 0; r < 4; ++r) { const int j = 16 * b + 4 * fq + r; const int dd = i - j;
                const float dm = dd > 0 ? exp2f(l2f * (float)dd) : (dd < 0 ? exp2f(l2b * (float)(-dd)) : 2.f); pv[r] = s[r] * dm; }
            pw[2 * bb] = cvt_pk_bf16(pv[0], pv[1]); pw[2 * bb + 1] = cvt_pk_bf16(pv[2], pv[3]);
        }
        u32x4 pk; pk.x = pw[0]; pk.y = pw[1]; pk.z = pw[2]; pk.w = pw[3];
        pf[tp] = __builtin_bit_cast(bf16x8, pk);
    }
    const float af = exp2f(l2f * (float)(i + 1)), ab = exp2f(l2b * (float)(128 - i));
    f32x4 o[8]; float ss = 0.f;
#pragma unroll
    for (int eb = 0; eb < 8; ++eb) {
        f32x4 a0 = (f32x4){0.f, 0.f, 0.f, 0.f}, a1 = a0, a2 = a0;
#pragma unroll
        for (int t = 0; t < 4; ++t) {
            a0 = MFMA16(tr_frag(VT, 32 * t + 4 * fq, 32 * t + 16 + 4 * fq, 16 * eb, F.lane), pf[t], a0);
            a1 = MFMA16(*(const LAS bf16x8*)(SF + (16 * eb + fr) * TP + (32 * t + 8 * fq) * 2), qf[t], a1);
            a2 = MFMA16(*(const LAS bf16x8*)(SB + (16 * eb + fr) * TP + (32 * t + 8 * fq) * 2), qf[t], a2);
        }
        o[eb] = a0 + a1 * af + a2 * ab;
        ss += (o[eb][0] * o[eb][0] + o[eb][1] * o[eb][1]) + (o[eb][2] * o[eb][2] + o[eb][3] * o[eb][3]);
    }
    ss += __shfl_xor(ss, 16); ss += __shfl_xor(ss, 32);
    const float r = rsqrtf(ss * (1.f / HD) + EPS);
    bf16* MIX = (bf16*)(F.ws + WS_MIX) + (size_t)(c * 128 + i) * D + h * HD + 4 * fq;
    f32x4 n4v[8];
    { const float* ng = F.in[I_RNG] + (size_t)l * RET_W + h * HD + 4 * fq;
#pragma unroll
      for (int eb = 0; eb < 8; ++eb) n4v[eb] = *(const f32x4*)(ng + 16 * eb); }
#pragma unroll
    for (int eb = 0; eb < 8; ++eb) {
        const u32x2 gv = gvv[eb]; const f32x4 n4 = n4v[eb];
        const f32x4 v = o[eb] * r * n4;
        u32x2 ov; ov.x = cvt_pk_bf16(v[0] * bflo(gv.x), v[1] * bfhi(gv.x)); ov.y = cvt_pk_bf16(v[2] * bflo(gv.y), v[3] * bfhi(gv.y));
        *(u32x2*)(MIX + 16 * eb) = ov;
    }
    __syncthreads();
}


template <bool CTXSRC>
__device__ __forceinline__ void ret_item(Frame& F, int l, int c, int h) {
    LAS unsigned char* Kt = F.lds; LAS unsigned char* VT = F.lds + TILE_B; LAS unsigned char* SF = F.lds + 2 * TILE_B; LAS unsigned char* SB = F.lds + 3 * TILE_B;
    const bf16* ZB = (const bf16*)(F.ws + WS_ZB) + (size_t)c * 128 * N_IN;
    const bf16* ST = (const bf16*)(F.ws + WS_ST) + (((size_t)c * RET_H + h) * 2) * 16384;
    const float* lg = F.in[I_RLOG] + (size_t)l * 2 * RET_H;
    const float l2f = log_sigmoid_f(lg[h]) * LOG2E, l2b = log_sigmoid_f(lg[RET_H + h]) * LOG2E;
    const int tid = F.tid, w = F.wave, fr = F.lane & 15, fq = F.lane >> 4;
    fill_rows(Kt, ZB + C_K + h * HD, N_IN, tid);
    if (CTXSRC) {
        const bf16* KV = (const bf16*)(F.ws + WS_KVT) + (((size_t)(1 - c) * RET_H + h) * 2) * 16384;
        if (c == 1) fill_rows(SF, KV, 128, tid); else fill_rows_f32(SF, nullptr, tid);
        if (c == 0) fill_rows(SB, KV + 16384, 128, tid); else fill_rows_f32(SB, nullptr, tid);
    } else {
        fill_rows(SF, ST, 128, tid);
        fill_rows(SB, ST + 16384, 128, tid);
    }
    fill_rows(VT, ZB + C_V + h * HD, N_IN, tid);
    bf16x8 qf[4];
    { const bf16* qp = ZB + (size_t)(16 * w + fr) * N_IN + C_Q + h * HD + 8 * fq;
#pragma unroll
      for (int t = 0; t < 4; ++t) qf[t] = *(const bf16x8*)(qp + 32 * t); }
    const int i = 16 * w + fr;
    u32x2 gvv[8];
    { const bf16* G = ZB + (size_t)i * N_IN + C_G + h * HD + 4 * fq;
#pragma unroll
      for (int eb = 0; eb < 8; ++eb) gvv[eb] = *(const u32x2*)(G + 16 * eb); }
    __syncthreads();
    ret_core(F, l, c, h, l2f, l2b, qf, gvv);
}
__device__ __forceinline__ void ret_tiles_load(Frame& F, int c, int h, u32x4 (&pf)[8]) {
    const bf16* ZB = (const bf16*)(F.ws + WS_ZB) + (size_t)c * 128 * N_IN;
    int t = F.tid; asm volatile("" : "+v"(t));
    const int r = t >> 4, sg = t & 15;
#pragma unroll
    for (int q = 0; q < 4; ++q) { pf[q] = *(const u32x4*)(ZB + (size_t)(r + 32 * q) * N_IN + C_K + h * HD + sg * 8); pf[4 + q] = *(const u32x4*)(ZB + (size_t)(r + 32 * q) * N_IN + C_V + h * HD + sg * 8); }
}
__device__ __forceinline__ void ret_item_pipe(Frame& F, int l, int c, int h, u32x4 (&pf)[8], int nc, int nh, bool has_next) {
    LAS unsigned char* Kt = F.lds; LAS unsigned char* VT = F.lds + TILE_B; LAS unsigned char* SF = F.lds + 2 * TILE_B; LAS unsigned char* SB = F.lds + 3 * TILE_B;
    const bf16* ZB = (const bf16*)(F.ws + WS_ZB) + (size_t)c * 128 * N_IN;
    const bf16* ST = (const bf16*)(F.ws + WS_ST) + (((size_t)c * RET_H + h) * 2) * 16384;
    const float* lg = F.in[I_RLOG] + (size_t)l * 2 * RET_H;
    const float l2f = log_sigmoid_f(lg[h]) * LOG2E, l2b = log_sigmoid_f(lg[RET_H + h]) * LOG2E;
    const int w = F.wave, fr = F.lane & 15, fq = F.lane >> 4, r = F.tid >> 4, sg = F.tid & 15;
    fill_rows(SF, ST, 128, F.tid);
    fill_rows(SB, ST + 16384, 128, F.tid);
    bf16x8 qf[4];
    { const bf16* qp = ZB + (size_t)(16 * w + fr) * N_IN + C_Q + h * HD + 8 * fq;
#pragma unroll
      for (int t = 0; t < 4; ++t) qf[t] = *(const bf16x8*)(qp + 32 * t); }
    u32x2 gvv[8];
    { const bf16* G = ZB + (size_t)(16 * w + fr) * N_IN + C_G + h * HD + 4 * fq;
#pragma unroll
      for (int eb = 0; eb < 8; ++eb) gvv[eb] = *(const u32x2*)(G + 16 * eb); }
#pragma unroll
    for (int q = 0; q < 4; ++q) { const int o = (r + 32 * q) * TP + sg * 16; *(LAS u32x4*)(Kt + o) = pf[q]; *(LAS u32x4*)(VT + o) = pf[4 + q]; }
    __syncthreads();
    if (has_next) ret_tiles_load(F, nc, nh, pf);
    ret_core(F, l, c, h, l2f, l2b, qf, gvv);
}
template <int R, int C, int WR, int WC, int KC>
__device__ __forceinline__ void skinny_acc(Frame& F, f32x4 (&acc)[WR][WC], const bf16* A, int lda, const bf16* Bt, int ldb, int K) {
    constexpr int PITCH = KC * 2 + 16, SEGS = KC / 8, PIECES = (R + C) * SEGS, PPT = PIECES / 512, STAGE = (R + C) * PITCH, WGC = C / 16 / WC;
    static_assert(PIECES % 512 == 0 && (R / 16 / WR) * WGC == 8 && 2 * STAGE <= SCR_BYTES, "skinny geometry");
    const int tid = F.tid, fr = F.lane & 15, fq = F.lane >> 4, wgr = F.wave / WGC, wgc = F.wave % WGC;
    u32x4 rg0[PPT], rg1[PPT];
    const bf16* src[PPT]; int dst[PPT];
#pragma unroll
    for (int q = 0; q < PPT; ++q) { const int p = tid + 512 * q, row = p / SEGS, sg = p % SEGS;
        src[q] = row < R ? A + (size_t)row * lda + sg * 8 : Bt + (size_t)(row - R) * ldb + sg * 8; dst[q] = row * PITCH + sg * 16; }
#define SK_GLOAD(rg, k0) do { _Pragma("unroll") for (int q = 0; q < PPT; ++q) rg[q] = *(const u32x4*)(src[q] + (k0)); } while (0)
#define SK_LSTORE(rg, buf) do { _Pragma("unroll") for (int q = 0; q < PPT; ++q) *(LAS u32x4*)(F.lds + (buf) * STAGE + dst[q]) = rg[q]; } while (0)
#define SK_COMPUTE(buf) do { const LAS unsigned char* bA = F.lds + (buf) * STAGE; const LAS unsigned char* bB = bA + R * PITCH; \
        _Pragma("unroll") for (int t = 0; t < KC / 32; ++t) { bf16x8 af[WR], bfr[WC]; \
            _Pragma("unroll") for (int i = 0; i < WR; ++i) af[i] = *(const LAS bf16x8*)(bA + (16 * (wgr * WR + i) + fr) * PITCH + (32 * t + 8 * fq) * 2); \
            _Pragma("unroll") for (int j = 0; j < WC; ++j) bfr[j] = *(const LAS bf16x8*)(bB + (16 * (wgc * WC + j) + fr) * PITCH + (32 * t + 8 * fq) * 2); \
            _Pragma("unroll") for (int i = 0; i < WR; ++i) _Pragma("unroll") for (int j = 0; j < WC; ++j) acc[i][j] = MFMA16(bfr[j], af[i], acc[i][j]); } } while (0)
    const int nch = K / KC;
    __syncthreads();
    SK_GLOAD(rg0, 0); SK_GLOAD(rg1, KC);
    for (int ch = 0; ch < nch; ch += 2) {
        SK_LSTORE(rg0, 0); __syncthreads();
        if (ch + 2 < nch) SK_GLOAD(rg0, (ch + 2) * KC);
        SK_COMPUTE(0);
        SK_LSTORE(rg1, 1); __syncthreads();
        if (ch + 3 < nch) SK_GLOAD(rg1, (ch + 3) * KC);
        SK_COMPUTE(1);
    }
#undef SK_GLOAD
#undef SK_LSTORE
#undef SK_COMPUTE
}
template <int MODE>
__device__ __forceinline__ void ctx_n2048(Frame& F, int l, const bf16* A, const bf16* Bt, int gi, float dry) {
    if (F.G != 256) return;
    constexpr int AP = D * 2 + 16, PART = 32 * AP;
    static_assert(PART + 8 * 64 * 16 <= SCR_BYTES, "ctx_n2048 LDS");
    const int r0 = 32 * (F.bid >> 5), c0 = 64 * (F.bid & 31), fr = F.lane & 15, fq = F.lane >> 4, j = F.wave & 3, kh = F.wave >> 2, tid = F.tid;
    u32x4 av[16];
#pragma unroll
    for (int q = 0; q < 16; ++q) { const int p = tid + 512 * q; av[q] = *(const u32x4*)(A + (size_t)(r0 + (p >> 8)) * D + (p & 255) * 8); }
    const bf16* bp = Bt + (size_t)(c0 + 16 * j + fr) * D + 1024 * kh + 8 * fq;
    bf16x8 bfv[32];
#pragma unroll
    for (int t = 0; t < 16; ++t) bfv[t] = *(const bf16x8*)(bp + 32 * t);
    const int col = c0 + 16 * j + 4 * fq;
    unsigned g0[2], g1[2]; u32x2 xo[2]; f32x4 gt = (f32x4){0.f, 0.f, 0.f, 0.f};
#pragma unroll
    for (int i = 0; i < 2; ++i) { const int row = r0 + 16 * i + fr;
        if (MODE == 0) { const unsigned char* gp = (const unsigned char*)(F.ws + WS_ZB) + (size_t)row * (N_IN * 2) + 2 * C_GATE + col;
            g0[i] = *(const unsigned*)(gp + kh * D); g1[i] = *(const unsigned*)(gp + 2 * kh * D); }
        else xo[i] = *(const u32x2*)((const bf16*)(F.ws + WS_X) + (size_t)row * D + col); }
    if (MODE == 1) gt = *(const f32x4*)((const float*)(F.ws + WS_MOD) + ((size_t)l * 2 + 0) * 6 * D + gi * D + col) * dry;
    __syncthreads();
#pragma unroll
    for (int q = 0; q < 16; ++q) { const int p = tid + 512 * q; *(LAS u32x4*)(F.lds + (p >> 8) * AP + (p & 255) * 16) = av[q]; }
#pragma unroll
    for (int t = 16; t < 32; ++t) bfv[t] = *(const bf16x8*)(bp + 32 * t);
    __syncthreads();
    f32x4 acc[2][2];
#pragma unroll
    for (int s2 = 0; s2 < 2; ++s2)
#pragma unroll
        for (int i = 0; i < 2; ++i) acc[s2][i] = (f32x4){0.f, 0.f, 0.f, 0.f};
    const LAS unsigned char* ap = F.lds + fr * AP + (1024 * kh + 8 * fq) * 2;
#pragma unroll
    for (int t = 0; t < 32; ++t) { const int s2 = (MODE == 0 && t >= 16) ? 1 : 0;
        const bf16x8 a0 = *(const LAS bf16x8*)(ap + 64 * t), a1 = *(const LAS bf16x8*)(ap + 16 * AP + 64 * t);
        acc[s2][0] = MFMA16(bfv[t], a0, acc[s2][0]); acc[s2][1] = MFMA16(bfv[t], a1, acc[s2][1]); }
    f32x4 y[2];
#pragma unroll
    for (int i = 0; i < 2; ++i) {
        if (MODE == 0) {
#pragma unroll
            for (int e = 0; e < 4; ++e) y[i][e] = (acc[0][i][e] * (float)((g0[i] >> (8 * e)) & 255u) + acc[1][i][e] * (float)((g1[i] >> (8 * e)) & 255u)) * (1.f / 255.f);
        } else y[i] = acc[0][i];
    }
    LAS f32x4* part = (LAS f32x4*)(F.lds + PART);
    if (kh == 1) { part[(j * 2 + 0) * 64 + F.lane] = y[0]; part[(j * 2 + 1) * 64 + F.lane] = y[1]; }
    __syncthreads();
    if (kh == 0) {
#pragma unroll
        for (int i = 0; i < 2; ++i) { const int row = r0 + 16 * i + fr; const f32x4 v = y[i] + part[(j * 2 + i) * 64 + F.lane];
            if (MODE == 0) { u32x2 o; o.x = cvt_pk_bf16(v[0], v[1]); o.y = cvt_pk_bf16(v[2], v[3]); *(u32x2*)((bf16*)(F.ws + WS_Y) + (size_t)row * D + col) = o; }
            else { const f32x4 d = gt * v; u32x2 xn; xn.x = cvt_pk_bf16(bflo(xo[i].x) + d[0], bfhi(xo[i].x) + d[1]); xn.y = cvt_pk_bf16(bflo(xo[i].y) + d[2], bfhi(xo[i].y) + d[3]);
                *(u32x2*)((bf16*)(F.ws + WS_X) + (size_t)row * D + col) = xn; }
        }
    }
    __syncthreads();
}
__device__ __forceinline__ void ctx_up(Frame& F, const bf16* Bt) {
    if (F.G != 256) return;
    const int r0 = 64 * (F.bid >> 6), c0 = 128 * (F.bid & 63), fr = F.lane & 15, fq = F.lane >> 4, wgr = F.wave >> 2, wgc = F.wave & 3;
    f32x4 acc[2][2];
#pragma unroll
    for (int i = 0; i < 2; ++i)
#pragma unroll
        for (int j = 0; j < 2; ++j) acc[i][j] = (f32x4){0.f, 0.f, 0.f, 0.f};
    skinny_acc<64, 128, 2, 2, 128>(F, acc, (const bf16*)(F.ws + WS_H) + (size_t)r0 * D, D, Bt + (size_t)c0 * D, D, D);
#pragma unroll
    for (int i = 0; i < 2; ++i)
#pragma unroll
        for (int j = 0; j < 2; ++j) { const int row = r0 + 16 * (wgr * 2 + i) + fr, col = c0 + 16 * (wgc * 2 + j) + 4 * fq; f32x4 a = acc[i][j];
#pragma unroll
            for (int q = 0; q < 4; ++q) { const float x = fmaxf(a[q], 0.f); a[q] = x * x; }
            u32x2 o; o.x = cvt_pk_bf16(a[0], a[1]); o.y = cvt_pk_bf16(a[2], a[3]);
            *(u32x2*)((bf16*)(F.ws + WS_A1) + (size_t)row * DFF + col) = o; }
}

__device__ __forceinline__ void ctx_down_splitk(Frame& F, const bf16* Bt) {
    if (F.G != 256) return;
    const int ks = F.bid >> 6, r0 = 64 * ((F.bid >> 4) & 3), c0 = 128 * (F.bid & 15), fr = F.lane & 15, fq = F.lane >> 4, wgr = F.wave >> 2, wgc = F.wave & 3;
    f32x4 acc[2][2];
#pragma unroll
    for (int i = 0; i < 2; ++i)
#pragma unroll
        for (int j = 0; j < 2; ++j) acc[i][j] = (f32x4){0.f, 0.f, 0.f, 0.f};
    skinny_acc<64, 128, 2, 2, 128>(F, acc, (const bf16*)(F.ws + WS_A1) + (size_t)r0 * DFF + ks * 2048, DFF, Bt + (size_t)c0 * DFF + ks * 2048, DFF, 2048);
    float* SL = (float*)(F.ws + WS_SLAB) + (size_t)ks * CTX * D;
#pragma unroll
    for (int i = 0; i < 2; ++i)
#pragma unroll
        for (int j = 0; j < 2; ++j) { const int row = r0 + 16 * (wgr * 2 + i) + fr, col = c0 + 16 * (wgc * 2 + j) + 4 * fq; *(f32x4*)(SL + (size_t)row * D + col) = acc[i][j]; }
}

constexpr int PH_PER_LAYER = 10, PH_PRE = 3, N_PHASES = PH_PRE + DEPTH * PH_PER_LAYER;
__global__ void __launch_bounds__(512, 2) mk_fwd(Args args) {
    extern __shared__ __attribute__((aligned(16))) unsigned char lds_raw[];
    LAS unsigned char* const ldsb = (LAS unsigned char*)lds_raw;
    volatile LAS unsigned* MISC = (volatile LAS unsigned*)(ldsb + MISC_OFF);
    for (int u = threadIdx.x; u < 64; u += 512) MISC[u] = 0u;
    __syncthreads();
    unsigned* barw = (unsigned*)(args.ws + WS_BAR);
    XcdBarrier bar; bar.bar = barw; bar.x = 0; bar.st = MISC + 8;
    if (!MK_SPLIT) bar = xcd_barrier_post(barw, MISC + 8);
    const int lo = args.ph_lo, hi = args.ph_hi;
#define IN(k) (lo <= (k) && (k) < hi)
#define SEAM(k) do { if (IN((k) + 1)) xcd_barrier(bar); } while (0)
#define MODP(F) ((const float*)((F).ws + WS_MOD))

    if (IN(0) && (PMASK & 1)) { for (int rep = 0; rep < ((DUP >> 12) & 1) + 1; ++rep) { Frame F; make_frame(F, ldsb); p0_prologue(F); __syncthreads(); } SEAM(0); }
    if (IN(1) && (PMASK & 1)) { Frame F; make_frame(F, ldsb); mod_reduce_phase(F); SEAM(1); }
    if (IN(2) && (PMASK & 2)) { Frame F; make_frame(F, ldsb); norm_phase(F, F.in[I_N1G], MODP(F), 0, true); SEAM(2); }

    for (int l = 0; l < DEPTH; ++l) {
        const int pb = PH_PRE + l * PH_PER_LAYER;
        if (IN(pb + 0) && (PMASK & 4)) for (int rep = 0; rep < ((DUP >> 0) & 1) + 1; ++rep) {
            Frame F; make_frame(F, ldsb);
            pg8::GemmSched S; S.T.init(MROWS / 256, N_IN / 256, F.G, F.bid); S.A = (const char*)(F.ws + WS_H); S.B = (const char*)(F.ws + WS_WIN + l * SZ_WIN);
            S.a_tile = (size_t)256 * D * 2; S.b_tile = (size_t)256 * D * 2; S.nt = D / 64; S.pm0 = 0;
            EpiInProj E{(bf16*)(F.ws + WS_ZB), (const float*)(F.ws + WS_ROPE)};
            pg8::gemm_phase(F.lds, F.tid, D, D, S, E);
            SEAM(pb + 0);
        }
        if (IN(pb + 1) && (PMASK & 8)) for (int rep = 0; rep < ((DUP >> 1) & 1) + 1; ++rep) {
            Frame F; make_frame(F, ldsb);
            constexpr int N_KV = NCHUNK * RET_H, N_PG = (NCHUNK - 4) * 4;
            for (int it = F.bid; it < N_KV + 2 * N_PG; it += F.G) {
                if (it < N_KV) kv_item(F, l, it / RET_H, it % RET_H);
                else if (it < N_KV + N_PG) { const int r = it - N_KV + 16; pool_item(F, l, r >> 2, r & 3); }
                else { const int r = it - N_KV - N_PG + 16; sg_item(F, l, r >> 2, r & 3); }
            }
            SEAM(pb + 1);
        }
        if (IN(pb + 2) && (PMASK & 16)) for (int rep = 0; rep < ((DUP >> 2) & 1) + 1; ++rep) { Frame F; make_frame(F, ldsb);
            const bool ctx_live = l + 1 < DEPTH;
            const int nctx = ctx_live ? 2 * RET_H : 0, ndef = ctx_live ? 32 : 16;
            if (F.bid < nctx) ret_item<true>(F, l, F.bid >> 3, F.bid & 7);
            else if (F.bid < nctx + ndef) { const int j = F.bid - nctx, d = ctx_live ? j : (j < 8 ? 8 + j : 16 + j);
                if (d < 16) pool_item(F, l, d >> 2, d & 3); else sg_item(F, l, (d - 16) >> 2, d & 3); }
            scan_phase(F, l, nctx + ndef); SEAM(pb + 2); }
        if (IN(pb + 3) && (PMASK & 32)) for (int rep = 0; rep < ((DUP >> 3) & 1) + 1; ++rep) {
            Frame F; make_frame(F, ldsb);
            constexpr int N_RET = SEQ / 128 * RET_H;
            if (F.bid < N_RET) { u32x4 pf[8]; { const int itx = 2 * RET_H + F.bid; ret_tiles_load(F, itx / RET_H, itx % RET_H, pf); }
                for (int it = F.bid; it < N_RET; it += F.G) { const int itx = 2 * RET_H + it, nx = itx + F.G; ret_item_pipe(F, l, itx / RET_H, itx % RET_H, pf, nx / RET_H, nx % RET_H, it + F.G < N_RET); } }
            SEAM(pb + 3);
        }
        if (IN(pb + 4) && (PMASK & 64)) for (int rep = 0; rep < ((DUP >> 4) & 1) + 1; ++rep) {
            Frame F; make_frame(F, ldsb);
            pg8::BranchSched S; S.T.init(SEQ / 256, D / 256, F.G, F.bid); S.A = (const char*)(F.ws + WS_MIX); S.B = (const char*)(F.ws + WS_WCAT + l * SZ_WSQ);
            S.a_tile = (size_t)256 * D * 2; S.b_tile = (size_t)256 * D * 2; S.pm0 = 1;
            EpiBranch E{(const bf16*)(F.ws + WS_ZB), (bf16*)(F.ws + WS_Y)};
            pg8::gemm_phase(F.lds, F.tid, D, D, S, E);
            if (l + 1 < DEPTH) ctx_n2048<0>(F, l, (const bf16*)(F.ws + WS_MIX), (const bf16*)(F.ws + WS_WCAT + l * SZ_WSQ), 0, 1.f);
            SEAM(pb + 4);
        }
        if (IN(pb + 5) && (PMASK & 128)) for (int rep = 0; rep < ((DUP >> 5) & 1) + 1; ++rep) {
            Frame F; make_frame(F, ldsb);
            pg8::GemmSched S; S.T.init(SEQ / 256, D / 256, F.G, F.bid); S.A = (const char*)(F.ws + WS_Y); S.B = (const char*)(F.ws + WS_WOUT + l * SZ_WSQ);
            S.a_tile = (size_t)256 * D * 2; S.b_tile = (size_t)256 * D * 2; S.nt = D / 64; S.pm0 = 1;
            if (l + 1 < DEPTH || !FUSE_FINAL) {
                EpiResid E{(bf16*)(F.ws + WS_X), MODP(F) + (size_t)l * 2 * 6 * D, 2, rep ? 0.f : 1.f};
                pg8::gemm_phase(F.lds, F.tid, D, D, S, E);
                if (l + 1 < DEPTH) ctx_n2048<1>(F, l, (const bf16*)(F.ws + WS_Y), (const bf16*)(F.ws + WS_WOUT + l * SZ_WSQ), 2, rep ? 0.f : 1.f);
            } else {
                const float* ml = MODP(F) + (size_t)l * 2 * 6 * D;
                EpiResidNorm<false> E{(bf16*)(F.ws + WS_X), ml, 2, F.in[I_N2G] + (size_t)l * D, nullptr, (unsigned*)(F.ws + WS_XCH), (unsigned*)(F.ws + WS_CNT), F.lds + 131072, 64u, (bf16*)(F.ws + WS_H), ml + 6 * D + 4 * D, ml + 6 * D + 3 * D};
                pg8::gemm_phase(F.lds, F.tid, D, D, S, E);
            }
            SEAM(pb + 5);
        }
        if (IN(pb + 6) && (PMASK & 256) && (l + 1 < DEPTH || !FUSE_FINAL)) for (int rep = 0; rep < ((DUP >> 6) & 1) + 1; ++rep) { Frame F; make_frame(F, ldsb); norm_phase(F, F.in[I_N2G] + (size_t)l * D, MODP(F) + (size_t)l * 2 * 6 * D, 3, false); SEAM(pb + 6); }
        if (IN(pb + 7) && (PMASK & 512)) for (int rep = 0; rep < ((DUP >> 7) & 1) + 1; ++rep) {
            Frame F; make_frame(F, ldsb);
            pg8::GemmSched S; S.T.init(SEQ / 256, DFF / 256, F.G, F.bid); S.A = (const char*)(F.ws + WS_H); S.B = (const char*)(F.ws + WS_W1 + l * SZ_WFF);
            S.a_tile = (size_t)256 * D * 2; S.b_tile = (size_t)256 * D * 2; S.nt = D / 64; S.pm0 = 1;
            EpiRelu2 E{(bf16*)(F.ws + WS_A1)};
            pg8::gemm_phase(F.lds, F.tid, D, D, S, E);
            if (l + 1 < DEPTH) ctx_up(F, (const bf16*)(F.ws + WS_W1 + l * SZ_WFF));
            SEAM(pb + 7);
        }
        if (IN(pb + 8) && (PMASK & 1024)) for (int rep = 0; rep < ((DUP >> 8) & 1) + 1; ++rep) {
            Frame F; make_frame(F, ldsb);
            pg8::GemmSched S; S.T.init(SEQ / 256, D / 256, F.G, F.bid); S.A = (const char*)(F.ws + WS_A1); S.B = (const char*)(F.ws + WS_W2 + l * SZ_WFF);
            S.a_tile = (size_t)256 * DFF * 2; S.b_tile = (size_t)256 * DFF * 2; S.nt = DFF / 64; S.pm0 = 1;
            if (l + 1 < DEPTH) {
                EpiResid E{(bf16*)(F.ws + WS_X), MODP(F) + (size_t)l * 2 * 6 * D, 5, rep ? 0.f : 1.f};
                pg8::gemm_phase(F.lds, F.tid, DFF, DFF, S, E);
                ctx_down_splitk(F, (const bf16*)(F.ws + WS_W2 + l * SZ_WFF));
            } else {
                EpiResidNorm<true> E{(bf16*)(F.ws + WS_X), MODP(F) + (size_t)l * 2 * 6 * D, 5, F.in[I_FNG], ((KArgs)__builtin_amdgcn_kernarg_segment_ptr())->out, (unsigned*)(F.ws + WS_XCH), (unsigned*)(F.ws + WS_CNT), F.lds + 131072, 128u, nullptr, nullptr, nullptr};
                pg8::gemm_phase(F.lds, F.tid, DFF, DFF, S, E);
            }
            if (l + 1 < DEPTH || !FUSE_FINAL) SEAM(pb + 8);
        }
        if (IN(pb + 9) && (PMASK & 2048)) for (int rep = 0; rep < ((DUP >> 9) & 1) + 1; ++rep) {
            Frame F; make_frame(F, ldsb);
            if (l + 1 < DEPTH) { norm_phase(F, F.in[I_N1G] + (size_t)(l + 1) * D, MODP(F) + (size_t)(l + 1) * 2 * 6 * D, 0, false, MODP(F) + (size_t)l * 2 * 6 * D + 5 * D); SEAM(pb + 9); }
            else final_norm_phase(F, ((KArgs)__builtin_amdgcn_kernarg_segment_ptr())->out);
        }
    }
#undef IN
#undef SEAM
}

extern "C" void kernel_launch(void* const* d_in, const int* in_sizes, int n_in, void* d_out, int out_size, void* d_ws, size_t ws_size, hipStream_t stream) {
    static int grid = 0;
    if (grid == 0) {
        if (n_in != 23 || out_size != SEQ * D || ws_size < WS_END) { fprintf(stderr, "kernel_launch: unexpected problem (n_in %d, out %d, ws %zu < %zu)\n", n_in, out_size, ws_size, (size_t)WS_END); grid = -1; return; }
        int dev = 0, cus = 0, per_cu = 0;
        if (hipGetDevice(&dev) != hipSuccess || hipDeviceGetAttribute(&cus, hipDeviceAttributeMultiprocessorCount, dev) != hipSuccess) { grid = -1; return; }
        if (hipFuncSetAttribute((const void*)mk_fwd, hipFuncAttributeMaxDynamicSharedMemorySize, LDS_BYTES) != hipSuccess) { fprintf(stderr, "kernel_launch: hipFuncSetAttribute failed\n"); grid = -1; return; }
        if (hipOccupancyMaxActiveBlocksPerMultiprocessor(&per_cu, (const void*)mk_fwd, 512, LDS_BYTES) != hipSuccess || per_cu < 1) { fprintf(stderr, "kernel_launch: occupancy query reports %d blocks per CU\n", per_cu); (void)hipGetLastError(); grid = -1; return; }
        grid = cus;
    }
    if (grid < 0) return;
    if (hipMemsetAsync((char*)d_ws + WS_CTL, 0, CTL_ZERO_BYTES, stream) != hipSuccess) return;
    Args a{};
    for (int i = 0; i < 23; ++i) a.in[i] = (const float*)d_in[i];
    a.out = (float*)d_out; a.ws = (unsigned char*)d_ws;
#if MK_SPLIT
    for (int p = 0; p < N_PHASES; ++p) { a.ph_lo = p; a.ph_hi = p + 1; hipLaunchKernelGGL(mk_fwd, dim3(grid), dim3(512), LDS_BYTES, stream, a); }
#else
    a.ph_lo = 0; a.ph_hi = N_PHASES;
    hipLaunchKernelGGL(mk_fwd, dim3(grid), dim3(512), LDS_BYTES, stream, a);
#endif
}
```

```cpp
#include <hip/hip_runtime.h>
#include <cstdio>
#include <cstdint>

#ifndef PMASK
#define PMASK 0xFFFF
#endif
#ifndef DUP
#define DUP 0
#endif
#ifndef MK_SPLIT
#define MK_SPLIT 0
#endif

constexpr int D = 2048, SEQ = 8192, CTX = 256, DEPTH = 4, GRID_W = 64;
constexpr int MROWS = CTX + SEQ;
constexpr int NCHUNK = MROWS / 128;
constexpr int RET_W = 1024, RET_H = 8, HD = 128;
constexpr int POOL_W = 512, SG_W = 512, DFF = 8192;
constexpr int N_IN = 4 * RET_W + POOL_W + 2 * SG_W + 3 * D;
constexpr int C_Q = 0, C_K = 1024, C_V = 2048, C_G = 3072, C_P = 4096, C_U = 4608, C_SV = 5120, C_GATE = 5632;
constexpr float EPS = 1e-6f;
constexpr float K_SCALE = 0.08838834764831845f;
constexpr float LOG2E = 1.4426950408889634f;

#define LAS __attribute__((address_space(3)))
#define GAS __attribute__((address_space(1)))
typedef unsigned short bf16;
typedef short bf16x8 __attribute__((ext_vector_type(8)));
typedef short bf16x4 __attribute__((ext_vector_type(4)));
typedef float f32x4 __attribute__((ext_vector_type(4)));
typedef float f32x2 __attribute__((ext_vector_type(2)));
typedef unsigned u32x4 __attribute__((ext_vector_type(4)));
typedef unsigned u32x2 __attribute__((ext_vector_type(2)));

__device__ __forceinline__ unsigned f2bf(float f) { unsigned u = __builtin_bit_cast(unsigned, f); return (u + 0x7fffu + ((u >> 16) & 1u)) >> 16; }
__device__ __forceinline__ unsigned pk2(float lo, float hi) { return f2bf(lo) | (f2bf(hi) << 16); }
__device__ __forceinline__ unsigned cvt_pk_bf16(float lo, float hi) { unsigned r; asm volatile("v_cvt_pk_bf16_f32 %0, %1, %2" : "=v"(r) : "v"(lo), "v"(hi)); return r; }
__device__ __forceinline__ float bflo(unsigned w) { return __uint_as_float(w << 16); }
__device__ __forceinline__ float bfhi(unsigned w) { return __uint_as_float(w & 0xffff0000u); }
__device__ __forceinline__ float silu_f(float x) { return x * __builtin_amdgcn_rcpf(1.f + __expf(-x)); }
__device__ __forceinline__ float gelu_tanh_f(float x) { const float u = 1.5957691216057308f * (x + 0.044715f * x * x * x); return x * __builtin_amdgcn_rcpf(1.f + __expf(-u)); }
__device__ __forceinline__ float log_sigmoid_f(float x) { return x >= 0.f ? -log1pf(expf(-x)) : x - log1pf(expf(x)); }
__device__ __forceinline__ float wave_sum(float v) {
#pragma unroll
    for (int o = 1; o < 64; o <<= 1) v += __shfl_xor(v, o);
    return v;
}
#define LDS_WAIT() asm volatile("s_waitcnt lgkmcnt(0)" ::: "memory")
#define VM_WAIT() asm volatile("s_waitcnt vmcnt(0)" ::: "memory")

namespace pg8 {
constexpr int BM = 256, BK = 64, HALF = 128, HTB = HALF * BK * 2  , STAGE_BYTES = 8 * HTB, NXCD = 8, WGM = 8;
__host__ __device__ __forceinline__ int lds_byte(int r, int c) { const int st = (r >> 4) * 2 + (c >> 5), rr = r & 15, cc = c & 31, ob = rr * 64 + cc * 2; return st * 1024 + (ob ^ (((ob >> 9) & 1) << 5)); }
__host__ __device__ __forceinline__ void stage_rc(int b, int& R, int& C) { const int st = b / 1024, sb = b % 1024, swz = sb ^ (((sb >> 9) & 1) << 5); R = (st >> 1) * 16 + swz / 64; C = (st & 1) * 32 + (swz % 64) / 2; }
__host__ __device__ __forceinline__ int perm32(int rho) { const int n = rho >> 4, i = rho & 15; return 8 * (i >> 2) + 4 * n + (i & 3); }

struct Unit { const char* A; const char* B; int nt, pm, pn, kind; };

struct TileOrder {
    int nM, nN, nwg, G, c;
    __device__ void init(int nM_, int nN_, int G_, int c_) { nM = nM_; nN = nN_; nwg = nM * nN; G = G_; c = c_; }
    __device__ bool tile(int i, int& pm, int& pn) const {
        const long L = (long)i * G + c; if (L >= nwg) return false;
        int wgid = (int)L; { const int q = nwg / NXCD, r = nwg % NXCD, xcd = wgid % NXCD, off = wgid / NXCD; wgid = (xcd < r ? xcd * (q + 1) : r * (q + 1) + (xcd - r) * q) + off; }
        const int nig = WGM * nN, gid = wgid / nig, fm = gid * WGM, gsz = (nM - fm) < WGM ? (nM - fm) : WGM;
        pm = fm + ((wgid % nig) % gsz); pn = (wgid % nig) / gsz; return true;
    }
};
struct GemmSched {
    TileOrder T; const char* A; const char* B; size_t a_tile, b_tile; int nt, pm0;
    __device__ __forceinline__ bool next(int i, Unit& u) const { int pm, pn; if (!T.tile(i, pm, pn)) return false; pm += pm0; u.A = A + (size_t)pm * a_tile; u.B = B + (size_t)pn * b_tile; u.nt = nt; u.pm = pm; u.pn = pn; u.kind = 0; return true; }
};
struct BranchSched {
    TileOrder T; const char* A; const char* B; size_t a_tile, b_tile; int pm0;
    __device__ __forceinline__ bool next(int i, Unit& u) const { int pm, pn; const int ti = i / 3, seg = i - 3 * ti; if (!T.tile(ti, pm, pn)) return false; pm += pm0;
        const int koff = seg == 0 ? 0 : (seg == 1 ? 1024 : 1536);
        u.A = A + (size_t)pm * a_tile + koff * 2; u.B = B + (size_t)pn * b_tile + koff * 2; u.nt = seg == 0 ? 16 : 8; u.pm = pm; u.pn = pn; u.kind = seg; return true; }
};

template <class Epi, class Sched>
__device__ __forceinline__ void gemm_phase(LAS unsigned char* lds, const int tid, const int lda, const int ldb, const Sched& S, const Epi& E) {
    const int wid = __builtin_amdgcn_readfirstlane(tid >> 6), lane = tid & 63, wr = wid >> 2, wc = wid & 3, fr = lane & 15, fq = lane >> 4;
    unsigned voffA[2], voffB[2];
#pragma unroll
    for (int i = 0; i < 2; ++i) { int R, C; stage_rc(tid * 16 + i * 8192, R, C); const int Rb = Epi::PERM ? (64 * (R >> 5) + perm32(R & 31)) : R;
        voffA[i] = (unsigned)(R * lda + C) * 2u; voffB[i] = (unsigned)(Rb * ldb + C) * 2u; }
    const size_t kstep = (size_t)(BK * 2);
    const size_t hstepA = (size_t)HALF * lda * 2, hstepB = (size_t)(Epi::PERM ? 32 : HALF) * ldb * 2;
    const unsigned ldsw = (unsigned)wid * 1024u;
    const int aoff = lds_byte(wr * 64 + fr, fq * 8), boff = lds_byte(wc * 32 + fr, fq * 8);
#define PG8_SA(b, h) (((b) * 2 + (h)) * HTB)
#define PG8_SB(b, h) ((4 + (b) * 2 + (h)) * HTB)
#define PG8_STAGE(bufoff, gbase, voff) do { _Pragma("unroll") for (int _i = 0; _i < 2; ++_i) \
        __builtin_amdgcn_global_load_lds((const unsigned*)((const char*)(gbase) + (voff)[_i]), (LAS unsigned*)(lds + (bufoff) + ldsw + _i * 8192), 16, 0, 0); } while (0)
#define PG8_LDA(dst, b, h) do { _Pragma("unroll") for (int m = 0; m < 4; ++m) _Pragma("unroll") for (int k = 0; k < 2; ++k) dst[m][k] = *(const LAS bf16x8*)(lds + PG8_SA(b, h) + aoff + m * 2048 + k * 1024); } while (0)
#define PG8_LDB(dst, b, h) do { _Pragma("unroll") for (int n = 0; n < 2; ++n) _Pragma("unroll") for (int k = 0; k < 2; ++k) dst[n][k] = *(const LAS bf16x8*)(lds + PG8_SB(b, h) + boff + n * 2048 + k * 1024); } while (0)
#define PG8_MMA(ai, bj, At, Bt) do { __builtin_amdgcn_s_setprio(1); _Pragma("unroll") for (int m = 0; m < 4; ++m) _Pragma("unroll") for (int n = 0; n < 2; ++n) _Pragma("unroll") for (int k = 0; k < 2; ++k) \
        acc[ai][bj][m][n] = __builtin_amdgcn_mfma_f32_16x16x32_bf16(Bt[n][k], At[m][k], acc[ai][bj][m][n], 0, 0, 0); __builtin_amdgcn_s_setprio(0); } while (0)
#define PG8_WAIT_V(n) asm volatile("s_waitcnt vmcnt(" #n ")" ::: "memory")
#define PG8_WAIT_L(n) asm volatile("s_waitcnt lgkmcnt(" #n ")" ::: "memory")
#define PG8_BAR __builtin_amdgcn_s_barrier()
#define PG8_SCHED __builtin_amdgcn_sched_barrier(0)
    Unit cur, nxt; int ui = 0;
    if (!S.next(0, cur)) return;
    f32x4 acc[2][2][4][2];
#pragma unroll
    for (int a = 0; a < 2; ++a)
#pragma unroll
        for (int b = 0; b < 2; ++b)
#pragma unroll
            for (int m = 0; m < 4; ++m)
#pragma unroll
                for (int n = 0; n < 2; ++n) acc[a][b][m][n] = (f32x4){0.f, 0.f, 0.f, 0.f};
    bf16x8 At[4][2], B0[2][2], B1[2][2];
    const char* cA = cur.A; const char* cB = cur.B;
    PG8_STAGE(PG8_SB(0, 0), cB, voffB); PG8_STAGE(PG8_SB(0, 1), cB + hstepB, voffB); PG8_STAGE(PG8_SA(0, 0), cA, voffA); PG8_STAGE(PG8_SA(0, 1), cA + hstepA, voffA);
    if (wr == 1) PG8_BAR;
    PG8_WAIT_V(2); PG8_BAR;
    PG8_STAGE(PG8_SB(1, 0), cB + kstep, voffB); PG8_STAGE(PG8_SA(1, 0), cA + kstep, voffA); PG8_STAGE(PG8_SB(1, 1), cB + hstepB + kstep, voffB);
    PG8_WAIT_V(6); PG8_BAR;
    for (;;) {
        const bool has_next = S.next(ui + 1, nxt);
        const char* nA = has_next ? nxt.A : cA; const char* nB = has_next ? nxt.B : cB;
        const int nt = cur.nt;
        for (int t = 0; t < nt; t += 2) {
            const bool last = (t == nt - 2);
            const char* a1 = cA + (size_t)(t + 1) * kstep;
            const char* a2 = last ? nA : cA + (size_t)(t + 2) * kstep; const char* b2 = last ? nB : cB + (size_t)(t + 2) * kstep;
            const char* a3 = a2 + kstep; const char* b3 = b2 + kstep;
            PG8_LDB(B0, 0, 0); PG8_LDB(B1, 0, 1); PG8_SCHED; PG8_LDA(At, 0, 0); PG8_STAGE(PG8_SA(1, 1), a1 + hstepA, voffA);
            PG8_WAIT_V(8); PG8_WAIT_L(0); PG8_BAR; PG8_MMA(0, 0, At, B0); PG8_MMA(0, 1, At, B1); PG8_BAR; PG8_SCHED;
            PG8_LDA(At, 0, 1); PG8_STAGE(PG8_SB(0, 0), b2, voffB); PG8_STAGE(PG8_SB(0, 1), b2 + hstepB, voffB); PG8_STAGE(PG8_SA(0, 0), a2, voffA);
            PG8_WAIT_V(8); PG8_WAIT_L(0); PG8_BAR; PG8_MMA(1, 0, At, B0); PG8_MMA(1, 1, At, B1); PG8_BAR; PG8_SCHED;
            PG8_LDB(B0, 1, 0); PG8_LDB(B1, 1, 1); PG8_SCHED; PG8_LDA(At, 1, 0); PG8_STAGE(PG8_SA(0, 1), a2 + hstepA, voffA);
            PG8_WAIT_V(8); PG8_WAIT_L(0); PG8_BAR; PG8_MMA(0, 0, At, B0); PG8_MMA(0, 1, At, B1); PG8_BAR; PG8_SCHED;
            PG8_LDA(At, 1, 1); PG8_STAGE(PG8_SB(1, 0), b3, voffB); PG8_STAGE(PG8_SB(1, 1), b3 + hstepB, voffB); PG8_STAGE(PG8_SA(1, 0), a3, voffA);
            PG8_WAIT_V(8); PG8_WAIT_L(0); PG8_BAR; PG8_MMA(1, 0, At, B0); PG8_MMA(1, 1, At, B1); PG8_BAR; PG8_SCHED;
        }
        if (wr == 0) PG8_BAR;
        E(acc, cur, wr, wc, fr, fq);
#if defined(EPI2)
        if (Epi::PROBE2) E(acc, cur, wr, wc, fr, fq);
#endif
        if (!has_next) break;
        if (!(Epi::KEEP && E.keep(cur))) {
#pragma unroll
            for (int a = 0; a < 2; ++a)
#pragma unroll
                for (int b = 0; b < 2; ++b)
#pragma unroll
                    for (int m = 0; m < 4; ++m)
#pragma unroll
                        for (int n = 0; n < 2; ++n) acc[a][b][m][n] = (f32x4){0.f, 0.f, 0.f, 0.f};
        }
        cur = nxt; cA = nA; cB = nB; ++ui;
        if (wr == 1) PG8_BAR;
    }
    PG8_WAIT_V(0);
    PG8_BAR;
#undef PG8_SA
#undef PG8_SB
#undef PG8_STAGE
#undef PG8_LDA
#undef PG8_LDB
#undef PG8_MMA
#undef PG8_WAIT_V
#undef PG8_WAIT_L
#undef PG8_BAR
#undef PG8_SCHED
}
}

constexpr size_t KiB = 1024, MiB = 1u << 20;
constexpr size_t WS_CTL = 0, CTL_ZERO_BYTES = 128 * KiB;
constexpr size_t WS_BAR = 64 * KiB;
constexpr size_t WS_MOD = 256 * KiB;
constexpr size_t WS_ROPE = 1 * MiB;
constexpr size_t WS_PWT = WS_ROPE + 64 * KiB;
constexpr size_t WS_SGW = WS_PWT + 512 * KiB;
constexpr size_t WS_WIN = 4 * MiB;
constexpr size_t SZ_WIN = (size_t)N_IN * D * 2;
constexpr size_t WS_WCAT = WS_WIN + DEPTH * SZ_WIN;
constexpr size_t SZ_WSQ = (size_t)D * D * 2;
constexpr size_t WS_WOUT = WS_WCAT + DEPTH * SZ_WSQ;
constexpr size_t WS_W1 = WS_WOUT + DEPTH * SZ_WSQ;
constexpr size_t SZ_WFF = (size_t)DFF * D * 2;
constexpr size_t WS_W2 = WS_W1 + DEPTH * SZ_WFF;
constexpr size_t WS_X = WS_W2 + DEPTH * SZ_WFF;
constexpr size_t WS_H = WS_X + (size_t)MROWS * D * 4;
constexpr size_t WS_ZB = WS_H + (size_t)MROWS * D * 2;
constexpr size_t WS_KVT = WS_ZB + (size_t)MROWS * N_IN * 2;
constexpr size_t WS_ST = WS_KVT + (size_t)NCHUNK * 16 * 16384 * 4;
constexpr size_t WS_MIX = WS_ST + (size_t)NCHUNK * 16 * 16384 * 2;
constexpr size_t WS_Y = WS_MIX + (size_t)MROWS * D * 2;
constexpr size_t WS_A1 = WS_Y + (size_t)MROWS * D * 2;
constexpr size_t WS_MODP = WS_A1 + (size_t)MROWS * DFF * 2;
constexpr size_t WS_SLAB = WS_MODP + (size_t)16 * DEPTH * 2 * 6 * D * 4;
constexpr size_t WS_XCH = WS_SLAB + (size_t)4 * CTX * D * 4;
constexpr size_t WS_END = WS_XCH + (size_t)MROWS * 8 * 4;
constexpr size_t WS_CNT = 0;

constexpr int SCR_BYTES = 147456;
constexpr int MISC_OFF = SCR_BYTES;
constexpr int LDS_BYTES = SCR_BYTES + 256;
constexpr int TP = 272;
constexpr int TILE_B = 128 * TP;

#define XB_TMO      128
#define XB_XCNT(j)  (256  + 64 * (j))
#define XB_XSUB(j)  (1280 + 64 * (j))
#define XB_XGEN(j)  (2304 + 64 * (j))
#define XB_TOP      3328
#define XB_TOPGEN   3392
#define XCD_BAR_WORDS 3456
#define XB_SPIN_CAP (1u << 18)
__device__ __forceinline__ unsigned xb_ld(unsigned* p)              { return __hip_atomic_load(p, __ATOMIC_RELAXED, __HIP_MEMORY_SCOPE_AGENT); }
__device__ __forceinline__ unsigned xb_add(unsigned* p, unsigned v) { return __hip_atomic_fetch_add(p, v, __ATOMIC_RELAXED, __HIP_MEMORY_SCOPE_AGENT); }
__device__ __forceinline__ unsigned xb_xcc_id() { return (unsigned)__builtin_amdgcn_s_getreg((3 << 11) | 20) & 0xFu; }
#define XB_SPIN(cond, bar) do { unsigned _sp = 0; while (cond) { __builtin_amdgcn_s_sleep(1); \
    if ((++_sp & 255u) == 0u) { if (xb_ld(&(bar)[XB_TMO])) break; if (_sp > XB_SPIN_CAP) { atomicAdd(&(bar)[XB_TMO], 1u); break; } } } } while (0)
struct XcdBarrier { unsigned* bar; unsigned x; volatile LAS unsigned* st; };
__device__ __forceinline__ XcdBarrier xcd_barrier_post(unsigned* bar, volatile LAS unsigned* st) {
    XcdBarrier b; b.bar = bar; b.x = xb_xcc_id(); b.st = st;
    if (threadIdx.x == 0) (void)xb_add(&bar[XB_XCNT(b.x)], 1u);
    return b;
}
__device__ __forceinline__ void xcd_barrier_complete(unsigned* bar, unsigned x, unsigned& nloc, unsigned& nx) {
    const unsigned G = gridDim.x * gridDim.y * gridDim.z;
    unsigned sum, cnt, mine, sp = 0u;
    for (;;) {
        sum = 0u; cnt = 0u; mine = 0u;
#pragma unroll
        for (unsigned j = 0; j < 16; ++j) { const unsigned c = xb_ld(&bar[XB_XCNT(j)]); sum += c; cnt += (c > 0u) ? 1u : 0u; mine = (j == x) ? c : mine; }
        if (sum == G) break;
        __builtin_amdgcn_s_sleep(1);
        if ((++sp & 255u) == 0u) { if (xb_ld(&bar[XB_TMO])) break; if (sp > XB_SPIN_CAP) { atomicAdd(&bar[XB_TMO], 1u); break; } }
    }
    nloc = mine > 0u ? mine : 1u; nx = cnt > 0u ? cnt : 1u;
}
__device__ __forceinline__ void xcd_barrier(const XcdBarrier& b) {
    asm volatile("s_waitcnt vmcnt(0)" ::: "memory");
    __syncthreads();
    if (threadIdx.x == 0) {
        unsigned* bar = b.bar;
        __builtin_amdgcn_s_waitcnt(0);
        unsigned nloc = b.st[0], nx = b.st[1];
        if (nloc == 0u) { xcd_barrier_complete(bar, b.x, nloc, nx); b.st[0] = nloc; b.st[1] = nx; }
        const unsigned old = xb_add(&bar[XB_XSUB(b.x)], 1u);
        const unsigned gen = old / nloc;
        if (old + 1u == (gen + 1u) * nloc) {
            __builtin_amdgcn_fence(__ATOMIC_RELEASE, "agent");
            asm volatile("s_waitcnt vmcnt(0)" ::: "memory");
            const unsigned og = xb_add(&bar[XB_TOP], 1u);
            const unsigned tg = og / nx;
            if (og + 1u == (tg + 1u) * nx) xb_add(&bar[XB_TOPGEN], 1u);
            else XB_SPIN(xb_ld(&bar[XB_TOPGEN]) == tg, bar);
            __builtin_amdgcn_fence(__ATOMIC_ACQUIRE, "agent");
            xb_add(&bar[XB_XGEN(b.x)], 1u);
            asm volatile("s_waitcnt vmcnt(0)" ::: "memory");
        } else {
            XB_SPIN(xb_ld(&bar[XB_XGEN(b.x)]) == gen, bar);
            __builtin_amdgcn_fence(__ATOMIC_ACQUIRE, "agent");
            asm volatile("s_waitcnt vmcnt(0)" ::: "memory");
        }
    }
    __syncthreads();
}

struct Args { const float* in[23]; float* out; unsigned char* ws; int ph_lo, ph_hi; };
typedef const __attribute__((address_space(4))) Args* KArgs;
struct Frame {
    LAS unsigned char* lds;
    int tid, lane, wave, G, bid;
    unsigned char* ws;
    const float* const __attribute__((address_space(4)))* in;
};
__device__ __forceinline__ void make_frame(Frame& F, LAS unsigned char* lds) {
    int t = threadIdx.x; asm volatile("" : "+v"(t));
    KArgs ka = (KArgs)__builtin_amdgcn_kernarg_segment_ptr(); asm volatile("" : "+s"(ka));
    F.lds = lds; F.tid = t; F.lane = t & 63; F.wave = __builtin_amdgcn_readfirstlane(t >> 6); { int g_ = gridDim.x, b_ = blockIdx.x; asm volatile("" : "+s"(g_), "+s"(b_)); F.G = g_; F.bid = b_; }
    F.ws = ka->ws; F.in = ka->in;
}
enum { I_X = 0, I_C, I_CTX, I_CCTX, I_WADA, I_BADA, I_N1G, I_WIN, I_RLOG, I_RNG, I_PW, I_PS, I_SGNG, I_SGW, I_SGB, I_WBR, I_WBP, I_WBS, I_WOUT, I_N2G, I_W1, I_W2, I_FNG };

using pg8::Unit; using pg8::BM; using pg8::HALF;
#if defined(EPI2)
#define P2(x) static constexpr bool PROBE2 = (EPI2 == x);
#else
#define P2(x)
#endif
struct EpiInProj {           P2(1)
    static constexpr bool PERM = true, KEEP = false;
    bf16* ZB; const float* rope;
    __device__ __forceinline__ bool keep(const Unit&) const { return false; }
    __device__ __forceinline__ void operator()(f32x4 (&acc)[2][2][4][2], const Unit& u, int wr, int wc, int fr, int fq) const {
        const int pn = u.pn, row0 = u.pm * BM + wr * 64 + fr;
        if (pn < 8) {
            const int half = wc & 1; const float ks = pn >= 4 ? K_SCALE : 1.f; const bool latent = u.pm > 0;
            f32x4 csn[4];
            auto ldcs = [&](int step, f32x4 (&c4)[4]) { const int row = row0 + (step >> 2) * HALF + (step & 3) * 16;
#pragma unroll
                for (int q = 0; q < 4; ++q) c4[q] = (f32x4){1.f, 0.f, 1.f, 0.f};
                if (latent) { const int tok = row - CTX; const int pos = half ? (tok & (GRID_W - 1)) : (tok / GRID_W); const float* rp = rope + (size_t)(pos * 32 + 8 * fq) * 2;
#pragma unroll
                    for (int q = 0; q < 4; ++q) c4[q] = *(const f32x4*)(rp + 4 * q); } };
            ldcs(0, csn);
#pragma unroll
            for (int ai = 0; ai < 2; ++ai)
#pragma unroll
                for (int m = 0; m < 4; ++m) {
                    const int row = row0 + ai * HALF + m * 16;
                    f32x4 cs[4];
#pragma unroll
                    for (int q = 0; q < 4; ++q) cs[q] = csn[q];
                    if (ai * 4 + m < 7) ldcs(ai * 4 + m + 1, csn);
                    float o1[8], o2[8];
#pragma unroll
                    for (int n = 0; n < 2; ++n) { const f32x4 t1 = acc[ai][0][m][n] * ks, t2 = acc[ai][1][m][n] * ks;
#pragma unroll
                        for (int j = 0; j < 4; ++j) { const int e = 4 * n + j; const float c = cs[e >> 1][2 * (e & 1)], sn = cs[e >> 1][2 * (e & 1) + 1];
                            o1[e] = t1[j] * c - t2[j] * sn; o2[e] = t1[j] * sn + t2[j] * c; } }
                    bf16* dst = ZB + (size_t)row * N_IN + pn * BM + 64 * wc + 8 * fq;
                    u32x4 w1, w2; w1.x = cvt_pk_bf16(o1[0], o1[1]); w1.y = cvt_pk_bf16(o1[2], o1[3]); w1.z = cvt_pk_bf16(o1[4], o1[5]); w1.w = cvt_pk_bf16(o1[6], o1[7]);
                    w2.x = cvt_pk_bf16(o2[0], o2[1]); w2.y = cvt_pk_bf16(o2[2], o2[3]); w2.z = cvt_pk_bf16(o2[4], o2[5]); w2.w = cvt_pk_bf16(o2[6], o2[7]);
                    *(u32x4*)dst = w1; *(u32x4*)(dst + 32) = w2;
                }
            return;
        }
        bf16* tile = ZB + (size_t)row0 * N_IN + pn * BM + wc * 64 + 8 * fq;
        if (pn >= 22) store_gate_tile(acc, (unsigned char*)ZB + (size_t)row0 * (N_IN * 2) + 2 * C_GATE + (pn * BM - C_GATE) + wc * 64 + 8 * fq);
        else if (pn < 12 || (pn >= 16 && pn < 18)) store_tile<0>(acc, tile);
        else if (pn < 16) store_tile<1>(acc, tile);
        else store_tile<2>(acc, tile);
    }
    __device__ __forceinline__ void store_gate_tile(f32x4 (&acc)[2][2][4][2], unsigned char* tile) const {
#pragma unroll
        for (int ai = 0; ai < 2; ++ai)
#pragma unroll
            for (int m = 0; m < 4; ++m) {
                unsigned char* rowp = tile + (size_t)(ai * HALF + m * 16) * (N_IN * 2);
#pragma unroll
                for (int bj = 0; bj < 2; ++bj) {
                    unsigned q[8];
#pragma unroll
                    for (int j = 0; j < 8; ++j) { const float z = j < 4 ? acc[ai][bj][m][0][j] : acc[ai][bj][m][1][j - 4];
                        const float g = __builtin_amdgcn_rcpf(1.f + __builtin_amdgcn_exp2f(z * -LOG2E));
                        q[j] = (unsigned)__builtin_amdgcn_fmed3f(g * 255.f + 0.5f, 1.f, 255.f); }
                    u32x2 w; w.x = q[0] | (q[1] << 8) | (q[2] << 16) | (q[3] << 24); w.y = q[4] | (q[5] << 8) | (q[6] << 16) | (q[7] << 24);
                    *(u32x2*)(rowp + bj * 32) = w;
                }
            }
    }
    template <int MODE>
    __device__ __forceinline__ void store_tile(f32x4 (&acc)[2][2][4][2], bf16* tile) const {
#pragma unroll
        for (int ai = 0; ai < 2; ++ai)
#pragma unroll
            for (int m = 0; m < 4; ++m) {
                bf16* rowp = tile + (size_t)(ai * HALF + m * 16) * N_IN;
#pragma unroll
                for (int bj = 0; bj < 2; ++bj) {
                    float v[8];
#pragma unroll
                    for (int j = 0; j < 4; ++j) { v[j] = acc[ai][bj][m][0][j]; v[4 + j] = acc[ai][bj][m][1][j]; }
#pragma unroll
                    for (int j = 0; j < 8; ++j) {
                        if (MODE == 1) v[j] = silu_f(v[j]);
                        else if (MODE == 2) v[j] = gelu_tanh_f(v[j]);
                        else if (MODE == 3) v[j] = 1.f + __expf(-fminf(fmaxf(v[j], -30.f), 30.f));
                    }
                    u32x4 w; w.x = cvt_pk_bf16(v[0], v[1]); w.y = cvt_pk_bf16(v[2], v[3]); w.z = cvt_pk_bf16(v[4], v[5]); w.w = cvt_pk_bf16(v[6], v[7]);
                    *(u32x4*)(rowp + bj * 32) = w;
                }
            }
    }
};
struct EpiBranch { static constexpr bool PRETOUCH = false;          P2(0)
    static constexpr bool PERM = true, KEEP = true;
    const bf16* ZB; bf16* Y;
    __device__ __forceinline__ bool keep(const Unit& u) const { return u.kind < 2; }
    __device__ __forceinline__ void operator()(f32x4 (&acc)[2][2][4][2], const Unit& u, int wr, int wc, int fr, int fq) const {
        const int kind = u.kind, rowu = u.pm * BM + wr * 64, colu = u.pn * BM + wc * 64;
        const unsigned char* gb = (const unsigned char*)ZB + (size_t)rowu * (N_IN * 2) + 2 * C_GATE + colu + kind * D;
        const int dstep = kind < 2 ? D : 0;
        const unsigned glo = (unsigned)(fr * (N_IN * 2) + 8 * fq);
        const bool fin = kind == 2;
#pragma unroll
        for (int ai = 0; ai < 2; ++ai) {
            u32x2 nm[4][2], dn[4][2];
#pragma unroll
            for (int m = 0; m < 4; ++m)
#pragma unroll
                for (int bj = 0; bj < 2; ++bj) { const unsigned char* p = gb + (size_t)(ai * HALF + m * 16) * (N_IN * 2) + bj * 32;
                    nm[m][bj] = *(const u32x2*)(p + glo); dn[m][bj] = *(const u32x2*)(p + dstep + glo); }
#pragma unroll
            for (int m = 0; m < 4; ++m)
#pragma unroll
                for (int bj = 0; bj < 2; ++bj) {
                    float sc[8];
#pragma unroll
                    for (int q = 0; q < 8; ++q) { const float n = (float)((nm[m][bj][q >> 2] >> (8 * (q & 3))) & 255u), r = __builtin_amdgcn_rcpf((float)((dn[m][bj][q >> 2] >> (8 * (q & 3))) & 255u));
                        sc[q] = n * (fin ? (1.f / 255.f) : r); }
#pragma unroll
                    for (int j = 0; j < 4; ++j) { acc[ai][bj][m][0][j] *= sc[j]; acc[ai][bj][m][1][j] *= sc[4 + j]; }
                }
        }
        if (fin) {
            bf16* yb = Y + (size_t)rowu * D + colu; const unsigned ylo = (unsigned)(fr * (D * 2) + 16 * fq);
#pragma unroll
            for (int ai = 0; ai < 2; ++ai)
#pragma unroll
                for (int m = 0; m < 4; ++m)
#pragma unroll
                    for (int bj = 0; bj < 2; ++bj) { const f32x4 a = acc[ai][bj][m][0], b = acc[ai][bj][m][1]; u32x4 w; w.x = cvt_pk_bf16(a[0], a[1]); w.y = cvt_pk_bf16(a[2], a[3]); w.z = cvt_pk_bf16(b[0], b[1]); w.w = cvt_pk_bf16(b[2], b[3]);
                        *(u32x4*)((unsigned char*)(yb + (size_t)(ai * HALF + m * 16) * D + bj * 32) + ylo) = w; }
        }
    }
};
struct EpiResid {            P2(0)
    static constexpr bool PERM = true, KEEP = false;
    bf16* X; const float* modl; int gi; float dry;
    __device__ __forceinline__ bool keep(const Unit&) const { return false; }
    __device__ __forceinline__ void operator()(f32x4 (&acc)[2][2][4][2], const Unit& u, int wr, int wc, int fr, int fq) const {
        const int row0 = u.pm * BM + wr * 64 + fr, col0 = u.pn * BM + wc * 64 + 8 * fq;
        const float* gate = modl + (size_t)(u.pm > 0 ? 1 : 0) * 6 * D + gi * D + col0;
        f32x4 gv[2][2];
#pragma unroll
        for (int bj = 0; bj < 2; ++bj)
#pragma unroll
            for (int n = 0; n < 2; ++n) gv[bj][n] = *(const f32x4*)(gate + bj * 32 + n * 4) * dry;
#pragma unroll
        for (int ai = 0; ai < 2; ++ai) {
            u32x4 xa[4][2];
#pragma unroll
            for (int m = 0; m < 4; ++m)
#pragma unroll
                for (int bj = 0; bj < 2; ++bj) xa[m][bj] = *(const u32x4*)(X + (size_t)(row0 + ai * HALF + m * 16) * D + col0 + bj * 32);
#pragma unroll
            for (int m = 0; m < 4; ++m) { bf16* rowp = X + (size_t)(row0 + ai * HALF + m * 16) * D + col0;
#pragma unroll
                for (int bj = 0; bj < 2; ++bj) { const f32x4 a = acc[ai][bj][m][0] * gv[bj][0], b = acc[ai][bj][m][1] * gv[bj][1]; const u32x4 x = xa[m][bj]; u32x4 w;
                    w.x = cvt_pk_bf16(bflo(x.x) + a[0], bfhi(x.x) + a[1]); w.y = cvt_pk_bf16(bflo(x.y) + a[2], bfhi(x.y) + a[3]);
                    w.z = cvt_pk_bf16(bflo(x.z) + b[0], bfhi(x.z) + b[1]); w.w = cvt_pk_bf16(bflo(x.w) + b[2], bfhi(x.w) + b[3]);
                    *(u32x4*)(rowp + bj * 32) = w; }
            }
        }
    }
};
template <bool FINAL>
struct EpiResidNorm {
    static constexpr bool PERM = true, KEEP = false;
    bf16* X; const float* modl; int gi; const float* ng; float* out; unsigned* xch; unsigned* cnt; LAS unsigned char* tab; unsigned want; bf16* H; const float* sc; const float* sh;
    __device__ __forceinline__ bool keep(const Unit&) const { return false; }
    __device__ __forceinline__ void operator()(f32x4 (&acc)[2][2][4][2], const Unit& u, int wr, int wc, int fr, int fq) const {
        const int lane = fq * 16 + fr, wid = wr * 4 + wc;
        const int row0 = u.pm * BM + wr * 64 + fr, col0 = u.pn * BM + wc * 64 + 8 * fq;
        LAS float* P = (LAS float*)tab; LAS float* S = (LAS float*)(tab + 4096);
        {
            const float* gate = modl + (size_t)6 * D + gi * D + col0;
            f32x4 gv[2][2];
#pragma unroll
            for (int bj = 0; bj < 2; ++bj)
#pragma unroll
                for (int n = 0; n < 2; ++n) gv[bj][n] = *(const f32x4*)(gate + bj * 32 + n * 4);
#pragma unroll
            for (int ai = 0; ai < 2; ++ai) {
                u32x4 xa[4][2];
#pragma unroll
                for (int m = 0; m < 4; ++m)
#pragma unroll
                    for (int bj = 0; bj < 2; ++bj) xa[m][bj] = *(const u32x4*)(X + (size_t)(row0 + ai * HALF + m * 16) * D + col0 + bj * 32);
#pragma unroll
                for (int m = 0; m < 4; ++m) { float ss = 0.f;
#pragma unroll
                    for (int bj = 0; bj < 2; ++bj) { const f32x4 a = acc[ai][bj][m][0] * gv[bj][0], b = acc[ai][bj][m][1] * gv[bj][1]; const u32x4 x = xa[m][bj]; u32x4 w;
                        w.x = cvt_pk_bf16(bflo(x.x) + a[0], bfhi(x.x) + a[1]); w.y = cvt_pk_bf16(bflo(x.y) + a[2], bfhi(x.y) + a[3]);
                        w.z = cvt_pk_bf16(bflo(x.z) + b[0], bfhi(x.z) + b[1]); w.w = cvt_pk_bf16(bflo(x.w) + b[2], bfhi(x.w) + b[3]);
                        if (!FINAL) *(u32x4*)(X + (size_t)(row0 + ai * HALF + m * 16) * D + col0 + bj * 32) = w;
                        const f32x4 v0 = (f32x4){bflo(w.x), bfhi(w.x), bflo(w.y), bfhi(w.y)}, v1 = (f32x4){bflo(w.z), bfhi(w.z), bflo(w.w), bfhi(w.w)};
                        acc[ai][bj][m][0] = v0; acc[ai][bj][m][1] = v1;
                        ss += ((v0[0] * v0[0] + v0[1] * v0[1]) + (v0[2] * v0[2] + v0[3] * v0[3])) + ((v1[0] * v1[0] + v1[1] * v1[1]) + (v1[2] * v1[2] + v1[3] * v1[3])); }
                    ss += __shfl_xor(ss, 16); ss += __shfl_xor(ss, 32);
                    if (fq == 0) P[(ai * HALF + wr * 64 + m * 16 + fr) * 4 + wc] = ss; }
            }
        }
        asm volatile("s_waitcnt lgkmcnt(0)" ::: "memory"); __builtin_amdgcn_s_barrier(); asm volatile("" ::: "memory");
        const int prow = wid * 32 + (lane & 31);
        if (lane < 32) { const float t = (P[prow * 4 + 0] + P[prow * 4 + 1]) + (P[prow * 4 + 2] + P[prow * 4 + 3]);
            __hip_atomic_store(xch + (size_t)(u.pm * BM + prow) * 8 + u.pn, __float_as_uint(t), __ATOMIC_RELAXED, __HIP_MEMORY_SCOPE_AGENT); }
        asm volatile("s_waitcnt vmcnt(0)" ::: "memory");
        if (lane == 0) __hip_atomic_fetch_add(cnt + 64 * u.pm, 1u, __ATOMIC_RELAXED, __HIP_MEMORY_SCOPE_AGENT);
        if (wid == 0) { unsigned sp = 0;
            while ((unsigned)__builtin_amdgcn_readfirstlane(__hip_atomic_load(cnt + 64 * u.pm, __ATOMIC_RELAXED, __HIP_MEMORY_SCOPE_AGENT)) < want && ++sp < (1u << 20)) __builtin_amdgcn_s_sleep(2);
            __builtin_amdgcn_fence(__ATOMIC_ACQUIRE, "agent"); }
        asm volatile("s_waitcnt vmcnt(0) lgkmcnt(0)" ::: "memory"); __builtin_amdgcn_s_barrier(); asm volatile("" ::: "memory");
        if (lane < 32) { const unsigned* sl = xch + (size_t)(u.pm * BM + prow) * 8; float tot = 0.f;
#pragma unroll
            for (int t = 0; t < 8; ++t) tot += __uint_as_float(__hip_atomic_load(sl + t, __ATOMIC_RELAXED, __HIP_MEMORY_SCOPE_AGENT));
            S[prow] = rsqrtf(tot * (1.f / D) + EPS); }
        asm volatile("s_waitcnt vmcnt(0) lgkmcnt(0)" ::: "memory"); __builtin_amdgcn_s_barrier(); asm volatile("" ::: "memory");
        f32x4 gg[2][2], hh[2][2];
#pragma unroll
        for (int bj = 0; bj < 2; ++bj)
#pragma unroll
            for (int n = 0; n < 2; ++n) { gg[bj][n] = *(const f32x4*)(ng + col0 + bj * 32 + n * 4);
                if (!FINAL) { gg[bj][n] = gg[bj][n] * (*(const f32x4*)(sc + col0 + bj * 32 + n * 4) + 1.f); hh[bj][n] = *(const f32x4*)(sh + col0 + bj * 32 + n * 4); } }
#pragma unroll
        for (int ai = 0; ai < 2; ++ai)
#pragma unroll
            for (int m = 0; m < 4; ++m) { const float r = S[ai * HALF + wr * 64 + m * 16 + fr]; const size_t ro = (size_t)(row0 + ai * HALF + m * 16);
#pragma unroll
                for (int bj = 0; bj < 2; ++bj) {
                    if (FINAL) { float* op = out + (ro - CTX) * D + col0 + bj * 32; *(f32x4*)op = acc[ai][bj][m][0] * r * gg[bj][0]; *(f32x4*)(op + 4) = acc[ai][bj][m][1] * r * gg[bj][1]; }
                    else { const f32x4 a = acc[ai][bj][m][0] * r * gg[bj][0] + hh[bj][0], b = acc[ai][bj][m][1] * r * gg[bj][1] + hh[bj][1]; u32x4 w;
                        w.x = cvt_pk_bf16(a[0], a[1]); w.y = cvt_pk_bf16(a[2], a[3]); w.z = cvt_pk_bf16(b[0], b[1]); w.w = cvt_pk_bf16(b[2], b[3]);
                        *(u32x4*)(H + ro * D + col0 + bj * 32) = w; } } }
    }
};
struct EpiRelu2 {            P2(2)
    static constexpr bool PERM = true, KEEP = false;
    bf16* O;
    __device__ __forceinline__ bool keep(const Unit&) const { return false; }
    __device__ __forceinline__ void operator()(f32x4 (&acc)[2][2][4][2], const Unit& u, int wr, int wc, int fr, int fq) const {
        const int row0 = u.pm * BM + wr * 64 + fr, col0 = u.pn * BM + wc * 64 + 8 * fq;
#pragma unroll
        for (int ai = 0; ai < 2; ++ai)
#pragma unroll
            for (int m = 0; m < 4; ++m) { bf16* rowp = O + (size_t)(row0 + ai * HALF + m * 16) * DFF + col0;
#pragma unroll
                for (int bj = 0; bj < 2; ++bj) { f32x4 a = acc[ai][bj][m][0], b = acc[ai][bj][m][1];
#pragma unroll
                    for (int j = 0; j < 4; ++j) { const float x = fmaxf(a[j], 0.f), y = fmaxf(b[j], 0.f); a[j] = x * x; b[j] = y * y; }
                    u32x4 w; w.x = cvt_pk_bf16(a[0], a[1]); w.y = cvt_pk_bf16(a[2], a[3]); w.z = cvt_pk_bf16(b[0], b[1]); w.w = cvt_pk_bf16(b[2], b[3]);
                    *(u32x4*)(rowp + bj * 32) = w; } }
    }
};

__device__ __forceinline__ int rope_src_col(int nv) {
    if (nv >= 2048) return nv;
    const int v = nv & 127, wc = v >> 5, fq = (v >> 3) & 3, n = (v >> 2) & 1, j = v & 3;
    return (nv & ~127) + 64 * (wc >> 1) + 16 * (wc & 1) + 4 * fq + j + 32 * n;
}
__device__ __forceinline__ void p0_transpose_item(const float* W, int N, bf16* WT, int ld, int koff, bool ropeperm, LAS float* scr, int item, int lane) {
    const int nblk = N / 32, kb = item / nblk, nb = item % nblk, k0 = 64 * kb, n0 = 32 * nb;
    const int nsrc = ropeperm ? rope_src_col(n0 + (lane & 31)) : n0 + (lane & 31);
#pragma unroll 8
    for (int i = 0; i < 32; ++i) { const int kk = 2 * i + (lane >> 5); scr[kk * 33 + (lane & 31)] = W[(size_t)(k0 + kk) * N + nsrc]; }
    LDS_WAIT(); asm volatile("" ::: "memory");
    const int c = lane & 7;
#pragma unroll
    for (int j = 0; j < 4; ++j) { const int n = (lane >> 3) + 8 * j; const LAS float* s = scr + (8 * c) * 33 + n;
        u32x4 o; o.x = pk2(s[0 * 33], s[1 * 33]); o.y = pk2(s[2 * 33], s[3 * 33]); o.z = pk2(s[4 * 33], s[5 * 33]); o.w = pk2(s[6 * 33], s[7 * 33]);
        *(u32x4*)(WT + (size_t)(n0 + n) * ld + koff + k0 + 8 * c) = o; }
    LDS_WAIT(); asm volatile("" ::: "memory");
}
__device__ __forceinline__ void p0_prologue(Frame& F) {
    const float* const __attribute__((address_space(4)))* in = F.in;
    const int gw = F.bid * 8 + F.wave, NGW = F.G * 8, lane = F.lane;
    const int gt = F.bid * 512 + F.tid, NGT = F.G * 512;
    {
        float* MOD = (float*)(F.ws + WS_MODP);
        constexpr int NJB = 6 * D / 256, NKQ = 16, KS = D / NKQ;
        for (int it = gw; it < DEPTH * NJB * NKQ; it += NGW) {
            const int l = it / (NJB * NKQ), r = it % (NJB * NKQ), kq = r / NJB, jb = r % NJB;
            const float* W = in[I_WADA] + ((size_t)l * D + kq * KS) * 6 * D + jb * 256 + lane * 4;
            f32x4 a0 = (f32x4){0.f, 0.f, 0.f, 0.f}, a1 = a0;
#pragma unroll 16
            for (int k = 0; k < KS; ++k) { const f32x4 w = __builtin_nontemporal_load((const f32x4*)(W + (size_t)k * 6 * D)); const float s0 = silu_f(in[I_CCTX][kq * KS + k]), s1 = silu_f(in[I_C][kq * KS + k]); a0 += w * s0; a1 += w * s1; }
            if (kq == 0) { const f32x4 b = *(const f32x4*)(in[I_BADA] + (size_t)l * 6 * D + jb * 256 + lane * 4); a0 += b; a1 += b; }
            float* o0 = MOD + (size_t)kq * (DEPTH * 2 * 6 * D) + ((size_t)l * 2 + 0) * 6 * D + jb * 256 + lane * 4;
            *(f32x4*)o0 = a0; *(f32x4*)(o0 + 6 * D) = a1;
        }
    }
    {
        LAS float* scr = (LAS float*)(F.lds + F.wave * 16640);
        constexpr int I_IN = (D / 64) * (N_IN / 64), I_BR = (RET_W / 64) * (D / 64), I_BP = (POOL_W / 64) * (D / 64), I_SQ = (D / 64) * (D / 64), I_F1 = (D / 64) * (DFF / 64), I_F2 = (DFF / 64) * (D / 64);
        constexpr int PER_L = I_IN + I_BR + 2 * I_BP + I_SQ + I_F1 + I_F2, TOTAL = DEPTH * PER_L;
        static_assert(8 * 16640 <= SCR_BYTES, "transposer LDS");
        unsigned char* ws = F.ws;
        auto decode = [&](int it, const float*& src, bf16*& dst, int& N, int& ld) {
            const int l = it / PER_L; int r = it % PER_L; const float* W; bf16* WT; int koff = 0, kb, nb;
            if (r < I_IN) { W = in[I_WIN] + (size_t)l * D * N_IN; N = N_IN; WT = (bf16*)(ws + WS_WIN + l * SZ_WIN); ld = D; kb = r / (N_IN / 64); nb = r % (N_IN / 64); }
            else if ((r -= I_IN) < I_BR) { W = in[I_WBR] + (size_t)l * RET_W * D; N = D; WT = (bf16*)(ws + WS_WCAT + l * SZ_WSQ); ld = D; kb = r / (D / 64); nb = r % (D / 64); }
            else if ((r -= I_BR) < I_BP) { W = in[I_WBP] + (size_t)l * POOL_W * D; N = D; WT = (bf16*)(ws + WS_WCAT + l * SZ_WSQ); ld = D; koff = RET_W; kb = r / (D / 64); nb = r % (D / 64); }
            else if ((r -= I_BP) < I_BP) { W = in[I_WBS] + (size_t)l * SG_W * D; N = D; WT = (bf16*)(ws + WS_WCAT + l * SZ_WSQ); ld = D; koff = RET_W + POOL_W; kb = r / (D / 64); nb = r % (D / 64); }
            else if ((r -= I_BP) < I_SQ) { W = in[I_WOUT] + (size_t)l * D * D; N = D; WT = (bf16*)(ws + WS_WOUT + l * SZ_WSQ); ld = D; kb = r / (D / 64); nb = r % (D / 64); }
            else if ((r -= I_SQ) < I_F1) { W = in[I_W1] + (size_t)l * D * DFF; N = DFF; WT = (bf16*)(ws + WS_W1 + l * SZ_WFF); ld = D; kb = r / (DFF / 64); nb = r % (DFF / 64); }
            else { r -= I_F1; W = in[I_W2] + (size_t)l * DFF * D; N = D; WT = (bf16*)(ws + WS_W2 + l * SZ_WFF); ld = DFF; kb = r / (D / 64); nb = r % (D / 64); }
            const int k0 = 64 * kb, n0 = 64 * nb;
            src = W + (size_t)k0 * N + n0;
            dst = WT + (size_t)n0 * ld + koff + k0;
        };
#define P0_LOAD(buf, srcu, Nu) do { const unsigned loff_ = (unsigned)(((lane >> 5) * (Nu) + 2 * (lane & 31)) * 4); \
            _Pragma("unroll") for (int i = 0; i < 32; ++i) buf[i] = __builtin_nontemporal_load((const f32x2*)((const char*)((srcu) + (size_t)(2 * i) * (Nu)) + loff_)); } while (0)
        f32x2 bufA[32], bufB[32];
        const float* sA; bf16* dA; int NA, ldA; const float* sB; bf16* dB; int NB, ldB;
        auto process = [&](f32x2 (&buf)[32], bf16* dst, int ld) {
#pragma unroll
            for (int i = 0; i < 32; ++i) { LAS float* q = scr + (2 * i + (lane >> 5)) * 65 + 2 * (lane & 31); q[0] = buf[i][0]; q[1] = buf[i][1]; }
            LDS_WAIT(); asm volatile("" ::: "memory");
            const int c = lane & 7;
#pragma unroll
            for (int j = 0; j < 8; ++j) { const int n = (lane >> 3) + 8 * j; const LAS float* p = scr + (8 * c) * 65 + n;
                u32x4 o; o.x = pk2(p[0 * 65], p[1 * 65]); o.y = pk2(p[2 * 65], p[3 * 65]); o.z = pk2(p[4 * 65], p[5 * 65]); o.w = pk2(p[6 * 65], p[7 * 65]);
                *(u32x4*)(dst + (size_t)n * ld + 8 * c) = o; }
            LDS_WAIT(); asm volatile("" ::: "memory");
        };
        int it = gw;
        if (it < TOTAL) {
            decode(it, sA, dA, NA, ldA);
            P0_LOAD(bufA, sA, NA);
            for (;;) {
                const int i1 = it + NGW;
                decode(i1 < TOTAL ? i1 : it, sB, dB, NB, ldB);
                P0_LOAD(bufB, sB, NB);
                process(bufA, dA, ldA);
                if (i1 >= TOTAL) break;
                const int i2 = i1 + NGW;
                decode(i2 < TOTAL ? i2 : i1, sA, dA, NA, ldA);
                P0_LOAD(bufA, sA, NA);
                process(bufB, dB, ldB);
                if (i2 >= TOTAL) break;
                it = i2;
            }
        }
#undef P0_LOAD
    }
    {
        bf16* PWT = (bf16*)(F.ws + WS_PWT); bf16* SGW = (bf16*)(F.ws + WS_SGW); float* ROPE = (float*)(F.ws + WS_ROPE);
        for (int i = gt; i < DEPTH * 4 * 128 * 128; i += NGT) {
            const int lg = i >> 14, d = (i >> 7) & 127, c = i & 127;
            PWT[i] = (bf16)f2bf(in[I_PW][(size_t)lg * 16384 + c * 128 + d]);
            SGW[i] = (bf16)f2bf(in[I_SGW][i]);
        }
        for (int i = gt; i < 128 * 32; i += NGT) { const int pos = i >> 5, f = i & 31; const float inv = powf(10000.f, -(float)f / 32.f); const float ang = (float)pos * inv; ROPE[2 * i] = cosf(ang); ROPE[2 * i + 1] = sinf(ang); }
    }
}

__device__ __forceinline__ void mod_reduce_phase(Frame& F) {
    const float* P = (const float*)(F.ws + WS_MODP); float* MOD = (float*)(F.ws + WS_MOD);
    for (int i = F.bid * 512 + F.tid; i < DEPTH * 2 * 6 * D; i += F.G * 512) { float s = 0.f;
#pragma unroll
        for (int k = 0; k < 16; ++k) s += P[(size_t)k * (DEPTH * 2 * 6 * D) + i];
        MOD[i] = s; }
}
__device__ __forceinline__ void norm_phase(Frame& F, const float* g, const float* modl, int si, bool first, const float* slab_gate = nullptr) {
    bf16* X = (bf16*)(F.ws + WS_X); bf16* H = (bf16*)(F.ws + WS_H);
    const int gw = F.bid * 8 + F.wave, NGW = F.G * 8, lane = F.lane;
    if (slab_gate) {
        LAS float* red = (LAS float*)F.lds;
        for (int row = F.bid; row < CTX; row += F.G) {
            const int c = 256 * F.wave + 4 * lane;
            const float* SL = (const float*)(F.ws + WS_SLAB) + (size_t)row * D + c;
            f32x4 sm = *(const f32x4*)SL;
#pragma unroll
            for (int k = 1; k < 4; ++k) sm += *(const f32x4*)(SL + (size_t)k * CTX * D);
            const u32x2 xo = *(const u32x2*)(X + (size_t)row * D + c); const f32x4 gt = *(const f32x4*)(slab_gate + c);
            u32x2 xn; xn.x = cvt_pk_bf16(bflo(xo.x) + gt[0] * sm[0], bfhi(xo.x) + gt[1] * sm[1]); xn.y = cvt_pk_bf16(bflo(xo.y) + gt[2] * sm[2], bfhi(xo.y) + gt[3] * sm[3]);
            *(u32x2*)(X + (size_t)row * D + c) = xn;
            const float v0 = bflo(xn.x), v1 = bfhi(xn.x), v2 = bflo(xn.y), v3 = bfhi(xn.y);
            const float ps = wave_sum((v0 * v0 + v1 * v1) + (v2 * v2 + v3 * v3));
            __syncthreads();
            if (lane == 0) red[F.wave] = ps;
            __syncthreads();
            float tot = 0.f;
#pragma unroll
            for (int k = 0; k < 8; ++k) tot += red[k];
            const float r = rsqrtf(tot * (1.f / D) + EPS);
            const f32x4 gg = *(const f32x4*)(g + c), sc = *(const f32x4*)(modl + (si + 1) * D + c), sh = *(const f32x4*)(modl + si * D + c);
            u32x2 w; w.x = cvt_pk_bf16(v0 * r * gg[0] * (sc[0] + 1.f) + sh[0], v1 * r * gg[1] * (sc[1] + 1.f) + sh[1]); w.y = cvt_pk_bf16(v2 * r * gg[2] * (sc[2] + 1.f) + sh[2], v3 * r * gg[3] * (sc[3] + 1.f) + sh[3]);
            *(u32x2*)(H + (size_t)row * D + c) = w;
        }
    }
    if (!first) {
        const float* ml = modl + (size_t)6 * D;
        f32x4 Af[8], Sf[8];
#pragma unroll
        for (int j = 0; j < 4; ++j)
#pragma unroll
            for (int h = 0; h < 2; ++h) { const int c = j * 512 + lane * 8 + 4 * h; Af[2 * j + h] = *(const f32x4*)(g + c) * (*(const f32x4*)(ml + (si + 1) * D + c) + 1.f); Sf[2 * j + h] = *(const f32x4*)(ml + si * D + c); }
        auto ldrow = [&](int row, u32x4 (&d)[4]) {
#pragma unroll
            for (int j = 0; j < 4; ++j) d[j] = *(const u32x4*)(X + (size_t)row * D + j * 512 + lane * 8); };
        auto proc = [&](int row, const u32x4 (&cur)[4]) {
            float v[32]; float s = 0.f;
#pragma unroll
            for (int j = 0; j < 4; ++j)
#pragma unroll
                for (int e = 0; e < 4; ++e) { v[8 * j + 2 * e] = bflo(cur[j][e]); v[8 * j + 2 * e + 1] = bfhi(cur[j][e]); }
#pragma unroll
            for (int e = 0; e < 32; ++e) s += v[e] * v[e];
            const float r = rsqrtf(wave_sum(s) * (1.f / D) + EPS);
            if (row < CTX) {
#pragma unroll
                for (int j = 0; j < 4; ++j) { const int c = j * 512 + lane * 8; float o[8];
#pragma unroll
                    for (int h = 0; h < 2; ++h) { const f32x4 gg = *(const f32x4*)(g + c + 4 * h), sc = *(const f32x4*)(modl + (si + 1) * D + c + 4 * h), sh = *(const f32x4*)(modl + si * D + c + 4 * h);
#pragma unroll
                        for (int e = 0; e < 4; ++e) o[4 * h + e] = v[8 * j + 4 * h + e] * r * gg[e] * (sc[e] + 1.f) + sh[e]; }
                    u32x4 w; w.x = cvt_pk_bf16(o[0], o[1]); w.y = cvt_pk_bf16(o[2], o[3]); w.z = cvt_pk_bf16(o[4], o[5]); w.w = cvt_pk_bf16(o[6], o[7]);
                    *(u32x4*)(H + (size_t)row * D + c) = w; }
            } else {
#pragma unroll
                for (int j = 0; j < 4; ++j) { const int c = j * 512 + lane * 8; float o[8];
#pragma unroll
                    for (int h = 0; h < 2; ++h)
#pragma unroll
                        for (int e = 0; e < 4; ++e) o[4 * h + e] = v[8 * j + 4 * h + e] * r * Af[2 * j + h][e] + Sf[2 * j + h][e];
                    u32x4 w; w.x = cvt_pk_bf16(o[0], o[1]); w.y = cvt_pk_bf16(o[2], o[3]); w.z = cvt_pk_bf16(o[4], o[5]); w.w = cvt_pk_bf16(o[6], o[7]);
                    *(u32x4*)(H + (size_t)row * D + c) = w; }
            } };
        u32x4 bufA[4], bufB[4];
        int row = slab_gate ? CTX + gw : gw;
        if (row < MROWS) { ldrow(row, bufA);
            for (;;) {
                const int n1 = row + NGW; ldrow(n1 < MROWS ? n1 : row, bufB); proc(row, bufA); if (n1 >= MROWS) break;
                const int n2 = n1 + NGW; ldrow(n2 < MROWS ? n2 : n1, bufA); proc(n1, bufB); if (n2 >= MROWS) break;
                row = n2;
            } }
        return;
    }
    for (int row = slab_gate ? CTX + gw : gw; row < MROWS; row += NGW) {
        float v[32]; float s = 0.f;
        if (first) {
            const float* src = row < CTX ? F.in[I_CTX] + (size_t)row * D : F.in[I_X] + (size_t)(row - CTX) * D;
#pragma unroll
            for (int j = 0; j < 4; ++j) { const f32x4 a = *(const f32x4*)(src + j * 512 + lane * 8), b = *(const f32x4*)(src + j * 512 + lane * 8 + 4);
#pragma unroll
                for (int e = 0; e < 4; ++e) { v[8 * j + e] = a[e]; v[8 * j + 4 + e] = b[e]; }
                u32x4 w; w.x = cvt_pk_bf16(a[0], a[1]); w.y = cvt_pk_bf16(a[2], a[3]); w.z = cvt_pk_bf16(b[0], b[1]); w.w = cvt_pk_bf16(b[2], b[3]);
                *(u32x4*)(X + (size_t)row * D + j * 512 + lane * 8) = w; }
        } else {
#pragma unroll
            for (int j = 0; j < 4; ++j) { const u32x4 x = *(const u32x4*)(X + (size_t)row * D + j * 512 + lane * 8);
#pragma unroll
                for (int e = 0; e < 4; ++e) { v[8 * j + 2 * e] = bflo(x[e]); v[8 * j + 2 * e + 1] = bfhi(x[e]); } }
        }
#pragma unroll
        for (int e = 0; e < 32; ++e) s += v[e] * v[e];
        const float r = rsqrtf(wave_sum(s) * (1.f / D) + EPS);
        const float* m = modl + (size_t)(row < CTX ? 0 : 1) * 6 * D;
#pragma unroll
        for (int j = 0; j < 4; ++j) { const int c = j * 512 + lane * 8; float o[8];
#pragma unroll
            for (int h = 0; h < 2; ++h) { const f32x4 gg = *(const f32x4*)(g + c + 4 * h), sc = *(const f32x4*)(m + (si + 1) * D + c + 4 * h), sh = *(const f32x4*)(m + si * D + c + 4 * h);
#pragma unroll
                for (int e = 0; e < 4; ++e) o[4 * h + e] = v[8 * j + 4 * h + e] * r * gg[e] * (sc[e] + 1.f) + sh[e]; }
            u32x4 w; w.x = cvt_pk_bf16(o[0], o[1]); w.y = cvt_pk_bf16(o[2], o[3]); w.z = cvt_pk_bf16(o[4], o[5]); w.w = cvt_pk_bf16(o[6], o[7]);
            *(u32x4*)(H + (size_t)row * D + c) = w; }
    }
}
#ifndef FUSE_FINAL
#define FUSE_FINAL 1
#endif
__device__ __forceinline__ void final_norm_phase(Frame& F, float* out) {
    if (FUSE_FINAL) return;
    const bf16* X = (const bf16*)(F.ws + WS_X); const float* g = F.in[I_FNG];
    const int gw = F.bid * 8 + F.wave, NGW = F.G * 8, lane = F.lane;
    u32x4 cur[4], nxt[4];
    if (gw < SEQ) {
#pragma unroll
        for (int j = 0; j < 4; ++j) cur[j] = *(const u32x4*)(X + (size_t)(gw + CTX) * D + j * 512 + lane * 8);
    }
    for (int row = gw; row < SEQ; row += NGW) {
        if (row + NGW < SEQ) {
#pragma unroll
            for (int j = 0; j < 4; ++j) nxt[j] = *(const u32x4*)(X + (size_t)(row + NGW + CTX) * D + j * 512 + lane * 8);
        }
        float v[32]; float s = 0.f;
#pragma unroll
        for (int j = 0; j < 4; ++j) { const u32x4 x = cur[j];
#pragma unroll
            for (int e = 0; e < 4; ++e) { v[8 * j + 2 * e] = bflo(x[e]); v[8 * j + 2 * e + 1] = bfhi(x[e]); } }
#pragma unroll
        for (int e = 0; e < 32; ++e) s += v[e] * v[e];
        const float r = rsqrtf(wave_sum(s) * (1.f / D) + EPS);
#pragma unroll
        for (int j = 0; j < 4; ++j) { const int c = j * 512 + lane * 8;
#pragma unroll
            for (int h = 0; h < 2; ++h) { const f32x4 gg = *(const f32x4*)(g + c + 4 * h); f32x4 o;
#pragma unroll
                for (int e = 0; e < 4; ++e) o[e] = v[8 * j + 4 * h + e] * r * gg[e];
                *(f32x4*)(out + (size_t)row * D + c + 4 * h) = o; } }
#pragma unroll
        for (int j = 0; j < 4; ++j) cur[j] = nxt[j];
    }
}

#define MFMA16(a, b, c) __builtin_amdgcn_mfma_f32_16x16x32_bf16((a), (b), (c), 0, 0, 0)
template <bool TWO>
__device__ __forceinline__ void fill_transposed(LAS unsigned char* T0, LAS unsigned char* T1, const bf16* src, size_t ld, int tid, float sc0, float sc1, bool scaled) {
    const int s = tid & 127, dq = tid >> 7;
    const bf16* rp = src + (size_t)s * ld + 32 * dq;
    u32x4 v[4];
#pragma unroll
    for (int kk = 0; kk < 4; ++kk) v[kk] = *(const u32x4*)(rp + 8 * kk);
#pragma unroll
    for (int kk = 0; kk < 4; ++kk)
#pragma unroll
        for (int q = 0; q < 4; ++q) {
            const int d = 32 * dq + 8 * kk + 2 * q; const unsigned w = v[kk][q];
            if (scaled) { const float lo = bflo(w), hi = bfhi(w);
                *(LAS bf16*)(T0 + d * TP + s * 2) = (bf16)f2bf(lo * sc0); *(LAS bf16*)(T0 + (d + 1) * TP + s * 2) = (bf16)f2bf(hi * sc0);
                if (TWO) { *(LAS bf16*)(T1 + d * TP + s * 2) = (bf16)f2bf(lo * sc1); *(LAS bf16*)(T1 + (d + 1) * TP + s * 2) = (bf16)f2bf(hi * sc1); } }
            else { *(LAS bf16*)(T0 + d * TP + s * 2) = (bf16)(w & 0xffffu); *(LAS bf16*)(T0 + (d + 1) * TP + s * 2) = (bf16)(w >> 16); }
        }
}
__device__ __forceinline__ void fill_rows(LAS unsigned char* T, const bf16* src, size_t ld, int tid) {
    const int r = tid >> 4, sg = tid & 15;
    const bf16* rp = src + (size_t)r * ld + sg * 8;
    u32x4 v[4];
#pragma unroll
    for (int q = 0; q < 4; ++q) v[q] = *(const u32x4*)(rp + (size_t)(32 * q) * ld);
#pragma unroll
    for (int q = 0; q < 4; ++q) *(LAS u32x4*)(T + (r + 32 * q) * TP + sg * 16) = v[q];
}

typedef short s16x4 __attribute__((ext_vector_type(4)));
__device__ __forceinline__ bf16x8 tr_frag(const LAS unsigned char* T, int rowa, int rowb, int col0, int lane) {
    const int i = lane & 15;
    const LAS unsigned char* pa = T + (rowa + (i >> 2)) * TP + (col0 + 4 * (i & 3)) * 2;
    const LAS unsigned char* pb = T + (rowb + (i >> 2)) * TP + (col0 + 4 * (i & 3)) * 2;
    const s16x4 lo = __builtin_amdgcn_ds_read_tr16_b64_v4i16((LAS s16x4*)pa), hi = __builtin_amdgcn_ds_read_tr16_b64_v4i16((LAS s16x4*)pb);
    return (bf16x8){lo[0], lo[1], lo[2], lo[3], hi[0], hi[1], hi[2], hi[3]};
}
__device__ __forceinline__ void kv_item(Frame& F, int l, int c, int h) {
    LAS unsigned char* Kt = F.lds; LAS unsigned char* Vt = F.lds + TILE_B;
    const bf16* ZB = (const bf16*)(F.ws + WS_ZB) + (size_t)c * 128 * N_IN;
    const float* lg = F.in[I_RLOG] + (size_t)l * 2 * RET_H;
    const float l2f = log_sigmoid_f(lg[h]) * LOG2E, l2b = log_sigmoid_f(lg[RET_H + h]) * LOG2E;
    fill_rows(Kt, ZB + C_K + h * HD, N_IN, F.tid);
    fill_rows(Vt, ZB + C_V + h * HD, N_IN, F.tid);
    __syncthreads();
    const int w = F.wave, fr = F.lane & 15, fq = F.lane >> 4;
    bf16x8 vf[4], vb[4];
    float gpf[8], gpb[8];
    { const float gf = exp2f(l2f), gb = exp2f(l2b); gpf[0] = 1.f; gpb[0] = 1.f;
#pragma unroll
      for (int k = 1; k < 8; ++k) { gpf[k] = gpf[k - 1] * gf; gpb[k] = gpb[k - 1] * gb; } }
#pragma unroll
    for (int t = 0; t < 4; ++t) {
        const bf16x8 raw = tr_frag(Vt, 32 * t + 8 * fq, 32 * t + 8 * fq + 4, 16 * w, F.lane);
        const u32x4 rw = __builtin_bit_cast(u32x4, raw); u32x4 pf, pb;
        const int sg0 = 32 * t + 8 * fq;
        const float wf7 = exp2f(l2f * (float)(120 - sg0)), wb0 = exp2f(l2b * (float)sg0);
#pragma unroll
        for (int q = 0; q < 4; ++q) { const float lo = bflo(rw[q]), hi = bfhi(rw[q]);
            pf[q] = cvt_pk_bf16(lo * (wf7 * gpf[7 - 2 * q]), hi * (wf7 * gpf[6 - 2 * q]));
            pb[q] = cvt_pk_bf16(lo * (wb0 * gpb[2 * q]), hi * (wb0 * gpb[2 * q + 1])); }
        vf[t] = __builtin_bit_cast(bf16x8, pf); vb[t] = __builtin_bit_cast(bf16x8, pb);
    }
    bf16* KVT = (bf16*)(F.ws + WS_KVT) + (((size_t)c * RET_H + h) * 2) * 16384 + (size_t)(16 * w + fr) * 128 + 4 * fq;
#pragma unroll
    for (int db = 0; db < 8; ++db) {
        f32x4 af = (f32x4){0.f, 0.f, 0.f, 0.f}, ab = af;
#pragma unroll
        for (int t = 0; t < 4; ++t) {
            const bf16x8 kf = tr_frag(Kt, 32 * t + 8 * fq, 32 * t + 8 * fq + 4, 16 * db, F.lane);
            af = MFMA16(kf, vf[t], af); ab = MFMA16(kf, vb[t], ab);
        }
        u32x2 of, ob; of.x = pk2(af[0], af[1]); of.y = pk2(af[2], af[3]); ob.x = pk2(ab[0], ab[1]); ob.y = pk2(ab[2], ab[3]);
        *(u32x2*)(KVT + 16 * db) = of; *(u32x2*)(KVT + 16384 + 16 * db) = ob;
    }
    __syncthreads();
}
__device__ __forceinline__ void pool_item(Frame& F, int l, int c, int g) {
    LAS unsigned char* Pin = F.lds; LAS unsigned char* PWT = F.lds + 144 * TP; LAS unsigned char* Yl = PWT + TILE_B;
    const bf16* ZB = (const bf16*)(F.ws + WS_ZB);
    const int row0 = c * 128, tid = F.tid;
    for (int p = tid; p < 144 * 16; p += 512) { const int rr = p >> 4, sg = p & 15, grow = row0 - 8 + rr;
        if (grow >= 0 && grow < MROWS) *(LAS u32x4*)(Pin + rr * TP + sg * 16) = *(const u32x4*)(ZB + (size_t)grow * N_IN + C_P + g * 128 + sg * 8); }
    fill_rows(PWT, (const bf16*)(F.ws + WS_PWT) + (size_t)(l * 4 + g) * 16384, 128, tid);
    __syncthreads();
    {
        const int t = tid >> 2, cq = tid & 3, grow = row0 + t;
        int seg0, seglen, pos;
        if (grow < CTX) { seg0 = 0; seglen = CTX; pos = grow; } else { const int tok = grow - CTX; seg0 = CTX + (tok / GRID_W) * GRID_W; seglen = GRID_W; pos = tok % GRID_W; }
        const int w = 2 << g; int lo = pos - w / 2; if (lo < 0) lo = 0; int hi = pos + w / 2 - 1; if (hi > seglen - 1) hi = seglen - 1;
        const float inv = 1.f / (float)(hi - lo + 1);
        float sum[32];
#pragma unroll
        for (int j = 0; j < 32; ++j) sum[j] = 0.f;
        for (int p = lo; p <= hi; ++p) { const LAS unsigned char* rp = Pin + (seg0 + p - (row0 - 8)) * TP + cq * 64;
#pragma unroll
            for (int q = 0; q < 4; ++q) { const u32x4 v = *(const LAS u32x4*)(rp + q * 16);
#pragma unroll
                for (int e = 0; e < 4; ++e) { sum[q * 8 + 2 * e] += bflo(v[e]); sum[q * 8 + 2 * e + 1] += bfhi(v[e]); } } }
        const LAS unsigned char* sp = Pin + (t + 8) * TP + cq * 64;
#pragma unroll
        for (int q = 0; q < 4; ++q) { const u32x4 v = *(const LAS u32x4*)(sp + q * 16); u32x4 o;
#pragma unroll
            for (int e = 0; e < 4; ++e) o[e] = cvt_pk_bf16(sum[q * 8 + 2 * e] * inv - bflo(v[e]), sum[q * 8 + 2 * e + 1] * inv - bfhi(v[e]));
            *(LAS u32x4*)(Yl + t * TP + cq * 64 + q * 16) = o; }
    }
    __syncthreads();
    const int w = F.wave, fr = F.lane & 15, fq = F.lane >> 4;
    bf16x8 yb[4];
#pragma unroll
    for (int t = 0; t < 4; ++t) yb[t] = *(const LAS bf16x8*)(Yl + (16 * w + fr) * TP + (32 * t + 8 * fq) * 2);
    bf16* MIX = (bf16*)(F.ws + WS_MIX) + (size_t)(row0 + 16 * w + fr) * D + RET_W + g * 128 + 4 * fq;
    const float* ps = F.in[I_PS] + (size_t)l * POOL_W + g * 128 + 4 * fq;
    f32x4 scv[8];
#pragma unroll
    for (int db = 0; db < 8; ++db) scv[db] = *(const f32x4*)(ps + 16 * db);
#pragma unroll
    for (int db = 0; db < 8; ++db) {
        f32x4 a = (f32x4){0.f, 0.f, 0.f, 0.f};
#pragma unroll
        for (int t = 0; t < 4; ++t) a = MFMA16(*(const LAS bf16x8*)(PWT + (16 * db + fr) * TP + (32 * t + 8 * fq) * 2), yb[t], a);
        a = a * scv[db];
        u32x2 o; o.x = cvt_pk_bf16(a[0], a[1]); o.y = cvt_pk_bf16(a[2], a[3]);
        *(u32x2*)(MIX + 16 * db) = o;
    }
    __syncthreads();
}
__device__ __forceinline__ void sg_item(Frame& F, int l, int c, int g) {
    LAS unsigned char* VN = F.lds;
    const bf16* ZB = (const bf16*)(F.ws + WS_ZB) + (size_t)c * 128 * N_IN;
    const int tid = F.tid;
    {
        const int w0 = F.wave * 16, lane = F.lane;
        u32x4 rv[16];
#pragma unroll
        for (int i = 0; i < 16; ++i) rv[i] = *(const u32x4*)(ZB + (size_t)(w0 + i) * N_IN + C_SV + 8 * lane);
        const float* ng = F.in[I_SGNG] + (size_t)l * SG_W + 8 * lane;
        const f32x4 n0 = *(const f32x4*)ng, n1 = *(const f32x4*)(ng + 4);
        float ss[16];
#pragma unroll
        for (int i = 0; i < 16; ++i) { const u32x4 v = rv[i]; ss[i] = 0.f;
#pragma unroll
            for (int e = 0; e < 4; ++e) { const float a = bflo(v[e]), b = bfhi(v[e]); ss[i] += a * a + b * b; } }
#pragma unroll
        for (int o = 1; o < 64; o <<= 1)
#pragma unroll
            for (int i = 0; i < 16; ++i) ss[i] += __shfl_xor(ss[i], o);
        if ((lane >> 4) == g) {
#pragma unroll
            for (int i = 0; i < 16; ++i) { const u32x4 v = rv[i]; const float r = rsqrtf(ss[i] * (1.f / SG_W) + EPS); u32x4 o;
                o.x = cvt_pk_bf16(bflo(v.x) * r * n0[0], bfhi(v.x) * r * n0[1]); o.y = cvt_pk_bf16(bflo(v.y) * r * n0[2], bfhi(v.y) * r * n0[3]);
                o.z = cvt_pk_bf16(bflo(v.z) * r * n1[0], bfhi(v.z) * r * n1[1]); o.w = cvt_pk_bf16(bflo(v.w) * r * n1[2], bfhi(v.w) * r * n1[3]);
                *(LAS u32x4*)(VN + (w0 + i) * TP + (lane & 15) * 16) = o; }
        }
    }
    __syncthreads();
    const int w = F.wave, fr = F.lane & 15, fq = F.lane >> 4;
    const bf16* SGW = (const bf16*)(F.ws + WS_SGW) + ((size_t)(l * 4 + g) * 128 + 16 * w + fr) * 128;
    bf16x8 wf[4];
#pragma unroll
    for (int t = 0; t < 4; ++t) wf[t] = *(const bf16x8*)(SGW + 32 * t + 8 * fq);
    const float bias = F.in[I_SGB][(size_t)(l * 4 + g) * 128 + 16 * w + fr];
    const bf16* U = ZB + (size_t)(16 * w + fr) * N_IN + C_U + g * 128 + 4 * fq;
    u32x2 uvv[8];
#pragma unroll
    for (int cb = 0; cb < 8; ++cb) uvv[cb] = *(const u32x2*)(U + 16 * cb);
    bf16* MIX = (bf16*)(F.ws + WS_MIX) + (size_t)(c * 128 + 16 * w + fr) * D + RET_W + POOL_W + g * 128 + 4 * fq;
#pragma unroll
    for (int cb = 0; cb < 8; ++cb) {
        f32x4 a = (f32x4){0.f, 0.f, 0.f, 0.f};
#pragma unroll
        for (int t = 0; t < 4; ++t) a = MFMA16(tr_frag(VN, 32 * t + 8 * fq, 32 * t + 8 * fq + 4, 16 * cb, F.lane), wf[t], a);
        const u32x2 uv = uvv[cb];
        u32x2 o; o.x = cvt_pk_bf16((a[0] + bias) * bflo(uv.x), (a[1] + bias) * bfhi(uv.x)); o.y = cvt_pk_bf16((a[2] + bias) * bflo(uv.y), (a[3] + bias) * bfhi(uv.y));
        *(u32x2*)(MIX + 16 * cb) = o;
    }
    __syncthreads();
}
__device__ __forceinline__ void scan_phase(Frame& F, int l, int nskip) {
    const bf16* KVT = (const bf16*)(F.ws + WS_KVT); bf16* ST = (bf16*)(F.ws + WS_ST);
    const float* lg = F.in[I_RLOG] + (size_t)l * 2 * RET_H;
    if (F.bid < nskip) return;
    const int nw = F.G - nskip, per = (65536 + nw - 1) / nw, p = (F.bid - nskip) * per + F.tid;
    if (F.tid < per && p < 65536) {
        const int hd = p >> 12, h = hd >> 1, dir = hd & 1;
        const float g128 = expf(128.f * log_sigmoid_f(lg[dir * RET_H + h]));
        const size_t e0 = (size_t)p * 4;
        u32x2 kvw[NCHUNK];
#pragma unroll
        for (int c = 0; c < NCHUNK; ++c) kvw[c] = *(const u32x2*)(KVT + (size_t)c * 262144 + e0);
        f32x4 S = (f32x4){0.f, 0.f, 0.f, 0.f};
        if (dir == 0) {
#pragma unroll
            for (int c = 0; c < NCHUNK; ++c) { u32x2 o; o.x = cvt_pk_bf16(S[0], S[1]); o.y = cvt_pk_bf16(S[2], S[3]); *(u32x2*)(ST + (size_t)c * 262144 + e0) = o;
                S = S * g128 + (f32x4){bflo(kvw[c].x), bfhi(kvw[c].x), bflo(kvw[c].y), bfhi(kvw[c].y)}; }
        } else {
#pragma unroll
            for (int i = 0; i < NCHUNK; ++i) { const int c = i < 2 ? 1 - i : NCHUNK + 1 - i; u32x2 o; o.x = cvt_pk_bf16(S[0], S[1]); o.y = cvt_pk_bf16(S[2], S[3]); *(u32x2*)(ST + (size_t)c * 262144 + e0) = o;
                S = S * g128 + (f32x4){bflo(kvw[c].x), bfhi(kvw[c].x), bflo(kvw[c].y), bfhi(kvw[c].y)}; }
        }
    }
}
__device__ __forceinline__ void fill_rows_f32(LAS unsigned char* T, const float* src, int tid) {
    const int r = tid >> 2, sg = tid & 3;
#pragma unroll
    for (int q = 0; q < 4; ++q) { unsigned z = 0u; asm volatile("" : "+v"(z));
        u32x4 w = (u32x4){z, z, z, z};
        if (src) { const f32x4 a = *(const f32x4*)(src + (size_t)r * 128 + sg * 32 + q * 8), b = *(const f32x4*)(src + (size_t)r * 128 + sg * 32 + q * 8 + 4);
            w.x = cvt_pk_bf16(a[0], a[1]); w.y = cvt_pk_bf16(a[2], a[3]); w.z = cvt_pk_bf16(b[0], b[1]); w.w = cvt_pk_bf16(b[2], b[3]); }
        *(LAS u32x4*)(T + r * TP + sg * 64 + q * 16) = w; }
}
__device__ __forceinline__ void ret_core(Frame& F, int l, int c, int h, float l2f, float l2b, const bf16x8 (&qf)[4], const u32x2 (&gvv)[8]) {
    LAS unsigned char* Kt = F.lds; LAS unsigned char* VT = F.lds + TILE_B; LAS unsigned char* SF = F.lds + 2 * TILE_B; LAS unsigned char* SB = F.lds + 3 * TILE_B;
    const int w = F.wave, fr = F.lane & 15, fq = F.lane >> 4;
    const int i = 16 * w + fr;
    bf16x8 pf[4];
#pragma unroll
    for (int tp = 0; tp < 4; ++tp) {
        unsigned pw[4];
#pragma unroll
        for (int bb = 0; bb < 2; ++bb) {
            const int b = 2 * tp + bb;
            f32x4 s = (f32x4){0.f, 0.f, 0.f, 0.f};
#pragma unroll
            for (int t = 0; t < 4; ++t) s = MFMA16(*(const LAS bf16x8*)(Kt + (16 * b + fr) * TP + (32 * t + 8 * fq) * 2), qf[t], s);
            float pv[4];
#pragma unroll
            for (int r = 0; r < 4; ++r) { const int j = 16 * b + 4 * fq + r; const int dd = i - j;
                const float dm = dd > 0 ? exp2f(l2f * (float)dd) : (dd < 0 ? exp2f(l2b * (float)(-dd)) : 2.f); pv[r] = s[r] * dm; }
            pw[2 * bb] = cvt_pk_bf16(pv[0], pv[1]); pw[2 * bb + 1] = cvt_pk_bf16(pv[2], pv[3]);
        }
        u32x4 pk; pk.x = pw[0]; pk.y = pw[1]; pk.z = pw[2]; pk.w = pw[3];
        pf[tp] = __builtin_bit_cast(bf16x8, pk);
    }
    const float af = exp2f(l2f * (float)(i + 1)), ab = exp2f(l2b * (float)(128 - i));
    f32x4 o[8]; float ss = 0.f;
#pragma unroll
    for (int eb = 0; eb < 8; ++eb) {
        f32x4 a0 = (f32x4){0.f, 0.f, 0.f, 0.f}, a1 = a0, a2 = a0;
#pragma unroll
        for (int t = 0; t < 4; ++t) {
            a0 = MFMA16(tr_frag(VT, 32 * t + 4 * fq, 32 * t + 16 + 4 * fq, 16 * eb, F.lane), pf[t], a0);
            a1 = MFMA16(*(const LAS bf16x8*)(SF + (16 * eb + fr) * TP + (32 * t + 8 * fq) * 2), qf[t], a1);
            a2 = MFMA16(*(const LAS bf16x8*)(SB + (16 * eb + fr) * TP + (32 * t + 8 * fq) * 2), qf[t], a2);
        }
        o[eb] = a0 + a1 * af + a2 * ab;
        ss += (o[eb][0] * o[eb][0] + o[eb][1] * o[eb][1]) + (o[eb][2] * o[eb][2] + o[eb][3] * o[eb][3]);
    }
    ss += __shfl_xor(ss, 16); ss += __shfl_xor(ss, 32);
    const float r = rsqrtf(ss * (1.f / HD) + EPS);
    bf16* MIX = (bf16*)(F.ws + WS_MIX) + (size_t)(c * 128 + i) * D + h * HD + 4 * fq;
    f32x4 n4v[8];
    { const float* ng = F.in[I_RNG] + (size_t)l * RET_W + h * HD + 4 * fq;
#pragma unroll
      for (int eb = 0; eb < 8; ++eb) n4v[eb] = *(const f32x4*)(ng + 16 * eb); }
#pragma unroll
    for (int eb = 0; eb < 8; ++eb) {
        const u32x2 gv = gvv[eb]; const f32x4 n4 = n4v[eb];
        const f32x4 v = o[eb] * r * n4;
        u32x2 ov; ov.x = cvt_pk_bf16(v[0] * bflo(gv.x), v[1] * bfhi(gv.x)); ov.y = cvt_pk_bf16(v[2] * bflo(gv.y), v[3] * bfhi(gv.y));
        *(u32x2*)(MIX + 16 * eb) = ov;
    }
    __syncthreads();
}


template <bool CTXSRC>
__device__ __forceinline__ void ret_item(Frame& F, int l, int c, int h) {
    LAS unsigned char* Kt = F.lds; LAS unsigned char* VT = F.lds + TILE_B; LAS unsigned char* SF = F.lds + 2 * TILE_B; LAS unsigned char* SB = F.lds + 3 * TILE_B;
    const bf16* ZB = (const bf16*)(F.ws + WS_ZB) + (size_t)c * 128 * N_IN;
    const bf16* ST = (const bf16*)(F.ws + WS_ST) + (((size_t)c * RET_H + h) * 2) * 16384;
    const float* lg = F.in[I_RLOG] + (size_t)l * 2 * RET_H;
    const float l2f = log_sigmoid_f(lg[h]) * LOG2E, l2b = log_sigmoid_f(lg[RET_H + h]) * LOG2E;
    const int tid = F.tid, w = F.wave, fr = F.lane & 15, fq = F.lane >> 4;
    fill_rows(Kt, ZB + C_K + h * HD, N_IN, tid);
    if (CTXSRC) {
        const bf16* KV = (const bf16*)(F.ws + WS_KVT) + (((size_t)(1 - c) * RET_H + h) * 2) * 16384;
        if (c == 1) fill_rows(SF, KV, 128, tid); else fill_rows_f32(SF, nullptr, tid);
        if (c == 0) fill_rows(SB, KV + 16384, 128, tid); else fill_rows_f32(SB, nullptr, tid);
    } else {
        fill_rows(SF, ST, 128, tid);
        fill_rows(SB, ST + 16384, 128, tid);
    }
    fill_rows(VT, ZB + C_V + h * HD, N_IN, tid);
    bf16x8 qf[4];
    { const bf16* qp = ZB + (size_t)(16 * w + fr) * N_IN + C_Q + h * HD + 8 * fq;
#pragma unroll
      for (int t = 0; t < 4; ++t) qf[t] = *(const bf16x8*)(qp + 32 * t); }
    const int i = 16 * w + fr;
    u32x2 gvv[8];
    { const bf16* G = ZB + (size_t)i * N_IN + C_G + h * HD + 4 * fq;
#pragma unroll
      for (int eb = 0; eb < 8; ++eb) gvv[eb] = *(const u32x2*)(G + 16 * eb); }
    __syncthreads();
    ret_core(F, l, c, h, l2f, l2b, qf, gvv);
}
__device__ __forceinline__ void ret_tiles_load(Frame& F, int c, int h, u32x4 (&pf)[8]) {
    const bf16* ZB = (const bf16*)(F.ws + WS_ZB) + (size_t)c * 128 * N_IN;
    int t = F.tid; asm volatile("" : "+v"(t));
    const int r = t >> 4, sg = t & 15;
#pragma unroll
    for (int q = 0; q < 4; ++q) { pf[q] = *(const u32x4*)(ZB + (size_t)(r + 32 * q) * N_IN + C_K + h * HD + sg * 8); pf[4 + q] = *(const u32x4*)(ZB + (size_t)(r + 32 * q) * N_IN + C_V + h * HD + sg * 8); }
}
__device__ __forceinline__ void ret_item_pipe(Frame& F, int l, int c, int h, u32x4 (&pf)[8], int nc, int nh, bool has_next) {
    LAS unsigned char* Kt = F.lds; LAS unsigned char* VT = F.lds + TILE_B; LAS unsigned char* SF = F.lds + 2 * TILE_B; LAS unsigned char* SB = F.lds + 3 * TILE_B;
    const bf16* ZB = (const bf16*)(F.ws + WS_ZB) + (size_t)c * 128 * N_IN;
    const bf16* ST = (const bf16*)(F.ws + WS_ST) + (((size_t)c * RET_H + h) * 2) * 16384;
    const float* lg = F.in[I_RLOG] + (size_t)l * 2 * RET_H;
    const float l2f = log_sigmoid_f(lg[h]) * LOG2E, l2b = log_sigmoid_f(lg[RET_H + h]) * LOG2E;
    const int w = F.wave, fr = F.lane & 15, fq = F.lane >> 4, r = F.tid >> 4, sg = F.tid & 15;
    fill_rows(SF, ST, 128, F.tid);
    fill_rows(SB, ST + 16384, 128, F.tid);
    bf16x8 qf[4];
    { const bf16* qp = ZB + (size_t)(16 * w + fr) * N_IN + C_Q + h * HD + 8 * fq;
#pragma unroll
      for (int t = 0; t < 4; ++t) qf[t] = *(const bf16x8*)(qp + 32 * t); }
    u32x2 gvv[8];
    { const bf16* G = ZB + (size_t)(16 * w + fr) * N_IN + C_G + h * HD + 4 * fq;
#pragma unroll
      for (int eb = 0; eb < 8; ++eb) gvv[eb] = *(const u32x2*)(G + 16 * eb); }
#pragma unroll
    for (int q = 0; q < 4; ++q) { const int o = (r + 32 * q) * TP + sg * 16; *(LAS u32x4*)(Kt + o) = pf[q]; *(LAS u32x4*)(VT + o) = pf[4 + q]; }
    __syncthreads();
    if (has_next) ret_tiles_load(F, nc, nh, pf);
    ret_core(F, l, c, h, l2f, l2b, qf, gvv);
}
template <int R, int C, int WR, int WC, int KC>
__device__ __forceinline__ void skinny_acc(Frame& F, f32x4 (&acc)[WR][WC], const bf16* A, int lda, const bf16* Bt, int ldb, int K) {
    constexpr int PITCH = KC * 2 + 16, SEGS = KC / 8, PIECES = (R + C) * SEGS, PPT = PIECES / 512, STAGE = (R + C) * PITCH, WGC = C / 16 / WC;
    static_assert(PIECES % 512 == 0 && (R / 16 / WR) * WGC == 8 && 2 * STAGE <= SCR_BYTES, "skinny geometry");
    const int tid = F.tid, fr = F.lane & 15, fq = F.lane >> 4, wgr = F.wave / WGC, wgc = F.wave % WGC;
    u32x4 rg0[PPT], rg1[PPT];
    const bf16* src[PPT]; int dst[PPT];
#pragma unroll
    for (int q = 0; q < PPT; ++q) { const int p = tid + 512 * q, row = p / SEGS, sg = p % SEGS;
        src[q] = row < R ? A + (size_t)row * lda + sg * 8 : Bt + (size_t)(row - R) * ldb + sg * 8; dst[q] = row * PITCH + sg * 16; }
#define SK_GLOAD(rg, k0) do { _Pragma("unroll") for (int q = 0; q < PPT; ++q) rg[q] = *(const u32x4*)(src[q] + (k0)); } while (0)
#define SK_LSTORE(rg, buf) do { _Pragma("unroll") for (int q = 0; q < PPT; ++q) *(LAS u32x4*)(F.lds + (buf) * STAGE + dst[q]) = rg[q]; } while (0)
#define SK_COMPUTE(buf) do { const LAS unsigned char* bA = F.lds + (buf) * STAGE; const LAS unsigned char* bB = bA + R * PITCH; \
        _Pragma("unroll") for (int t = 0; t < KC / 32; ++t) { bf16x8 af[WR], bfr[WC]; \
            _Pragma("unroll") for (int i = 0; i < WR; ++i) af[i] = *(const LAS bf16x8*)(bA + (16 * (wgr * WR + i) + fr) * PITCH + (32 * t + 8 * fq) * 2); \
            _Pragma("unroll") for (int j = 0; j < WC; ++j) bfr[j] = *(const LAS bf16x8*)(bB + (16 * (wgc * WC + j) + fr) * PITCH + (32 * t + 8 * fq) * 2); \
            _Pragma("unroll") for (int i = 0; i < WR; ++i) _Pragma("unroll") for (int j = 0; j < WC; ++j) acc[i][j] = MFMA16(bfr[j], af[i], acc[i][j]); } } while (0)
    const int nch = K / KC;
    __syncthreads();
    SK_GLOAD(rg0, 0); SK_GLOAD(rg1, KC);
    for (int ch = 0; ch < nch; ch += 2) {
        SK_LSTORE(rg0, 0); __syncthreads();
        if (ch + 2 < nch) SK_GLOAD(rg0, (ch + 2) * KC);
        SK_COMPUTE(0);
        SK_LSTORE(rg1, 1); __syncthreads();
        if (ch + 3 < nch) SK_GLOAD(rg1, (ch + 3) * KC);
        SK_COMPUTE(1);
    }
#undef SK_GLOAD
#undef SK_LSTORE
#undef SK_COMPUTE
}
template <int MODE>
__device__ __forceinline__ void ctx_n2048(Frame& F, int l, const bf16* A, const bf16* Bt, int gi, float dry) {
    if (F.G != 256) return;
    constexpr int AP = D * 2 + 16, PART = 32 * AP;
    static_assert(PART + 8 * 64 * 16 <= SCR_BYTES, "ctx_n2048 LDS");
    const int r0 = 32 * (F.bid >> 5), c0 = 64 * (F.bid & 31), fr = F.lane & 15, fq = F.lane >> 4, j = F.wave & 3, kh = F.wave >> 2, tid = F.tid;
    u32x4 av[16];
#pragma unroll
    for (int q = 0; q < 16; ++q) { const int p = tid + 512 * q; av[q] = *(const u32x4*)(A + (size_t)(r0 + (p >> 8)) * D + (p & 255) * 8); }
    const bf16* bp = Bt + (size_t)(c0 + 16 * j + fr) * D + 1024 * kh + 8 * fq;
    bf16x8 bfv[32];
#pragma unroll
    for (int t = 0; t < 16; ++t) bfv[t] = *(const bf16x8*)(bp + 32 * t);
    const int col = c0 + 16 * j + 4 * fq;
    unsigned g0[2], g1[2]; u32x2 xo[2]; f32x4 gt = (f32x4){0.f, 0.f, 0.f, 0.f};
#pragma unroll
    for (int i = 0; i < 2; ++i) { const int row = r0 + 16 * i + fr;
        if (MODE == 0) { const unsigned char* gp = (const unsigned char*)(F.ws + WS_ZB) + (size_t)row * (N_IN * 2) + 2 * C_GATE + col;
            g0[i] = *(const unsigned*)(gp + kh * D); g1[i] = *(const unsigned*)(gp + 2 * kh * D); }
        else xo[i] = *(const u32x2*)((const bf16*)(F.ws + WS_X) + (size_t)row * D + col); }
    if (MODE == 1) gt = *(const f32x4*)((const float*)(F.ws + WS_MOD) + ((size_t)l * 2 + 0) * 6 * D + gi * D + col) * dry;
    __syncthreads();
#pragma unroll
    for (int q = 0; q < 16; ++q) { const int p = tid + 512 * q; *(LAS u32x4*)(F.lds + (p >> 8) * AP + (p & 255) * 16) = av[q]; }
#pragma unroll
    for (int t = 16; t < 32; ++t) bfv[t] = *(const bf16x8*)(bp + 32 * t);
    __syncthreads();
    f32x4 acc[2][2];
#pragma unroll
    for (int s2 = 0; s2 < 2; ++s2)
#pragma unroll
        for (int i = 0; i < 2; ++i) acc[s2][i] = (f32x4){0.f, 0.f, 0.f, 0.f};
    const LAS unsigned char* ap = F.lds + fr * AP + (1024 * kh + 8 * fq) * 2;
#pragma unroll
    for (int t = 0; t < 32; ++t) { const int s2 = (MODE == 0 && t >= 16) ? 1 : 0;
        const bf16x8 a0 = *(const LAS bf16x8*)(ap + 64 * t), a1 = *(const LAS bf16x8*)(ap + 16 * AP + 64 * t);
        acc[s2][0] = MFMA16(bfv[t], a0, acc[s2][0]); acc[s2][1] = MFMA16(bfv[t], a1, acc[s2][1]); }
    f32x4 y[2];
#pragma unroll
    for (int i = 0; i < 2; ++i) {
        if (MODE == 0) {
#pragma unroll
            for (int e = 0; e < 4; ++e) y[i][e] = (acc[0][i][e] * (float)((g0[i] >> (8 * e)) & 255u) + acc[1][i][e] * (float)((g1[i] >> (8 * e)) & 255u)) * (1.f / 255.f);
        } else y[i] = acc[0][i];
    }
    LAS f32x4* part = (LAS f32x4*)(F.lds + PART);
    if (kh == 1) { part[(j * 2 + 0) * 64 + F.lane] = y[0]; part[(j * 2 + 1) * 64 + F.lane] = y[1]; }
    __syncthreads();
    if (kh == 0) {
#pragma unroll
        for (int i = 0; i < 2; ++i) { const int row = r0 + 16 * i + fr; const f32x4 v = y[i] + part[(j * 2 + i) * 64 + F.lane];
            if (MODE == 0) { u32x2 o; o.x = cvt_pk_bf16(v[0], v[1]); o.y = cvt_pk_bf16(v[2], v[3]); *(u32x2*)((bf16*)(F.ws + WS_Y) + (size_t)row * D + col) = o; }
            else { const f32x4 d = gt * v; u32x2 xn; xn.x = cvt_pk_bf16(bflo(xo[i].x) + d[0], bfhi(xo[i].x) + d[1]); xn.y = cvt_pk_bf16(bflo(xo[i].y) + d[2], bfhi(xo[i].y) + d[3]);
                *(u32x2*)((bf16*)(F.ws + WS_X) + (size_t)row * D + col) = xn; }
        }
    }
    __syncthreads();
}
__device__ __forceinline__ void ctx_up(Frame& F, const bf16* Bt) {
    if (F.G != 256) return;
    const int r0 = 64 * (F.bid >> 6), c0 = 128 * (F.bid & 63), fr = F.lane & 15, fq = F.lane >> 4, wgr = F.wave >> 2, wgc = F.wave & 3;
    f32x4 acc[2][2];
#pragma unroll
    for (int i = 0; i < 2; ++i)
#pragma unroll
        for (int j = 0; j < 2; ++j) acc[i][j] = (f32x4){0.f, 0.f, 0.f, 0.f};
    skinny_acc<64, 128, 2, 2, 128>(F, acc, (const bf16*)(F.ws + WS_H) + (size_t)r0 * D, D, Bt + (size_t)c0 * D, D, D);
#pragma unroll
    for (int i = 0; i < 2; ++i)
#pragma unroll
        for (int j = 0; j < 2; ++j) { const int row = r0 + 16 * (wgr * 2 + i) + fr, col = c0 + 16 * (wgc * 2 + j) + 4 * fq; f32x4 a = acc[i][j];
#pragma unroll
            for (int q = 0; q < 4; ++q) { const float x = fmaxf(a[q], 0.f); a[q] = x * x; }
            u32x2 o; o.x = cvt_pk_bf16(a[0], a[1]); o.y = cvt_pk_bf16(a[2], a[3]);
            *(u32x2*)((bf16*)(F.ws + WS_A1) + (size_t)row * DFF + col) = o; }
}

__device__ __forceinline__ void ctx_down_splitk(Frame& F, const bf16* Bt) {
    if (F.G != 256) return;
    const int ks = F.bid >> 6, r0 = 64 * ((F.bid >> 4) & 3), c0 = 128 * (F.bid & 15), fr = F.lane & 15, fq = F.lane >> 4, wgr = F.wave >> 2, wgc = F.wave & 3;
    f32x4 acc[2][2];
#pragma unroll
    for (int i = 0; i < 2; ++i)
#pragma unroll
        for (int j = 0; j < 2; ++j) acc[i][j] = (f32x4){0.f, 0.f, 0.f, 0.f};
    skinny_acc<64, 128, 2, 2, 128>(F, acc, (const bf16*)(F.ws + WS_A1) + (size_t)r0 * DFF + ks * 2048, DFF, Bt + (size_t)c0 * DFF + ks * 2048, DFF, 2048);
    float* SL = (float*)(F.ws + WS_SLAB) + (size_t)ks * CTX * D;
#pragma unroll
    for (int i = 0; i < 2; ++i)
#pragma unroll
        for (int j = 0; j < 2; ++j) { const int row = r0 + 16 * (wgr * 2 + i) + fr, col = c0 + 16 * (wgc * 2 + j) + 4 * fq; *(f32x4*)(SL + (size_t)row * D + col) = acc[i][j]; }
}

constexpr int PH_PER_LAYER = 10, PH_PRE = 3, N_PHASES = PH_PRE + DEPTH * PH_PER_LAYER;
__global__ void __launch_bounds__(512, 2) mk_fwd(Args args) {
    extern __shared__ __attribute__((aligned(16))) unsigned char lds_raw[];
    LAS unsigned char* const ldsb = (LAS unsigned char*)lds_raw;
    volatile LAS unsigned* MISC = (volatile LAS unsigned*)(ldsb + MISC_OFF);
    for (int u = threadIdx.x; u < 64; u += 512) MISC[u] = 0u;
    __syncthreads();
    unsigned* barw = (unsigned*)(args.ws + WS_BAR);
    XcdBarrier bar; bar.bar = barw; bar.x = 0; bar.st = MISC + 8;
    if (!MK_SPLIT) bar = xcd_barrier_post(barw, MISC + 8);
    const int lo = args.ph_lo, hi = args.ph_hi;
#define IN(k) (lo <= (k) && (k) < hi)
#define SEAM(k) do { if (IN((k) + 1)) xcd_barrier(bar); } while (0)
#define MODP(F) ((const float*)((F).ws + WS_MOD))

    if (IN(0) && (PMASK & 1)) { for (int rep = 0; rep < ((DUP >> 12) & 1) + 1; ++rep) { Frame F; make_frame(F, ldsb); p0_prologue(F); __syncthreads(); } SEAM(0); }
    if (IN(1) && (PMASK & 1)) { Frame F; make_frame(F, ldsb); mod_reduce_phase(F); SEAM(1); }
    if (IN(2) && (PMASK & 2)) { Frame F; make_frame(F, ldsb); norm_phase(F, F.in[I_N1G], MODP(F), 0, true); SEAM(2); }

    for (int l = 0; l < DEPTH; ++l) {
        const int pb = PH_PRE + l * PH_PER_LAYER;
        if (IN(pb + 0) && (PMASK & 4)) for (int rep = 0; rep < ((DUP >> 0) & 1) + 1; ++rep) {
            Frame F; make_frame(F, ldsb);
            pg8::GemmSched S; S.T.init(MROWS / 256, N_IN / 256, F.G, F.bid); S.A = (const char*)(F.ws + WS_H); S.B = (const char*)(F.ws + WS_WIN + l * SZ_WIN);
            S.a_tile = (size_t)256 * D * 2; S.b_tile = (size_t)256 * D * 2; S.nt = D / 64; S.pm0 = 0;
            EpiInProj E{(bf16*)(F.ws + WS_ZB), (const float*)(F.ws + WS_ROPE)};
            pg8::gemm_phase(F.lds, F.tid, D, D, S, E);
            SEAM(pb + 0);
        }
        if (IN(pb + 1) && (PMASK & 8)) for (int rep = 0; rep < ((DUP >> 1) & 1) + 1; ++rep) {
            Frame F; make_frame(F, ldsb);
            constexpr int N_KV = NCHUNK * RET_H, N_PG = (NCHUNK - 4) * 4;
            for (int it = F.bid; it < N_KV + 2 * N_PG; it += F.G) {
                if (it < N_KV) kv_item(F, l, it / RET_H, it % RET_H);
                else if (it < N_KV + N_PG) { const int r = it - N_KV + 16; pool_item(F, l, r >> 2, r & 3); }
                else { const int r = it - N_KV - N_PG + 16; sg_item(F, l, r >> 2, r & 3); }
            }
            SEAM(pb + 1);
        }
        if (IN(pb + 2) && (PMASK & 16)) for (int rep = 0; rep < ((DUP >> 2) & 1) + 1; ++rep) { Frame F; make_frame(F, ldsb);
            const bool ctx_live = l + 1 < DEPTH;
            const int nctx = ctx_live ? 2 * RET_H : 0, ndef = ctx_live ? 32 : 16;
            if (F.bid < nctx) ret_item<true>(F, l, F.bid >> 3, F.bid & 7);
            else if (F.bid < nctx + ndef) { const int j = F.bid - nctx, d = ctx_live ? j : (j < 8 ? 8 + j : 16 + j);
                if (d < 16) pool_item(F, l, d >> 2, d & 3); else sg_item(F, l, (d - 16) >> 2, d & 3); }
            scan_phase(F, l, nctx + ndef); SEAM(pb + 2); }
        if (IN(pb + 3) && (PMASK & 32)) for (int rep = 0; rep < ((DUP >> 3) & 1) + 1; ++rep) {
            Frame F; make_frame(F, ldsb);
            constexpr int N_RET = SEQ / 128 * RET_H;
            if (F.bid < N_RET) { u32x4 pf[8]; { const int itx = 2 * RET_H + F.bid; ret_tiles_load(F, itx / RET_H, itx % RET_H, pf); }
                for (int it = F.bid; it < N_RET; it += F.G) { const int itx = 2 * RET_H + it, nx = itx + F.G; ret_item_pipe(F, l, itx / RET_H, itx % RET_H, pf, nx / RET_H, nx % RET_H, it + F.G < N_RET); } }
            SEAM(pb + 3);
        }
        if (IN(pb + 4) && (PMASK & 64)) for (int rep = 0; rep < ((DUP >> 4) & 1) + 1; ++rep) {
            Frame F; make_frame(F, ldsb);
            pg8::BranchSched S; S.T.init(SEQ / 256, D / 256, F.G, F.bid); S.A = (const char*)(F.ws + WS_MIX); S.B = (const char*)(F.ws + WS_WCAT + l * SZ_WSQ);
            S.a_tile = (size_t)256 * D * 2; S.b_tile = (size_t)256 * D * 2; S.pm0 = 1;
            EpiBranch E{(const bf16*)(F.ws + WS_ZB), (bf16*)(F.ws + WS_Y)};
            pg8::gemm_phase(F.lds, F.tid, D, D, S, E);
            if (l + 1 < DEPTH) ctx_n2048<0>(F, l, (const bf16*)(F.ws + WS_MIX), (const bf16*)(F.ws + WS_WCAT + l * SZ_WSQ), 0, 1.f);
            SEAM(pb + 4);
        }
        if (IN(pb + 5) && (PMASK & 128)) for (int rep = 0; rep < ((DUP >> 5) & 1) + 1; ++rep) {
            Frame F; make_frame(F, ldsb);
            pg8::GemmSched S; S.T.init(SEQ / 256, D / 256, F.G, F.bid); S.A = (const char*)(F.ws + WS_Y); S.B = (const char*)(F.ws + WS_WOUT + l * SZ_WSQ);
            S.a_tile = (size_t)256 * D * 2; S.b_tile = (size_t)256 * D * 2; S.nt = D / 64; S.pm0 = 1;
            if (l + 1 < DEPTH || !FUSE_FINAL) {
                EpiResid E{(bf16*)(F.ws + WS_X), MODP(F) + (size_t)l * 2 * 6 * D, 2, rep ? 0.f : 1.f};
                pg8::gemm_phase(F.lds, F.tid, D, D, S, E);
                if (l + 1 < DEPTH) ctx_n2048<1>(F, l, (const bf16*)(F.ws + WS_Y), (const bf16*)(F.ws + WS_WOUT + l * SZ_WSQ), 2, rep ? 0.f : 1.f);
            } else {
                const float* ml = MODP(F) + (size_t)l * 2 * 6 * D;
                EpiResidNorm<false> E{(bf16*)(F.ws + WS_X), ml, 2, F.in[I_N2G] + (size_t)l * D, nullptr, (unsigned*)(F.ws + WS_XCH), (unsigned*)(F.ws + WS_CNT), F.lds + 131072, 64u, (bf16*)(F.ws + WS_H), ml + 6 * D + 4 * D, ml + 6 * D + 3 * D};
                pg8::gemm_phase(F.lds, F.tid, D, D, S, E);
            }
            SEAM(pb + 5);
        }
        if (IN(pb + 6) && (PMASK & 256) && (l + 1 < DEPTH || !FUSE_FINAL)) for (int rep = 0; rep < ((DUP >> 6) & 1) + 1; ++rep) { Frame F; make_frame(F, ldsb); norm_phase(F, F.in[I_N2G] + (size_t)l * D, MODP(F) + (size_t)l * 2 * 6 * D, 3, false); SEAM(pb + 6); }
        if (IN(pb + 7) && (PMASK & 512)) for (int rep = 0; rep < ((DUP >> 7) & 1) + 1; ++rep) {
            Frame F; make_frame(F, ldsb);
            pg8::GemmSched S; S.T.init(SEQ / 256, DFF / 256, F.G, F.bid); S.A = (const char*)(F.ws + WS_H); S.B = (const char*)(F.ws + WS_W1 + l * SZ_WFF);
            S.a_tile = (size_t)256 * D * 2; S.b_tile = (size_t)256 * D * 2; S.nt = D / 64; S.pm0 = 1;
            EpiRelu2 E{(bf16*)(F.ws + WS_A1)};
            pg8::gemm_phase(F.lds, F.tid, D, D, S, E);
            if (l + 1 < DEPTH) ctx_up(F, (const bf16*)(F.ws + WS_W1 + l * SZ_WFF));
            SEAM(pb + 7);
        }
        if (IN(pb + 8) && (PMASK & 1024)) for (int rep = 0; rep < ((DUP >> 8) & 1) + 1; ++rep) {
            Frame F; make_frame(F, ldsb);
            pg8::GemmSched S; S.T.init(SEQ / 256, D / 256, F.G, F.bid); S.A = (const char*)(F.ws + WS_A1); S.B = (const char*)(F.ws + WS_W2 + l * SZ_WFF);
            S.a_tile = (size_t)256 * DFF * 2; S.b_tile = (size_t)256 * DFF * 2; S.nt = DFF / 64; S.pm0 = 1;
            if (l + 1 < DEPTH) {
                EpiResid E{(bf16*)(F.ws + WS_X), MODP(F) + (size_t)l * 2 * 6 * D, 5, rep ? 0.f : 1.f};
                pg8::gemm_phase(F.lds, F.tid, DFF, DFF, S, E);
                ctx_down_splitk(F, (const bf16*)(F.ws + WS_W2 + l * SZ_WFF));
            } else {
                EpiResidNorm<true> E{(bf16*)(F.ws + WS_X), MODP(F) + (size_t)l * 2 * 6 * D, 5, F.in[I_FNG], ((KArgs)__builtin_amdgcn_kernarg_segment_ptr())->out, (unsigned*)(F.ws + WS_XCH), (unsigned*)(F.ws + WS_CNT), F.lds + 131072, 128u, nullptr, nullptr, nullptr};
                pg8::gemm_phase(F.lds, F.tid, DFF, DFF, S, E);
            }
            if (l + 1 < DEPTH || !FUSE_FINAL) SEAM(pb + 8);
        }
        if (IN(pb + 9) && (PMASK & 2048)) for (int rep = 0; rep < ((DUP >> 9) & 1) + 1; ++rep) {
            Frame F; make_frame(F, ldsb);
            if (l + 1 < DEPTH) { norm_phase(F, F.in[I_N1G] + (size_t)(l + 1) * D, MODP(F) + (size_t)(l + 1) * 2 * 6 * D, 0, false, MODP(F) + (size_t)l * 2 * 6 * D + 5 * D); SEAM(pb + 9); }
            else final_norm_phase(F, ((KArgs)__builtin_amdgcn_kernarg_segment_ptr())->out);
        }
    }
#undef IN
#undef SEAM
}

extern "C" void kernel_launch(void* const* d_in, const int* in_sizes, int n_in, void* d_out, int out_size, void* d_ws, size_t ws_size, hipStream_t stream) {
    static int grid = 0;
    if (grid == 0) {
        if (n_in != 23 || out_size != SEQ * D || ws_size < WS_END) { fprintf(stderr, "kernel_launch: unexpected problem (n_in %d, out %d, ws %zu < %zu)\n", n_in, out_size, ws_size, (size_t)WS_END); grid = -1; return; }
        int dev = 0, cus = 0, per_cu = 0;
        if (hipGetDevice(&dev) != hipSuccess || hipDeviceGetAttribute(&cus, hipDeviceAttributeMultiprocessorCount, dev) != hipSuccess) { grid = -1; return; }
        if (hipFuncSetAttribute((const void*)mk_fwd, hipFuncAttributeMaxDynamicSharedMemorySize, LDS_BYTES) != hipSuccess) { fprintf(stderr, "kernel_launch: hipFuncSetAttribute failed\n"); grid = -1; return; }
        if (hipOccupancyMaxActiveBlocksPerMultiprocessor(&per_cu, (const void*)mk_fwd, 512, LDS_BYTES) != hipSuccess || per_cu < 1) { fprintf(stderr, "kernel_launch: occupancy query reports %d blocks per CU\n", per_cu); (void)hipGetLastError(); grid = -1; return; }
        grid = cus;
    }
    if (grid < 0) return;
    if (hipMemsetAsync((char*)d_ws + WS_CTL, 0, CTL_ZERO_BYTES, stream) != hipSuccess) return;
    Args a{};
    for (int i = 0; i < 23; ++i) a.in[i] = (const float*)d_in[i];
    a.out = (float*)d_out; a.ws = (unsigned char*)d_ws;
#if MK_SPLIT
    for (int p = 0; p < N_PHASES; ++p) { a.ph_lo = p; a.ph_hi = p + 1; hipLaunchKernelGGL(mk_fwd, dim3(grid), dim3(512), LDS_BYTES, stream, a); }
#else
    a.ph_lo = 0; a.ph_hi = N_PHASES;
    hipLaunchKernelGGL(mk_fwd, dim3(grid), dim3(512), LDS_BYTES, stream, a);
#endif
}
```
